# Optimizing an MI355X kernel written in HIP

```python
import math
import jax, jax.numpy as jnp
from jax import lax
import numpy as np

D_MODEL = 2048
BATCH = 4
SEQ = 8192
DEPTH = 4

W_A = 512
CONV_A = 3
W_B = 512
CONV_B = 31
W_C = 512
GMLP_CHUNK = 128
GMLP_GROUPS = 4
N_HEADS = 4
HEAD_DIM = 128
W_D = N_HEADS * HEAD_DIM
MOBA_BLOCK = 256
MOBA_TOPK = 3
Q_CHUNK = 64
N_BUCKETS = 32
REL_MAX_DIST = 2048
D_FF = 4 * D_MODEL
N_BRANCH = 4
EPS = 1e-6
NEG_INF = -1e30

OFF_A = 0
OFF_B = OFF_A + 3 * W_A
OFF_C = OFF_B + 2 * W_B
OFF_D = OFF_C + 2 * W_C
OFF_G = OFF_D + 3 * W_D
IN_COLS = OFF_G + N_BRANCH * D_MODEL

kernel_name = "hybrid_gated_conv_gmlp_moba_trunk"


def _rms_norm(x, g):
    xf = x.astype(jnp.float32)
    y = xf * lax.rsqrt(jnp.mean(xf * xf, axis=-1, keepdims=True) + EPS)
    return (y * g.astype(jnp.float32)).astype(x.dtype)


def _layer_norm(x, g, b):
    xf = x.astype(jnp.float32)
    mu = jnp.mean(xf, axis=-1, keepdims=True)
    xc = xf - mu
    y = xc * lax.rsqrt(jnp.mean(xc * xc, axis=-1, keepdims=True) + EPS)
    return (y * g.astype(jnp.float32) + b.astype(jnp.float32)).astype(x.dtype)


def _causal_depthwise_conv(x, w):
    k = w.shape[0]
    return lax.conv_general_dilated(
        x, w[:, None, :].astype(x.dtype), window_strides=(1,), padding=[(k - 1, 0)],
        dimension_numbers=("NWC", "WIO", "NWC"), feature_group_count=x.shape[-1])


def _rel_bucket(dist):
    n = jnp.maximum(dist, 0)
    max_exact = N_BUCKETS // 2
    nf = jnp.maximum(n, 1).astype(jnp.float32)
    large = max_exact + (jnp.log(nf / max_exact) / math.log(REL_MAX_DIST / max_exact)
                         * (N_BUCKETS - max_exact)).astype(jnp.int32)
    large = jnp.minimum(large, N_BUCKETS - 1)
    return jnp.where(n < max_exact, n, large)


def _moba_attention(q, k, v, rel_bias):
    bsz, seq = q.shape[0], q.shape[1]
    n_blk = -(-seq // MOBA_BLOCK)
    s_pad = n_blk * MOBA_BLOCK
    pad = ((0, 0), (0, s_pad - seq), (0, 0), (0, 0))
    q = jnp.pad(q, pad).transpose(0, 2, 1, 3)
    k = jnp.pad(k, pad).transpose(0, 2, 1, 3)
    v = jnp.pad(v, pad).transpose(0, 2, 1, 3)
    k_blk = k.reshape(bsz, N_HEADS, n_blk, MOBA_BLOCK, HEAD_DIM)
    v_blk = v.reshape(bsz, N_HEADS, n_blk, MOBA_BLOCK, HEAD_DIM)
    k_mean = jnp.mean(k_blk.astype(jnp.float32), axis=3)
    pos = jnp.arange(s_pad, dtype=jnp.int32)
    q_blk_id = pos // MOBA_BLOCK
    gate = jnp.einsum("bhsd,bhnd->bhsn", q.astype(jnp.float32), k_mean)
    past = jnp.arange(n_blk, dtype=jnp.int32)[None, :] < q_blk_id[:, None]
    gate = jnp.where(past, gate, NEG_INF)
    n_sel = min(MOBA_TOPK, n_blk)
    _, sel_idx = lax.top_k(gate, n_sel)
    sel_valid = sel_idx < q_blk_id[:, None]

    n_chunk = s_pad // Q_CHUNK
    b_idx = jnp.arange(bsz)[:, None, None, None]
    h_idx = jnp.arange(N_HEADS)[None, :, None, None]
    h5 = jnp.arange(N_HEADS)[None, :, None, None, None]
    offs = jnp.arange(MOBA_BLOCK, dtype=jnp.int32)
    scale = HEAD_DIM ** -0.5

    def chunk(c):
        start = c * Q_CHUNK
        q_c = lax.dynamic_slice_in_dim(q, start, Q_CHUNK, axis=2)
        idx_c = lax.dynamic_slice_in_dim(sel_idx, start, Q_CHUNK, axis=2)
        val_c = lax.dynamic_slice_in_dim(sel_valid, start, Q_CHUNK, axis=2)
        q_pos = start + jnp.arange(Q_CHUNK, dtype=jnp.int32)
        own = start // MOBA_BLOCK
        k_own = lax.dynamic_index_in_dim(k_blk, own, axis=2, keepdims=False)
        v_own = lax.dynamic_index_in_dim(v_blk, own, axis=2, keepdims=False)
        d_own = q_pos[:, None] - (own * MOBA_BLOCK + offs)[None, :]
        l_own = (jnp.einsum("bhqd,bhkd->bhqk", q_c, k_own).astype(jnp.float32) * scale
                 + rel_bias[_rel_bucket(d_own)].transpose(2, 0, 1).astype(jnp.float32))
        l_own = jnp.where(d_own >= 0, l_own, NEG_INF)
        k_g = k_blk[b_idx, h_idx, idx_c]
        v_g = v_blk[b_idx, h_idx, idx_c]
        d_sel = q_pos[None, None, :, None, None] - (idx_c[..., None] * MOBA_BLOCK + offs)
        l_sel = (jnp.einsum("bhqd,bhqnkd->bhqnk", q_c, k_g).astype(jnp.float32) * scale
                 + rel_bias[_rel_bucket(d_sel), h5].astype(jnp.float32))
        l_sel = jnp.where(val_c[..., None], l_sel, NEG_INF)
        logits = jnp.concatenate(
            [l_own, l_sel.reshape(bsz, N_HEADS, Q_CHUNK, n_sel * MOBA_BLOCK)], axis=-1)
        p = jax.nn.softmax(logits, axis=-1).astype(v.dtype)
        p_own = p[..., :MOBA_BLOCK]
        p_sel = p[..., MOBA_BLOCK:].reshape(bsz, N_HEADS, Q_CHUNK, n_sel, MOBA_BLOCK)
        return (jnp.einsum("bhqk,bhkd->bhqd", p_own, v_own)
                + jnp.einsum("bhqnk,bhqnkd->bhqd", p_sel, v_g))

    out = lax.map(chunk, jnp.arange(n_chunk, dtype=jnp.int32))
    out = out.transpose(1, 0, 3, 2, 4).reshape(bsz, s_pad, W_D)
    return out[:, :seq]


def setup_inputs(seed: int = 0) -> dict:
    key = jax.random.key(seed)
    ks = jax.random.split(key, 32)
    f32 = jnp.float32
    nrm = lambda k, shape, s: jax.random.normal(k, shape, f32) * s
    return {
        "x": nrm(ks[0], (BATCH, SEQ, D_MODEL), 1.0),
        "rel_bias": nrm(ks[1], (N_BUCKETS, N_HEADS), 0.5),
        "norm_mix_g": 1.0 + nrm(ks[2], (DEPTH, D_MODEL), 0.05),
        "w_in": nrm(ks[3], (DEPTH, D_MODEL, IN_COLS), D_MODEL ** -0.5),
        "conv_a_w": nrm(ks[4], (DEPTH, CONV_A, W_A), CONV_A ** -0.5),
        "w_out_a": nrm(ks[5], (DEPTH, W_A, D_MODEL), W_A ** -0.5),
        "conv_b_w": nrm(ks[6], (DEPTH, CONV_B, W_B), CONV_B ** -0.5),
        "conv_b_bias": nrm(ks[7], (DEPTH, W_B), 0.02),
        "ln_b_g": 1.0 + nrm(ks[8], (DEPTH, W_B), 0.05),
        "ln_b_b": nrm(ks[9], (DEPTH, W_B), 0.02),
        "w_out_b": nrm(ks[10], (DEPTH, W_B, D_MODEL), W_B ** -0.5),
        "ln_c_g": 1.0 + nrm(ks[11], (DEPTH, W_C), 0.05),
        "ln_c_b": nrm(ks[12], (DEPTH, W_C), 0.02),
        "w_spatial": nrm(ks[13], (DEPTH, GMLP_GROUPS, GMLP_CHUNK, GMLP_CHUNK), GMLP_CHUNK ** -0.5),
        "b_spatial": 1.0 + nrm(ks[14], (DEPTH, GMLP_GROUPS, GMLP_CHUNK), 0.1),
        "w_out_c": nrm(ks[15], (DEPTH, W_C, D_MODEL), W_C ** -0.5),
        "q_norm_g": 1.0 + nrm(ks[16], (DEPTH, HEAD_DIM), 0.05),
        "k_norm_g": 1.0 + nrm(ks[17], (DEPTH, HEAD_DIM), 0.05),
        "w_out_d": nrm(ks[18], (DEPTH, W_D, D_MODEL), W_D ** -0.5),
        "w_o": nrm(ks[19], (DEPTH, D_MODEL, D_MODEL), D_MODEL ** -0.5),
        "norm_mlp_g": 1.0 + nrm(ks[20], (DEPTH, D_MODEL), 0.05),
        "w_mlp_in": nrm(ks[21], (DEPTH, D_MODEL, D_FF), D_MODEL ** -0.5),
        "w_mlp_out": nrm(ks[22], (DEPTH, D_FF, D_MODEL), D_FF ** -0.5),
    }


def reference(x, rel_bias, norm_mix_g, w_in, conv_a_w, w_out_a, conv_b_w, conv_b_bias,
              ln_b_g, ln_b_b, w_out_b, ln_c_g, ln_c_b, w_spatial, b_spatial, w_out_c,
              q_norm_g, k_norm_g, w_out_d, w_o, norm_mlp_g, w_mlp_in, w_mlp_out):
    bsz, seq = x.shape[0], x.shape[1]
    n_chunks = seq // GMLP_CHUNK
    causal_tri = jnp.tril(jnp.ones((GMLP_CHUNK, GMLP_CHUNK), x.dtype))
    for l in range(DEPTH):
        h = _rms_norm(x, norm_mix_g[l])
        z = h @ w_in[l]

        a_b, a_c, a_x = jnp.split(z[..., OFF_A:OFF_B], 3, axis=-1)
        y_a = (a_b * _causal_depthwise_conv(a_c * a_x, conv_a_w[l])) @ w_out_a[l]

        b_a, b_g = jnp.split(z[..., OFF_B:OFF_C], 2, axis=-1)
        hb = _causal_depthwise_conv(b_a * jax.nn.sigmoid(b_g), conv_b_w[l]) + conv_b_bias[l]
        y_b = jax.nn.silu(_layer_norm(hb, ln_b_g[l], ln_b_b[l])) @ w_out_b[l]

        u, vv = jnp.split(jax.nn.gelu(z[..., OFF_C:OFF_D]), 2, axis=-1)
        vv = _layer_norm(vv, ln_c_g[l], ln_c_b[l])
        vv = vv.reshape(bsz, n_chunks, GMLP_CHUNK, GMLP_GROUPS, W_C // GMLP_GROUPS)
        sv = (jnp.einsum("gts,bnsgc->bntgc", w_spatial[l] * causal_tri, vv)
              + b_spatial[l].T[:, :, None])
        y_c = (u * sv.reshape(bsz, seq, W_C)) @ w_out_c[l]

        q, k, v = jnp.split(z[..., OFF_D:OFF_G], 3, axis=-1)
        q = _rms_norm(q.reshape(bsz, seq, N_HEADS, HEAD_DIM), q_norm_g[l])
        k = _rms_norm(k.reshape(bsz, seq, N_HEADS, HEAD_DIM), k_norm_g[l])
        v = v.reshape(bsz, seq, N_HEADS, HEAD_DIM)
        y_d = _moba_attention(q, k, v, rel_bias) @ w_out_d[l]

        g = jax.nn.sigmoid(z[..., OFF_G:].astype(jnp.float32)).astype(x.dtype)
        g = g.reshape(bsz, seq, N_BRANCH, D_MODEL)
        merged = g[:, :, 0] * y_a + g[:, :, 1] * y_b + g[:, :, 2] * y_c + g[:, :, 3] * y_d
        x = x + merged @ w_o[l]

        h2 = _rms_norm(x, norm_mlp_g[l])
        x = x + jnp.square(jax.nn.relu(h2 @ w_mlp_in[l])) @ w_mlp_out[l]
    return x
```

```cpp
#include <hip/hip_runtime.h>
#include <cstdio>
#include <cstdint>

#define LAS __attribute__((address_space(3)))
#define GAS __attribute__((address_space(1)))
typedef unsigned short bf16_t;
typedef short bf16x8 __attribute__((ext_vector_type(8)));
typedef short s16x4 __attribute__((ext_vector_type(4)));
typedef float f32x4 __attribute__((ext_vector_type(4)));
typedef float f32x16 __attribute__((ext_vector_type(16)));
typedef unsigned u32x4 __attribute__((ext_vector_type(4)));
typedef unsigned u32x2 __attribute__((ext_vector_type(2)));

#ifndef PH_MASK
#define PH_MASK 0xFFFF
#endif
#ifndef DUP_MASK
#define DUP_MASK 0
#endif
#define REP(n) for (int rep = 0; rep <= ((DUP_MASK >> (n)) & 1); ++rep)
constexpr int DM = 2048, BATCH = 4, SEQ = 8192, DEPTH = 4, MROWS = BATCH * SEQ;
constexpr int OFF_A = 0, OFF_B = 1536, OFF_C = 2560, OFF_D = 3584, OFF_G = 5120, ZP = 13312;
constexpr int DFF = 8192, NH = 4, HD = 128;
constexpr float EPS = 1e-6f;
constexpr float LOG2E = 1.4426950408889634f;
constexpr float QSCALE = 0.08838834764831845f * 1.4426950408889634f;
constexpr int TABN = 1536;
constexpr int TABP = TABN + 128, TREV = TABN + 58;

__device__ __forceinline__ unsigned pk2(float lo, float hi) {
    typedef float f2_t __attribute__((ext_vector_type(2))); typedef __bf16 b2_t __attribute__((ext_vector_type(2)));
    f2_t v = {lo, hi}; b2_t b = __builtin_convertvector(v, b2_t); return __builtin_bit_cast(unsigned, b);
}
__device__ __forceinline__ float bflo(unsigned w) { return __uint_as_float(w << 16); }
__device__ __forceinline__ float bfhi(unsigned w) { return __uint_as_float(w & 0xffff0000u); }
__device__ __forceinline__ void unpack8(const u32x4 w, float (&f)[8]) {
    f[0] = bflo(w.x); f[1] = bfhi(w.x); f[2] = bflo(w.y); f[3] = bfhi(w.y); f[4] = bflo(w.z); f[5] = bfhi(w.z); f[6] = bflo(w.w); f[7] = bfhi(w.w);
}
__device__ __forceinline__ u32x4 pack8(const float (&f)[8]) { u32x4 w; w.x = pk2(f[0], f[1]); w.y = pk2(f[2], f[3]); w.z = pk2(f[4], f[5]); w.w = pk2(f[6], f[7]); return w; }
__device__ __forceinline__ float sigmoid_f(float x) { return __builtin_amdgcn_rcpf(1.0f + __builtin_amdgcn_exp2f(-x * LOG2E)); }
__device__ __forceinline__ float gelu_tanh_f(float x) {
    const float u2 = 1.5957691216057308f * (x + 0.044715f * x * x * x);
    return x * __builtin_amdgcn_rcpf(1.0f + __builtin_amdgcn_exp2f(-u2 * LOG2E));
}
__device__ __forceinline__ float wave_sum(float v) {
#pragma unroll
    for (int o = 1; o < 64; o <<= 1) v += __shfl_xor(v, o);
    return v;
}
__device__ __forceinline__ float wave_max(float v) {
#pragma unroll
    for (int o = 1; o < 64; o <<= 1) v = fmaxf(v, __shfl_xor(v, o));
    return v;
}
__device__ __forceinline__ unsigned lds_add(LAS unsigned* p, unsigned v) { return __hip_atomic_fetch_add(p, v, __ATOMIC_RELAXED, __HIP_MEMORY_SCOPE_WORKGROUP); }
__device__ __forceinline__ int opaque_tid() { int t = threadIdx.x; asm volatile("" : "+v"(t)); return t; }
__device__ __forceinline__ unsigned char* opaque_ptr(unsigned char* p) { asm volatile("" : "+s"(p)); return p; }
__device__ __forceinline__ u32x4 ldg16(const bf16_t* p) { return *(const GAS u32x4*)p; }
__device__ __forceinline__ void stg16(bf16_t* p, u32x4 v) { *(GAS u32x4*)p = v; }

namespace pg8 {
constexpr int BM = 256, BK = 64, HALF = 128, HTB = HALF * BK * 2, STAGE_BYTES = 8 * HTB, NXCD = 8, WGM = 4;
__host__ __device__ __forceinline__ int lds_byte(int r, int c) { const int st = (r >> 4) * 2 + (c >> 5), rr = r & 15, cc = c & 31, ob = rr * 64 + cc * 2; return st * 1024 + (ob ^ (((ob >> 9) & 1) << 5)); }
__host__ __device__ __forceinline__ void stage_rc(int b, int& R, int& C) { const int st = b / 1024, sb = b % 1024, swz = sb ^ (((sb >> 9) & 1) << 5); R = (st >> 1) * 16 + swz / 64; C = (st & 1) * 32 + (swz % 64) / 2; }
__host__ __device__ __forceinline__ int perm32(int rho) { const int n = rho >> 4, i = rho & 15; return 8 * (i >> 2) + 4 * n + (i & 3); }

typedef int v8i_t __attribute__((ext_vector_type(8)));
typedef v8i_t v8i_a16 __attribute__((aligned(16)));
__device__ __forceinline__ v8i_t cat8(const u32x4 a, const u32x4 b) { return (v8i_t){(int)a.x, (int)a.y, (int)a.z, (int)a.w, (int)b.x, (int)b.y, (int)b.z, (int)b.w}; }
struct Unit { int pm, pn, seg; };
struct Gemm { const void* A; const void* Bt; int lda_b, ldb_b, Kb; size_t a_seg, b_seg; };

template <int NSEG_LOG2> struct StaticOrder {
    int nM, nN, nwg, G, c;
    __device__ void init(int M, int N, int G_, int c_) { nM = M / BM; nN = N / BM; nwg = nM * nN; G = G_; c = c_; }
    __device__ bool next(int i, Unit& u) const {
        const int ti = i >> NSEG_LOG2;
        const long L = (long)ti * G + c; if (L >= nwg) return false;
        int wgid = (int)L; { const int q = nwg / NXCD, r = nwg % NXCD, xcd = wgid % NXCD, off = wgid / NXCD; wgid = (xcd < r ? xcd * (q + 1) : r * (q + 1) + (xcd - r) * q) + off; }
        const int nig = WGM * nN, gid = wgid / nig, fm = gid * WGM, gsz = (nM - fm) < WGM ? (nM - fm) : WGM;
        u.pm = fm + ((wgid % nig) % gsz); u.pn = (wgid % nig) / gsz; u.seg = i & ((1 << NSEG_LOG2) - 1); return true;
    }
};

typedef f32x4 Acc[2][2][4][2];
template <class V, int NDW> __device__ __forceinline__ void store_pair(void* pe, void* po, int odd, V w0, V w1) {
    V A, B;
#pragma unroll
    for (int d = 0; d < NDW; ++d) { const unsigned snd = odd ? w0[d] : w1[d]; const unsigned rcv = (unsigned)__builtin_amdgcn_mov_dpp((int)snd, 0xB1, 0xF, 0xF, true);
        A[d] = odd ? rcv : w0[d]; B[d] = odd ? w1[d] : rcv; }
    *(GAS V*)pe = A; *(GAS V*)po = B;
}
__device__ __forceinline__ void rows_rstd(const float* part, int row0, float scale, float (&rsv)[2][4]) {
    f32x4 pa[2][4], pb[2][4];
#pragma unroll
    for (int ai = 0; ai < 2; ++ai)
#pragma unroll
        for (int m = 0; m < 4; ++m) { const float* p = part + (size_t)(row0 + ai * HALF + m * 16) * 8; pa[ai][m] = *(const GAS f32x4*)p; pb[ai][m] = *(const GAS f32x4*)(p + 4); }
    asm volatile("" ::: "memory");
#pragma unroll
    for (int ai = 0; ai < 2; ++ai)
#pragma unroll
        for (int m = 0; m < 4; ++m) { const f32x4 a = pa[ai][m], b = pb[ai][m];
            rsv[ai][m] = __builtin_amdgcn_rsqf((((a.x + a.y) + (a.z + a.w)) + ((b.x + b.y) + (b.z + b.w))) * (1.0f / DM) + EPS) * scale; }
}

struct EpiZ {
    static constexpr bool PERM = true;
    bf16_t* O; const float* part; int col_base; int gates; float pre;
    __device__ __forceinline__ bool keep(const Unit&) const { return false; }
    __device__ __forceinline__ void operator()(Acc& acc, const Unit& u, int wr, int wc, int fr, int fq) const {
        const int row0 = u.pm * BM + wr * 64 + fr, col0 = col_base + u.pn * BM + wc * 64 + 8 * fq;
        const int pn = u.pn;
        const int act = gates ? 1 : ((pn == 8 || pn == 9) ? 1 : ((pn >= 10 && pn < 14) ? 2 : 0));
        float rsv[2][4]; rows_rstd(part, row0, pre, rsv);
#pragma unroll
        for (int ai = 0; ai < 2; ++ai)
#pragma unroll
            for (int m = 0; m < 4; ++m) { const int row = row0 + ai * HALF + m * 16; const int odd = fr & 1; bf16_t* rowp = O + (size_t)(row - odd) * ZP + col0 + 32 * odd;
                const float rs = rsv[ai][m]; const float nl2 = -LOG2E * rs; u32x4 wv[2];
#pragma unroll
                for (int bj = 0; bj < 2; ++bj) { f32x4 v0 = acc[ai][bj][m][0], v1 = acc[ai][bj][m][1];
                    if (act == 1) {
#pragma unroll
                        for (int j = 0; j < 4; ++j) { v0[j] = __builtin_amdgcn_rcpf(1.0f + __builtin_amdgcn_exp2f(v0[j] * nl2)); v1[j] = __builtin_amdgcn_rcpf(1.0f + __builtin_amdgcn_exp2f(v1[j] * nl2)); } }
                    else if (act == 2) {
#pragma unroll
                        for (int j = 0; j < 4; ++j) { v0[j] = gelu_tanh_f(v0[j] * rs); v1[j] = gelu_tanh_f(v1[j] * rs); } }
                    else { v0 *= rs; v1 *= rs; }
                    u32x4 w; w.x = pk2(v0[0], v0[1]); w.y = pk2(v0[2], v0[3]); w.z = pk2(v1[0], v1[1]); w.w = pk2(v1[2], v1[3]); wv[bj] = w; }
                store_pair<u32x4, 4>(rowp, rowp + ZP, odd, wv[0], wv[1]); }
    }
};
struct EpiGate8 {
    static constexpr bool PERM = true;
    unsigned char* G8; const float* part; float pre;
    __device__ __forceinline__ bool keep(const Unit&) const { return false; }
    __device__ __forceinline__ void operator()(Acc& acc, const Unit& u, int wr, int wc, int fr, int fq) const {
        const int row0 = u.pm * BM + wr * 64 + fr, col0 = u.pn * BM + wc * 64 + 8 * fq;
        float rsv[2][4]; rows_rstd(part, row0, pre, rsv);
#pragma unroll
        for (int ai = 0; ai < 2; ++ai)
#pragma unroll
            for (int m = 0; m < 4; ++m) { const int row = row0 + ai * HALF + m * 16; const int odd = fr & 1; unsigned char* rowp = G8 + (size_t)(row - odd) * (ZP * 2) + col0 + 32 * odd;
                const float nl2 = -LOG2E * rsv[ai][m]; u32x2 wv[2]; float cl = -7.98868469f; asm volatile("" : "+v"(cl));
#pragma unroll
                for (int bj = 0; bj < 2; ++bj) { const f32x4 v0 = acc[ai][bj][m][0], v1 = acc[ai][bj][m][1]; u32x2 w = (u32x2){0u, 0u};
                    typedef float f32x2_t __attribute__((ext_vector_type(2))); const f32x2_t nn = {nl2, nl2}, cc = {cl, cl};
                    const f32x2_t ta = __builtin_elementwise_fma((f32x2_t){v0[0], v0[1]}, nn, cc), tb = __builtin_elementwise_fma((f32x2_t){v0[2], v0[3]}, nn, cc), tc = __builtin_elementwise_fma((f32x2_t){v1[0], v1[1]}, nn, cc), td = __builtin_elementwise_fma((f32x2_t){v1[2], v1[3]}, nn, cc);
                    const f32x4 t0 = {ta[0], ta[1], tb[0], tb[1]}, t1 = {tc[0], tc[1], td[0], td[1]}; f32x4 e0, e1;
#pragma unroll
                    for (int j = 0; j < 4; ++j) { e0[j] = __builtin_amdgcn_exp2f(t0[j]); e1[j] = __builtin_amdgcn_exp2f(t1[j]); }
                    e0 += 1.0f / 254.0f; e1 += 1.0f / 254.0f;
#pragma unroll
                    for (int j = 0; j < 4; ++j) {
                        w.x = __builtin_amdgcn_cvt_pk_u8_f32(__builtin_amdgcn_rcpf(e0[j]), j, w.x);
                        w.y = __builtin_amdgcn_cvt_pk_u8_f32(__builtin_amdgcn_rcpf(e1[j]), j, w.y); }
                    w.x += 0x01010101u; w.y += 0x01010101u;
                    wv[bj] = w; }
                store_pair<u32x2, 2>(rowp, rowp + ZP * 2, odd, wv[0], wv[1]); }
    }
};
struct EpiLin {
    static constexpr bool PERM = true;
    bf16_t* scratch;
    __device__ __forceinline__ bool keep(const Unit&) const { return false; }
    __device__ __forceinline__ void operator()(Acc& acc, const Unit& u, int wr, int wc, int fr, int fq) const {
        bf16_t* base = scratch + (size_t)((u.pm * 52 + u.pn) & 1023) * 65536 + (size_t)((wr * 4 + wc) * 16) * 512 + (fr + 16 * fq) * 8;
#pragma unroll
        for (int ai = 0; ai < 2; ++ai)
#pragma unroll
            for (int m = 0; m < 4; ++m)
#pragma unroll
                for (int bj = 0; bj < 2; ++bj) { const f32x4 v0 = acc[ai][bj][m][0], v1 = acc[ai][bj][m][1];
                    u32x4 w; w.x = pk2(v0[0], v0[1]); w.y = pk2(v0[2], v0[3]); w.z = pk2(v1[0], v1[1]); w.w = pk2(v1[2], v1[3]);
                    *(GAS u32x4*)(base + ((ai * 4 + m) * 2 + bj) * 512) = w; }
    }
};
struct EpiNull {
    static constexpr bool PERM = true;
    __device__ __forceinline__ bool keep(const Unit&) const { return false; }
    __device__ __forceinline__ void operator()(Acc& acc, const Unit& u, int wr, int wc, int fr, int fq) const {
#pragma unroll
        for (int ai = 0; ai < 2; ++ai)
#pragma unroll
            for (int bj = 0; bj < 2; ++bj)
#pragma unroll
                for (int m = 0; m < 4; ++m)
#pragma unroll
                    for (int n = 0; n < 2; ++n) asm volatile("" :: "v"(acc[ai][bj][m][n]));
    }
};
struct EpiRelu2 {
    static constexpr bool PERM = true;
    bf16_t* O; int ldc; const float* part;
    __device__ __forceinline__ bool keep(const Unit&) const { return false; }
    __device__ __forceinline__ void operator()(Acc& acc, const Unit& u, int wr, int wc, int fr, int fq) const {
        const int row0 = u.pm * BM + wr * 64 + fr, col0 = u.pn * BM + wc * 64 + 8 * fq;
        float rsv[2][4]; rows_rstd(part, row0, 1.0f, rsv);
#pragma unroll
        for (int ai = 0; ai < 2; ++ai)
#pragma unroll
            for (int m = 0; m < 4; ++m) { const int row = row0 + ai * HALF + m * 16; const int odd = fr & 1; bf16_t* rowp = O + (size_t)(row - odd) * ldc + col0 + 32 * odd; const float rs = rsv[ai][m]; u32x4 wv[2];
#pragma unroll
                for (int bj = 0; bj < 2; ++bj) { f32x4 v0 = acc[ai][bj][m][0], v1 = acc[ai][bj][m][1];
#pragma unroll
                    for (int j = 0; j < 4; ++j) { const float a = __builtin_amdgcn_fmed3f(v0[j], 0.f, 3.0e38f) * rs, b = __builtin_amdgcn_fmed3f(v1[j], 0.f, 3.0e38f) * rs; v0[j] = a * a; v1[j] = b * b; }
                    u32x4 w; w.x = pk2(v0[0], v0[1]); w.y = pk2(v0[2], v0[3]); w.z = pk2(v1[0], v1[1]); w.w = pk2(v1[2], v1[3]); wv[bj] = w; }
                store_pair<u32x4, 4>(rowp, rowp + ldc, odd, wv[0], wv[1]); }
    }
};
struct EpiResidB {
    static constexpr bool PERM = true;
    const bf16_t* xr; bf16_t* xb; unsigned char* x8; float* part; float* outf; LAS float* red;
    __device__ __forceinline__ bool keep(const Unit&) const { return false; }
    __device__ __forceinline__ void operator()(Acc& acc, const Unit& u, int wr, int wc, int fr, int fq) const {
        const int row0 = u.pm * BM + wr * 64 + fr, col0 = u.pn * BM + wc * 64 + 8 * fq;
#pragma unroll
        for (int ai = 0; ai < 2; ++ai) {
            u32x4 rv[4][2];
#pragma unroll
            for (int m = 0; m < 4; ++m)
#pragma unroll
                for (int bj = 0; bj < 2; ++bj) rv[m][bj] = *(const GAS u32x4*)(xr + (size_t)(row0 + ai * HALF + m * 16) * DM + col0 + bj * 32);
#pragma unroll
            for (int m = 0; m < 4; ++m) { const int row = row0 + ai * HALF + m * 16; const int odd = fr & 1; const size_t off = (size_t)row * DM + col0, offp = (size_t)(row - odd) * DM + col0 + 32 * odd; float ss = 0.f;
                u32x4 wv[2]; u32x2 fv[2];
#pragma unroll
                for (int bj = 0; bj < 2; ++bj) {
                    float v[8]; unpack8(rv[m][bj], v);
#pragma unroll
                    for (int e = 0; e < 8; ++e) { v[e] += acc[ai][bj][m][e >> 2][e & 3]; ss += v[e] * v[e]; }
                    if (outf) { *(GAS f32x4*)(outf + off + bj * 32) = (f32x4){v[0], v[1], v[2], v[3]}; *(GAS f32x4*)(outf + off + bj * 32 + 4) = (f32x4){v[4], v[5], v[6], v[7]}; }
                    else { wv[bj] = pack8(v);
                        if (x8) { int t = __builtin_amdgcn_cvt_pk_fp8_f32(v[0], v[1], 0, false); t = __builtin_amdgcn_cvt_pk_fp8_f32(v[2], v[3], t, true); fv[bj].x = (unsigned)t;
                            t = __builtin_amdgcn_cvt_pk_fp8_f32(v[4], v[5], 0, false); t = __builtin_amdgcn_cvt_pk_fp8_f32(v[6], v[7], t, true); fv[bj].y = (unsigned)t; } }
                }
                if (!outf) { store_pair<u32x4, 4>(xb + offp, xb + offp + DM, odd, wv[0], wv[1]); if (x8) store_pair<u32x2, 2>(x8 + offp, x8 + offp + DM, odd, fv[0], fv[1]); }
                ss += __shfl_xor(ss, 16); ss += __shfl_xor(ss, 32);
                if (fq == 0) red[wc * 256 + ai * HALF + wr * 64 + m * 16 + fr] = ss;
            }
        }
        asm volatile("s_waitcnt lgkmcnt(0)" ::: "memory"); __builtin_amdgcn_s_barrier(); asm volatile("" ::: "memory");
        { const int t = (wr * 4 + wc) * 64 + fr + 16 * fq;
          if (t < 256 && !outf) part[(size_t)(u.pm * BM + t) * 8 + u.pn] = (red[t] + red[256 + t]) + (red[512 + t] + red[768 + t]); }
        asm volatile("s_waitcnt lgkmcnt(0)" ::: "memory"); __builtin_amdgcn_s_barrier(); asm volatile("" ::: "memory");
    }
};
struct EpiMerge {
    static constexpr bool PERM = true;
    const unsigned char* G;
    bf16_t* O;
    __device__ __forceinline__ bool keep(const Unit& u) const { return u.seg < 3; }
    __device__ __forceinline__ void operator()(Acc& acc, const Unit& u, int wr, int wc, int fr, int fq) const {
        const int row0 = u.pm * BM + wr * 64 + fr, col0 = u.pn * BM + wc * 64 + 8 * fq;
        const int seg = u.seg;
        const unsigned char* gp0 = G + (size_t)row0 * (ZP * 2) + seg * DM + col0;
        u32x2 ga[2][2][2], gb[2][2][2];
#define MG_LOAD(buf, q, TWO) do { _Pragma("unroll") for (int mm = 0; mm < 2; ++mm) _Pragma("unroll") for (int bj = 0; bj < 2; ++bj) { \
            const unsigned char* p_ = gp0 + (size_t)(((q) >> 1) * HALF + (((q) & 1) * 2 + mm) * 16) * (ZP * 2) + bj * 32; \
            ga[buf][mm][bj] = *(const GAS u32x2*)p_; if (TWO) gb[buf][mm][bj] = *(const GAS u32x2*)(p_ + DM); } } while (0)
#define MG_U8(w, e) ((float)((((e) < 4 ? (w).x : (w).y) >> (8 * ((e) & 3))) & 0xffu))
#define MG_SCALE(buf, q) do { _Pragma("unroll") for (int mm = 0; mm < 2; ++mm) _Pragma("unroll") for (int bj = 0; bj < 2; ++bj) { \
            const int ai_ = (q) >> 1, m_ = ((q) & 1) * 2 + mm; const u32x2 a_ = ga[buf][mm][bj], b_ = gb[buf][mm][bj]; \
            _Pragma("unroll") for (int e = 0; e < 8; ++e) acc[ai_][bj][m_][e >> 2][e & 3] *= MG_U8(a_, e) * __builtin_amdgcn_rcpf(MG_U8(b_, e)); } } while (0)
#define MG_STORE(buf, q) do { _Pragma("unroll") for (int mm = 0; mm < 2; ++mm) _Pragma("unroll") for (int bj = 0; bj < 2; ++bj) { \
            const int ai_ = (q) >> 1, m_ = ((q) & 1) * 2 + mm; const u32x2 a_ = ga[buf][mm][bj]; float v_[8]; \
            _Pragma("unroll") for (int e = 0; e < 8; ++e) v_[e] = acc[ai_][bj][m_][e >> 2][e & 3] * (MG_U8(a_, e) * (1.0f / 255.0f)); \
            *(GAS u32x4*)(O + (size_t)(row0 + ai_ * HALF + m_ * 16) * DM + col0 + bj * 32) = pack8(v_); } } while (0)
        if (seg < 3) {
            MG_LOAD(0, 0, true); MG_LOAD(1, 1, true); asm volatile("" ::: "memory");
            MG_SCALE(0, 0); MG_LOAD(0, 2, true); asm volatile("" ::: "memory");
            MG_SCALE(1, 1); MG_LOAD(1, 3, true); asm volatile("" ::: "memory");
            MG_SCALE(0, 2); MG_SCALE(1, 3);
        } else {
            MG_LOAD(0, 0, false); MG_LOAD(1, 1, false); asm volatile("" ::: "memory");
            MG_STORE(0, 0); MG_LOAD(0, 2, false); asm volatile("" ::: "memory");
            MG_STORE(1, 1); MG_LOAD(1, 3, false); asm volatile("" ::: "memory");
            MG_STORE(0, 2); MG_STORE(1, 3);
        }
#undef MG_SCALE
#undef MG_STORE
#undef MG_U8
#undef MG_LOAD
    }
};

template <class Epi, class Sched, bool FP8 = false>
__device__ __forceinline__ void gemm_phase(LAS unsigned char* lds, const Gemm g, const Sched& S, const Epi& E, const int tid) {
    const int wid = __builtin_amdgcn_readfirstlane(tid >> 6), lane = tid & 63, wr = wid >> 2, wc = wid & 3, fr = lane & 15, fq = lane >> 4;
    const int nt = g.Kb / 128;
    unsigned voffA[2], voffB[2];
#pragma unroll
    for (int i = 0; i < 2; ++i) { int R, C; stage_rc(tid * 16 + i * 8192, R, C); const int Rb = 64 * (R >> 5) + perm32(R & 31);
        voffA[i] = (unsigned)(R * g.lda_b + C * 2); voffB[i] = (unsigned)(Rb * g.ldb_b + C * 2); }
    const size_t kstep = (size_t)(BK * 2);
    const size_t hstepA = (size_t)HALF * g.lda_b, hstepB = (size_t)32 * g.ldb_b, tstepB = (size_t)BM * g.ldb_b;
    const unsigned ldsw = (unsigned)wid * 1024u;
    const int aoff = lds_byte(wr * 64 + fr, fq * 8), boff = lds_byte(wc * 32 + fr, fq * 8);
#define PG8_APTR(u) ((const char*)g.A + (size_t)(u).pm * 2 * hstepA + (size_t)(u).seg * g.a_seg)
#define PG8_BPTR(u) ((const char*)g.Bt + (size_t)(u).pn * tstepB + (size_t)(u).seg * g.b_seg)
#define PG8_SA(b, h) (((b) * 2 + (h)) * HTB)
#define PG8_SB(b, h) ((4 + (b) * 2 + (h)) * HTB)
#define PG8_STAGE(bufoff, gbase, voff) do { _Pragma("unroll") for (int _i = 0; _i < 2; ++_i) \
        __builtin_amdgcn_global_load_lds((const unsigned*)((const char*)(gbase) + (voff)[_i]), (LAS unsigned*)(lds + (bufoff) + ldsw + _i * 8192), 16, 0, 0); } while (0)
#define PG8_LDA(dst, b, h) do { _Pragma("unroll") for (int m = 0; m < 4; ++m) { \
        if constexpr (FP8) dst##8[m] = cat8(*(const LAS u32x4*)(lds + PG8_SA(b, h) + aoff + m * 2048), *(const LAS u32x4*)(lds + PG8_SA(b, h) + aoff + m * 2048 + 1024)); \
        else { _Pragma("unroll") for (int k = 0; k < 2; ++k) dst[m][k] = *(const LAS bf16x8*)(lds + PG8_SA(b, h) + aoff + m * 2048 + k * 1024); } } } while (0)
#define PG8_LDB(dst, b, h) do { _Pragma("unroll") for (int n = 0; n < 2; ++n) { \
        if constexpr (FP8) dst##8[n] = cat8(*(const LAS u32x4*)(lds + PG8_SB(b, h) + boff + n * 2048), *(const LAS u32x4*)(lds + PG8_SB(b, h) + boff + n * 2048 + 1024)); \
        else { _Pragma("unroll") for (int k = 0; k < 2; ++k) dst[n][k] = *(const LAS bf16x8*)(lds + PG8_SB(b, h) + boff + n * 2048 + k * 1024); } } } while (0)
#define PG8_MMA(ai, bj, At, Bt) do { __builtin_amdgcn_s_setprio(1); \
        if constexpr (FP8) { _Pragma("unroll") for (int m = 0; m < 4; ++m) _Pragma("unroll") for (int n = 0; n < 2; ++n) \
            asm volatile("v_mfma_f32_16x16x128_f8f6f4 %0, %1, %2, %0" : "+v"(acc[ai][bj][m][n]) : "v"(Bt##8[n]), "v"(At##8[m])); } \
        else { _Pragma("unroll") for (int m = 0; m < 4; ++m) _Pragma("unroll") for (int n = 0; n < 2; ++n) _Pragma("unroll") for (int k = 0; k < 2; ++k) \
            acc[ai][bj][m][n] = __builtin_amdgcn_mfma_f32_16x16x32_bf16(Bt[n][k], At[m][k], acc[ai][bj][m][n], 0, 0, 0); } \
        __builtin_amdgcn_s_setprio(0); } while (0)
#define PG8_WAIT_V(n) asm volatile("s_waitcnt vmcnt(" #n ")" ::: "memory")
#define PG8_WAIT_L(n) asm volatile("s_waitcnt lgkmcnt(" #n ")" ::: "memory")
#define PG8_BAR __builtin_amdgcn_s_barrier()
#define PG8_SCHED __builtin_amdgcn_sched_barrier(0)
    Unit cur, nxt; int ui = 0;
    if (!S.next(0, cur)) return;
    Acc acc;
#pragma unroll
    for (int a = 0; a < 2; ++a)
#pragma unroll
        for (int b = 0; b < 2; ++b)
#pragma unroll
            for (int m = 0; m < 4; ++m)
#pragma unroll
                for (int n = 0; n < 2; ++n) acc[a][b][m][n] = (f32x4){0.f, 0.f, 0.f, 0.f};
    bf16x8 At[4][2], B0[2][2], B1[2][2]; v8i_t At8[4], B08[2], B18[2];
    const char* cA = PG8_APTR(cur); const char* cB = PG8_BPTR(cur);
    PG8_STAGE(PG8_SB(0, 0), cB, voffB); PG8_STAGE(PG8_SB(0, 1), cB + hstepB, voffB); PG8_STAGE(PG8_SA(0, 0), cA, voffA); PG8_STAGE(PG8_SA(0, 1), cA + hstepA, voffA);
    if (wr == 1) PG8_BAR;
    PG8_WAIT_V(2); PG8_BAR;
    PG8_STAGE(PG8_SB(1, 0), cB + kstep, voffB); PG8_STAGE(PG8_SA(1, 0), cA + kstep, voffA); PG8_STAGE(PG8_SB(1, 1), cB + hstepB + kstep, voffB);
    PG8_WAIT_V(6); PG8_BAR;
    for (;;) {
        const bool has_next = S.next(ui + 1, nxt);
        const char* nA = has_next ? PG8_APTR(nxt) : cA; const char* nB = has_next ? PG8_BPTR(nxt) : cB;
        for (int t = 0; t < nt; t += 2) {
            const bool last = (t == nt - 2);
            const char* a1 = cA + (size_t)(t + 1) * kstep;
            const char* a2 = last ? nA : cA + (size_t)(t + 2) * kstep; const char* b2 = last ? nB : cB + (size_t)(t + 2) * kstep;
            const char* a3 = a2 + kstep; const char* b3 = b2 + kstep;
            PG8_LDB(B0, 0, 0); PG8_LDB(B1, 0, 1); PG8_SCHED; PG8_LDA(At, 0, 0); PG8_STAGE(PG8_SA(1, 1), a1 + hstepA, voffA);
            PG8_WAIT_V(8); PG8_WAIT_L(0); PG8_BAR; PG8_MMA(0, 0, At, B0); PG8_MMA(0, 1, At, B1); PG8_BAR; PG8_SCHED;
            PG8_LDA(At, 0, 1); PG8_STAGE(PG8_SB(0, 0), b2, voffB); PG8_STAGE(PG8_SB(0, 1), b2 + hstepB, voffB); PG8_STAGE(PG8_SA(0, 0), a2, voffA);
            PG8_WAIT_V(8); PG8_WAIT_L(0); PG8_BAR; PG8_MMA(1, 0, At, B0); PG8_MMA(1, 1, At, B1); PG8_BAR; PG8_SCHED;
            PG8_LDB(B0, 1, 0); PG8_LDB(B1, 1, 1); PG8_SCHED; PG8_LDA(At, 1, 0); PG8_STAGE(PG8_SA(0, 1), a2 + hstepA, voffA);
            PG8_WAIT_V(8); PG8_WAIT_L(0); PG8_BAR; PG8_MMA(0, 0, At, B0); PG8_MMA(0, 1, At, B1); PG8_BAR; PG8_SCHED;
            PG8_LDA(At, 1, 1); PG8_STAGE(PG8_SB(1, 0), b3, voffB); PG8_STAGE(PG8_SB(1, 1), b3 + hstepB, voffB); PG8_STAGE(PG8_SA(1, 0), a3, voffA);
            PG8_WAIT_V(8); PG8_WAIT_L(0); PG8_BAR; PG8_MMA(1, 0, At, B0); PG8_MMA(1, 1, At, B1); PG8_BAR; PG8_SCHED;
        }
        if (wr == 0) PG8_BAR;
        if constexpr (FP8) { asm volatile("s_nop 15\n\ts_nop 15" ::: "memory"); __builtin_amdgcn_sched_barrier(0); }
        E(acc, cur, wr, wc, fr, fq);
        if (!has_next) break;
        if (!E.keep(cur)) {
#pragma unroll
            for (int a = 0; a < 2; ++a)
#pragma unroll
                for (int b = 0; b < 2; ++b)
#pragma unroll
                    for (int m = 0; m < 4; ++m)
#pragma unroll
                        for (int n = 0; n < 2; ++n) acc[a][b][m][n] = (f32x4){0.f, 0.f, 0.f, 0.f};
        }
        cur = nxt; cA = nA; cB = nB; ++ui;
        if (wr == 1) PG8_BAR;
    }
    PG8_WAIT_V(0);
    PG8_BAR;
#undef PG8_APTR
#undef PG8_BPTR
#undef PG8_SA
#undef PG8_SB
#undef PG8_STAGE
#undef PG8_LDA
#undef PG8_LDB
#undef PG8_MMA
#undef PG8_WAIT_V
#undef PG8_WAIT_L
#undef PG8_BAR
#undef PG8_SCHED
}
}

constexpr size_t MiB = 1u << 20;
constexpr size_t WS_CTL = 0, CTL_ZERO_BYTES = 1 * MiB;
constexpr size_t WS_KSUM = 1 * MiB;
constexpr size_t WS_TAB = 1 * MiB + 512 * 1024;
constexpr size_t WS_WSB = 1 * MiB + 768 * 1024;
constexpr size_t WS_LIST = 2 * MiB;
constexpr size_t WS_LSLOT = 10 * MiB;
constexpr size_t WS_W = 16 * MiB;
constexpr size_t W_IN_OFF = 0, W_OUT_OFF = 52 * MiB, W_O_OFF = 60 * MiB, W_MI_OFF = 68 * MiB, W_MO_OFF = 100 * MiB;
constexpr size_t WS_ACTA = 148 * MiB;
constexpr size_t WS_U = 276 * MiB;
constexpr size_t WS_Z = 404 * MiB;
constexpr size_t WS_OSLOT = 1236 * MiB;
constexpr size_t WS_H8 = 1428 * MiB;
constexpr size_t WS_XB = 1492 * MiB;
constexpr size_t WS_END = 1620 * MiB;
constexpr size_t WS_PART = 12 * MiB;
constexpr size_t W_G8_OFF = 20 * MiB;
constexpr int CW_TMO = 0, CW_BAR = 4096, CW_CNT = 16384;

constexpr int MISC_OFF = 143360;
constexpr int LDS_BYTES = 147456;

#define XB_TMO      128
#define XB_XCNT(j)  (256  + 64 * (j))
#define XB_XSUB(j)  (1280 + 64 * (j))
#define XB_XGEN(j)  (2304 + 64 * (j))
#define XB_TOP      3328
#define XB_TOPGEN   3392
#define XCD_BAR_WORDS 3456
#define XB_SPIN_CAP (1u << 18)
__device__ __forceinline__ unsigned xb_ld(unsigned* p)              { return __hip_atomic_load(p, __ATOMIC_RELAXED, __HIP_MEMORY_SCOPE_AGENT); }
__device__ __forceinline__ unsigned xb_add(unsigned* p, unsigned v) { return __hip_atomic_fetch_add(p, v, __ATOMIC_RELAXED, __HIP_MEMORY_SCOPE_AGENT); }
__device__ __forceinline__ unsigned xb_xcc_id() { return (unsigned)__builtin_amdgcn_s_getreg((3 << 11) | 20) & 0xFu; }
#define XB_SPIN(cond, bar) do { unsigned _sp = 0; while (cond) { __builtin_amdgcn_s_sleep(1); \
    if ((++_sp & 255u) == 0u) { if (xb_ld(&(bar)[XB_TMO])) break; if (_sp > XB_SPIN_CAP) { atomicAdd(&(bar)[XB_TMO], 1u); break; } } } } while (0)
struct XcdBarrier { unsigned* bar; unsigned x; volatile LAS unsigned* st; };
__device__ __forceinline__ XcdBarrier xcd_barrier_post(unsigned* bar, volatile LAS unsigned* st) {
    XcdBarrier b; b.bar = bar; b.x = xb_xcc_id(); b.st = st;
    if (threadIdx.x == 0) (void)xb_add(&bar[XB_XCNT(b.x)], 1u);
    return b;
}
__device__ __forceinline__ void xcd_barrier_complete(unsigned* bar, unsigned x, unsigned& nloc, unsigned& nx) {
    const unsigned G = gridDim.x * gridDim.y * gridDim.z;
    unsigned sum, cnt, mine, sp = 0u;
    for (;;) {
        sum = 0u; cnt = 0u; mine = 0u;
#pragma unroll
        for (unsigned j = 0; j < 16; ++j) { const unsigned c = xb_ld(&bar[XB_XCNT(j)]); sum += c; cnt += (c > 0u) ? 1u : 0u; mine = (j == x) ? c : mine; }
        if (sum == G) break;
        __builtin_amdgcn_s_sleep(1);
        if ((++sp & 255u) == 0u) { if (xb_ld(&bar[XB_TMO])) break; if (sp > XB_SPIN_CAP) { atomicAdd(&bar[XB_TMO], 1u); break; } }
    }
    nloc = mine > 0u ? mine : 1u; nx = cnt > 0u ? cnt : 1u;
}
__device__ __forceinline__ void xcd_barrier(const XcdBarrier& b) {
    asm volatile("s_waitcnt vmcnt(0)" ::: "memory");
    __syncthreads();
    if (threadIdx.x == 0) {
        unsigned* bar = b.bar;
        __builtin_amdgcn_s_waitcnt(0);
        unsigned nloc = b.st[0], nx = b.st[1];
        if (nloc == 0u) { xcd_barrier_complete(bar, b.x, nloc, nx); b.st[0] = nloc; b.st[1] = nx; }
        const unsigned old = xb_add(&bar[XB_XSUB(b.x)], 1u);
        const unsigned gen = old / nloc;
        if (old + 1u == (gen + 1u) * nloc) {
            __builtin_amdgcn_fence(__ATOMIC_RELEASE, "agent");
            asm volatile("s_waitcnt vmcnt(0)" ::: "memory");
            const unsigned og = xb_add(&bar[XB_TOP], 1u);
            const unsigned tg = og / nx;
            if (og + 1u == (tg + 1u) * nx) xb_add(&bar[XB_TOPGEN], 1u);
            else XB_SPIN(xb_ld(&bar[XB_TOPGEN]) == tg, bar);
            __builtin_amdgcn_fence(__ATOMIC_ACQUIRE, "agent");
            xb_add(&bar[XB_XGEN(b.x)], 1u);
            asm volatile("s_waitcnt vmcnt(0)" ::: "memory");
        } else {
            XB_SPIN(xb_ld(&bar[XB_XGEN(b.x)]) == gen, bar);
            __builtin_amdgcn_fence(__ATOMIC_ACQUIRE, "agent");
            asm volatile("s_waitcnt vmcnt(0)" ::: "memory");
        }
    }
    __syncthreads();
}

struct Args { const float* in[23]; float* out; unsigned char* ws; };
#define LDS_WAIT() asm volatile("s_waitcnt lgkmcnt(0)" ::: "memory")

template <bool FP8>
__device__ __forceinline__ void transpose_item(const float* W, const float* gk, int K, int N, void* WTv, int n_first, LAS float* scr, int item, int lane) {
    const int nblk = N / 64, kb = item / nblk, nb = item % nblk, k0 = 64 * kb, n0 = 64 * nb;
    const int lr = lane >> 4, lc = lane & 15;
    f32x4 v[16];
#pragma unroll
    for (int i = 0; i < 16; ++i) v[i] = *(const GAS f32x4*)(W + (size_t)(k0 + 4 * i + lr) * N + n0 + 4 * lc);
#pragma unroll
    for (int i = 0; i < 16; ++i) { const int kk = 4 * i + lr; *(LAS f32x4*)(scr + kk * 68 + 4 * (lc ^ ((kk >> 3) & 7))) = v[i]; }
    LDS_WAIT(); asm volatile("" ::: "memory");
    if constexpr (!FP8) {
        bf16_t* WT = (bf16_t*)WTv; const int c = lane & 7;
        float g8[8];
#pragma unroll
        for (int e = 0; e < 8; ++e) g8[e] = gk ? gk[k0 + 8 * c + e] : 1.0f;
#pragma unroll
        for (int j = 0; j < 8; ++j) { const int n = (lane >> 3) + 8 * j; const LAS float* sp = scr + (8 * c) * 68 + 4 * ((n >> 2) ^ c) + (n & 3);
            u32x4 o; o.x = pk2(sp[0 * 68] * g8[0], sp[1 * 68] * g8[1]); o.y = pk2(sp[2 * 68] * g8[2], sp[3 * 68] * g8[3]); o.z = pk2(sp[4 * 68] * g8[4], sp[5 * 68] * g8[5]); o.w = pk2(sp[6 * 68] * g8[6], sp[7 * 68] * g8[7]);
            *(GAS u32x4*)(WT + (size_t)(n0 - n_first + n) * K + k0 + 8 * c) = o; }
    } else {
        unsigned char* W8 = (unsigned char*)WTv; const int c = lane & 3;
        float g16[16];
#pragma unroll
        for (int e = 0; e < 16; ++e) g16[e] = gk[k0 + 16 * c + e] * 64.f;
#pragma unroll
        for (int j = 0; j < 4; ++j) { const int n = (lane >> 2) + 16 * j; float t[16];
#pragma unroll
            for (int e = 0; e < 16; ++e) t[e] = scr[(16 * c + e) * 68 + 4 * ((n >> 2) ^ ((2 * c + (e >> 3)) & 7)) + (n & 3)] * g16[e];
            u32x4 o;
#pragma unroll
            for (int q = 0; q < 4; ++q) { int w = __builtin_amdgcn_cvt_pk_fp8_f32(t[4 * q], t[4 * q + 1], 0, false); w = __builtin_amdgcn_cvt_pk_fp8_f32(t[4 * q + 2], t[4 * q + 3], w, true); o[q] = (unsigned)w; }
            *(GAS u32x4*)(W8 + (size_t)(n0 - n_first + n) * K + k0 + 16 * c) = o; }
    }
    LDS_WAIT(); asm volatile("" ::: "memory");
}

__device__ __forceinline__ int rel_bucket(int n) {
    if (n < 16) return n;
    int b = 16;
    b += (n >= 22); b += (n >= 30); b += (n >= 40); b += (n >= 54); b += (n >= 73); b += (n >= 99); b += (n >= 134); b += (n >= 182);
    b += (n >= 246); b += (n >= 332); b += (n >= 450); b += (n >= 609); b += (n >= 825); b += (n >= 1117); b += (n >= 1513);
    return b;
}

__device__ __forceinline__ void x_rows_in(const float* x, bf16_t* xb, unsigned char* x8, float* part, int gw, int ngw, int lane) {
    for (int m = gw; m < MROWS; m += ngw) {
        const GAS f32x4* xr = (const GAS f32x4*)(x + (size_t)m * DM) + lane;
        f32x4 v[8]; float s = 0.f;
#pragma unroll
        for (int j = 0; j < 8; ++j) { v[j] = xr[64 * j]; s += (v[j].x * v[j].x + v[j].y * v[j].y) + (v[j].z * v[j].z + v[j].w * v[j].w); }
        s = wave_sum(s);
        GAS u32x2* o8 = (GAS u32x2*)(xb + (size_t)m * DM) + lane;
#pragma unroll
        for (int j = 0; j < 8; ++j) { u32x2 w; w.x = pk2(v[j].x, v[j].y); w.y = pk2(v[j].z, v[j].w); o8[64 * j] = w;
            int f = __builtin_amdgcn_cvt_pk_fp8_f32(v[j].x, v[j].y, 0, false); f = __builtin_amdgcn_cvt_pk_fp8_f32(v[j].z, v[j].w, f, true); *((GAS unsigned*)(x8 + (size_t)m * DM) + lane + 64 * j) = (unsigned)f; }
        if (lane < 8) part[(size_t)m * 8 + lane] = lane == 0 ? s : 0.f;
    }
}

__device__ __forceinline__ unsigned off_b(unsigned row, unsigned ch) { return 256u * row + 16u * (ch ^ (((row & 3) << 2) | ((row >> 2) & 3))); }
__device__ __forceinline__ s16x4 vtr(const LAS unsigned char* p) { typedef short v4i16_t __attribute__((ext_vector_type(4))); return __builtin_bit_cast(s16x4, __builtin_amdgcn_ds_read_tr16_b64_v4i16((LAS v4i16_t*)p)); }
__device__ __forceinline__ int crow(int r, int hi) { return (r & 3) + 8 * (r >> 2) + 4 * hi; }

__device__ __forceinline__ void store_o_bf16(bf16_t* p, const f32x16 (&o)[4], float scale, int hi) {
#pragma unroll
    for (int c = 0; c < 4; ++c)
#pragma unroll
        for (int kp = 0; kp < 2; ++kp) {
            unsigned ax = pk2(o[c][8 * kp] * scale, o[c][8 * kp + 1] * scale), ay = pk2(o[c][8 * kp + 2] * scale, o[c][8 * kp + 3] * scale);
            unsigned bx = pk2(o[c][8 * kp + 4] * scale, o[c][8 * kp + 5] * scale), by = pk2(o[c][8 * kp + 6] * scale, o[c][8 * kp + 7] * scale);
            auto r0 = __builtin_amdgcn_permlane32_swap(ax, bx, false, false); auto r1 = __builtin_amdgcn_permlane32_swap(ay, by, false, false);
            *(GAS u32x4*)(p + 32 * c + 16 * kp + 8 * hi) = (u32x4){r0[0], r1[0], r0[1], r1[1]};
        }
}
__device__ __forceinline__ void load_add_o_bf16(const bf16_t* p, f32x16 (&o)[4], int hi) {
    u32x4 L[4][2];
#pragma unroll
    for (int c = 0; c < 4; ++c)
#pragma unroll
        for (int kp = 0; kp < 2; ++kp) L[c][kp] = *(const GAS u32x4*)(p + 32 * c + 16 * kp + 8 * hi);
#pragma unroll
    for (int c = 0; c < 4; ++c)
#pragma unroll
        for (int kp = 0; kp < 2; ++kp) {
            auto r0 = __builtin_amdgcn_permlane32_swap(L[c][kp].x, L[c][kp].z, false, false); auto r1 = __builtin_amdgcn_permlane32_swap(L[c][kp].y, L[c][kp].w, false, false);
            o[c][8 * kp] += bflo(r0[0]); o[c][8 * kp + 1] += bfhi(r0[0]); o[c][8 * kp + 2] += bflo(r1[0]); o[c][8 * kp + 3] += bfhi(r1[0]);
            o[c][8 * kp + 4] += bflo(r0[1]); o[c][8 * kp + 5] += bfhi(r0[1]); o[c][8 * kp + 6] += bflo(r1[1]); o[c][8 * kp + 7] += bfhi(r1[1]);
        }
}

template <bool CAUSAL>
__device__ __forceinline__ void attn_core(const LAS unsigned char* ldsK, const LAS unsigned char* ldsV, const LAS float* tab, const bf16x8 (&qf)[8], int qrel, int ntiles, int lane, f32x16 (&o)[4], float& lsum) {
    const int r32 = lane & 31, hi = lane >> 5, blk16 = (lane >> 4) & 1, q4 = (lane & 15) >> 2, p4 = lane & 3;
    unsigned vlow[2], vc[4];
#pragma unroll
    for (int t = 0; t < 2; ++t) vlow[t] = 256u * (8 * t + 4 * hi + q4) + 16u * ((unsigned)(2 * blk16 + (p4 >> 1)) ^ (unsigned)((2 * t + hi) & 3)) + 8u * (p4 & 1);
#pragma unroll
    for (int c = 0; c < 4; ++c) vc[c] = 64u * (unsigned)(c ^ q4);
    unsigned koff[8], voff[2][4];
    unsigned vrel = (unsigned)(ldsV - ldsK); asm volatile("" : "+v"(vrel));
#pragma unroll
    for (int s = 0; s < 8; ++s) koff[s] = off_b(r32, 2 * s + hi);
#pragma unroll
    for (int t = 0; t < 2; ++t)
#pragma unroll
        for (int c = 0; c < 4; ++c) voff[t][c] = vrel + vlow[t] + vc[c];
    for (int kt = 0; kt < ntiles; ++kt) {
        const int dbase = qrel - 64 * kt - 4 * hi;
        const LAS float* tq = tab + (TREV - (dbase < 0 ? 0 : (dbase > TREV ? TREV : dbase)));
        f32x16 s0, s1;
#pragma unroll
        for (int r = 0; r < 16; ++r) { s0[r] = tq[(r & 3) + 8 * (r >> 2)]; s1[r] = tq[32 + (r & 3) + 8 * (r >> 2)]; }
        const unsigned kb = 16384u * (unsigned)kt;
        bf16x8 a0 = *(const LAS bf16x8*)(ldsK + (koff[0] + kb)), a1 = *(const LAS bf16x8*)(ldsK + (koff[0] + kb) + 8192);
#pragma unroll
        for (int s = 0; s < 8; ++s) {
            bf16x8 n0 = a0, n1 = a1;
            if (s < 7) { const LAS unsigned char* ka = ldsK + (koff[s + 1] + kb); n0 = *(const LAS bf16x8*)ka; n1 = *(const LAS bf16x8*)(ka + 8192); }
            __builtin_amdgcn_sched_barrier(0x6);
            s0 = __builtin_amdgcn_mfma_f32_32x32x16_bf16(a0, qf[s], s0, 0, 0, 0);
            s1 = __builtin_amdgcn_mfma_f32_32x32x16_bf16(a1, qf[s], s1, 0, 0, 0);
            __builtin_amdgcn_sched_barrier(0x6);
            a0 = n0; a1 = n1;
        }
#pragma unroll
        for (int r = 0; r < 16; ++r) {
            float p0 = __builtin_amdgcn_exp2f(s0[r]), p1 = __builtin_amdgcn_exp2f(s1[r]);
            if (CAUSAL) { const int e0 = (r & 3) + 8 * (r >> 2); p0 = dbase < e0 ? 0.f : p0; p1 = dbase < e0 + 32 ? 0.f : p1; }
            s0[r] = p0; s1[r] = p1;
        }
        bf16x8 pf[4];
        typedef __bf16 bf16x2_t __attribute__((ext_vector_type(2)));
        const bf16x2_t ones = __builtin_bit_cast(bf16x2_t, 0x3f803f80u);
#pragma unroll
        for (int s = 0; s < 2; ++s) {
            u32x4 w0, w1;
            w0.x = pk2(s0[8 * s + 0], s0[8 * s + 1]); w0.y = pk2(s0[8 * s + 2], s0[8 * s + 3]); w0.z = pk2(s0[8 * s + 4], s0[8 * s + 5]); w0.w = pk2(s0[8 * s + 6], s0[8 * s + 7]);
            w1.x = pk2(s1[8 * s + 0], s1[8 * s + 1]); w1.y = pk2(s1[8 * s + 2], s1[8 * s + 3]); w1.z = pk2(s1[8 * s + 4], s1[8 * s + 5]); w1.w = pk2(s1[8 * s + 6], s1[8 * s + 7]);
#pragma unroll
            for (int d = 0; d < 4; ++d) { const unsigned u0 = w0[d], u1 = w1[d];
                lsum = __builtin_amdgcn_fdot2_f32_bf16(__builtin_bit_cast(bf16x2_t, u0), ones, lsum, false); lsum = __builtin_amdgcn_fdot2_f32_bf16(__builtin_bit_cast(bf16x2_t, u1), ones, lsum, false); }
            pf[s] = __builtin_bit_cast(bf16x8, w0); pf[2 + s] = __builtin_bit_cast(bf16x8, w1);
        }
        s16x4 lo = vtr(ldsK + (voff[0][0] + kb)), hh = vtr(ldsK + (voff[1][0] + kb));
#pragma unroll
        for (int i = 0; i < 16; ++i) { const int c = i >> 2, ks = i & 3;
            s16x4 nlo = lo, nhh = hh;
            if (i < 15) { const int c2 = (i + 1) >> 2, ks2 = (i + 1) & 3; nlo = vtr(ldsK + (voff[0][c2] + kb) + 4096 * ks2); nhh = vtr(ldsK + (voff[1][c2] + kb) + 4096 * ks2); }
            __builtin_amdgcn_sched_barrier(0x6);
            const bf16x8 vf = (bf16x8){lo[0], lo[1], lo[2], lo[3], hh[0], hh[1], hh[2], hh[3]};
            o[c] = __builtin_amdgcn_mfma_f32_32x32x16_bf16(vf, pf[ks], o[c], 0, 0, 0);
            __builtin_amdgcn_sched_barrier(0x6);
            lo = nlo; hh = nhh;
        }
    }
}

__device__ __forceinline__ void load_kv(const bf16_t* Z, const float* tabg, LAS unsigned char* ldsK, LAS unsigned char* ldsV, LAS float* tab, float M2, int b, int h, int j, int tid) {
    const bf16_t* kbase = Z + (size_t)(b * SEQ + j * 256) * ZP + OFF_D + 512 + h * HD;
#pragma unroll
    for (int i = 0; i < 8; ++i) { const int idx = tid + 512 * i, row = idx >> 4, ch = idx & 15;
        const u32x4 kv = ldg16(kbase + (size_t)row * ZP + 8 * ch), vv = ldg16(kbase + (size_t)row * ZP + 512 + 8 * ch);
        *(LAS u32x4*)(ldsK + off_b(row, ch)) = kv; *(LAS u32x4*)(ldsV + off_b(row, ch)) = vv; }
    for (int i = tid; i < TABP; i += 512) { const int d = TREV - i; tab[i] = tabg[h * TABN + (d < 0 ? 0 : (d > TABN - 1 ? TABN - 1 : d))] - M2; }
}

__global__ void __launch_bounds__(512, 2) fwd(Args args) {
    extern __shared__ __attribute__((aligned(16))) unsigned char lds_raw[];
    LAS unsigned char* lds = (LAS unsigned char*)lds_raw;
    volatile LAS unsigned* MISC = (volatile LAS unsigned*)(lds + MISC_OFF);
    const int G = gridDim.x, bx = blockIdx.x;
    const int vcu = (G % 8 == 0) ? (bx % 8) * (G / 8) + bx / 8 : bx;
    const int ngw = G * 8;
    { const int tid0 = threadIdx.x; for (int u = tid0; u < (LDS_BYTES - MISC_OFF) / 4; u += 512) ((LAS unsigned*)(lds + MISC_OFF))[u] = 0u; }
    __syncthreads();
    XcdBarrier bar = xcd_barrier_post((unsigned*)(args.ws + WS_CTL) + CW_BAR, MISC + 8);
    float* xout = args.out;
#define LANE_VARS const int tid = opaque_tid(); const int lane = tid & 63; const int wave = __builtin_amdgcn_readfirstlane(tid >> 6); const int gw = vcu * 8 + wave; (void)tid; (void)lane; (void)wave; (void)gw;
#define PHASE_VARS \
    const int tid = opaque_tid(); const int lane = tid & 63; const int wave = __builtin_amdgcn_readfirstlane(tid >> 6); const int gw = vcu * 8 + wave; \
    unsigned char* ws = opaque_ptr(args.ws); unsigned* ctl = (unsigned*)(ws + WS_CTL); \
    float* ksum = (float*)(ws + WS_KSUM); float* tabg = (float*)(ws + WS_TAB); bf16_t* Wsb = (bf16_t*)(ws + WS_WSB); \
    unsigned short* lists = (unsigned short*)(ws + WS_LIST); float* lslot = (float*)(ws + WS_LSLOT); \
    bf16_t* Wt_in = (bf16_t*)(ws + WS_W + W_IN_OFF); bf16_t* Wt_out = (bf16_t*)(ws + WS_W + W_OUT_OFF); bf16_t* Wt_o = (bf16_t*)(ws + WS_W + W_O_OFF); \
    bf16_t* Wt_mi = (bf16_t*)(ws + WS_W + W_MI_OFF); bf16_t* Wt_mo = (bf16_t*)(ws + WS_W + W_MO_OFF); \
    unsigned char* h8 = ws + WS_H8; unsigned char* Wg8 = ws + WS_W + W_G8_OFF; bf16_t* xb = (bf16_t*)(ws + WS_XB); float* part = (float*)(ws + WS_PART); (void)h8; (void)Wg8; (void)xb; (void)part; \
    bf16_t* actA = (bf16_t*)(ws + WS_ACTA); bf16_t* U = (bf16_t*)(ws + WS_U); bf16_t* Z = (bf16_t*)(ws + WS_Z); float* oslot = (float*)(ws + WS_OSLOT); \
    (void)tid; (void)lane; (void)wave; (void)gw; (void)ctl; (void)ksum; (void)tabg; (void)Wsb; (void)lists; (void)lslot; (void)Wt_in; (void)Wt_out; (void)Wt_o; (void)Wt_mi; (void)Wt_mo; (void)actA; (void)U; (void)Z; (void)oslot;

    for (int l = 0; l < DEPTH; ++l) {
        if (PH_MASK & (1 << 0)) REP(0) { PHASE_VARS
            LAS float* scr = (LAS float*)(lds + wave * 17408);
            constexpr int I_IN = (DM / 64) * (ZP / 64), I_OUT1 = (512 / 64) * (DM / 64), I_O = (DM / 64) * (DM / 64), I_MI = (DM / 64) * (DFF / 64), I_MO = (DFF / 64) * (DM / 64);
            constexpr int NITEMS = I_IN + 4 * I_OUT1 + I_O + I_MI + I_MO;
            const float* w_in = args.in[3] + (size_t)l * DM * ZP;
            const float* w_oa = args.in[5] + (size_t)l * 512 * DM; const float* w_ob = args.in[10] + (size_t)l * 512 * DM;
            const float* w_oc = args.in[15] + (size_t)l * 512 * DM; const float* w_od = args.in[18] + (size_t)l * 512 * DM;
            const float* gmix = args.in[2] + (size_t)l * DM; const float* gmlp = args.in[20] + (size_t)l * DM;
            const float* w_o = args.in[19] + (size_t)l * DM * DM; const float* w_mi = args.in[21] + (size_t)l * DM * DFF; const float* w_mo = args.in[22] + (size_t)l * DFF * DM;
            for (int it = gw; it < NITEMS; it += ngw) {
                int r = it;
                if (r < I_IN) { if ((r % (ZP / 64)) < OFF_G / 64) transpose_item<false>(w_in, gmix, DM, ZP, Wt_in, 0, scr, r, lane); else transpose_item<true>(w_in, gmix, DM, ZP, Wg8, OFF_G, scr, r, lane); continue; } r -= I_IN;
                if (r < I_OUT1) { transpose_item<false>(w_oa, nullptr, 512, DM, Wt_out, 0, scr, r, lane); continue; } r -= I_OUT1;
                if (r < I_OUT1) { transpose_item<false>(w_ob, nullptr, 512, DM, Wt_out + (size_t)DM * 512, 0, scr, r, lane); continue; } r -= I_OUT1;
                if (r < I_OUT1) { transpose_item<false>(w_oc, nullptr, 512, DM, Wt_out + (size_t)2 * DM * 512, 0, scr, r, lane); continue; } r -= I_OUT1;
                if (r < I_OUT1) { transpose_item<false>(w_od, nullptr, 512, DM, Wt_out + (size_t)3 * DM * 512, 0, scr, r, lane); continue; } r -= I_OUT1;
                if (r < I_O) { transpose_item<false>(w_o, nullptr, DM, DM, Wt_o, 0, scr, r, lane); continue; } r -= I_O;
                if (r < I_MI) { transpose_item<false>(w_mi, gmlp, DM, DFF, Wt_mi, 0, scr, r, lane); continue; } r -= I_MI;
                transpose_item<false>(w_mo, nullptr, DFF, DM, Wt_mo, 0, scr, r, lane);
            }
            const float* wsp = args.in[13] + (size_t)l * 4 * 128 * 128;
            for (int e = bx * 512 + tid; e < 4 * 128 * 128; e += G * 512) { const int t = (e >> 7) & 127, s = e & 127; Wsb[e] = (bf16_t)(pk2(s <= t ? wsp[e] : 0.f, 0.f) & 0xffffu); }
            if (l == 0) for (int e = bx * 512 + tid; e < NH * TABN; e += G * 512) { const int h = e / TABN, d = e % TABN; tabg[e] = args.in[1][rel_bucket(d) * NH + h] * LOG2E; }
            if (l == 0) x_rows_in(args.in[0], xb, h8, part, gw, ngw, lane);
        }
        xcd_barrier(bar);
        if (PH_MASK & (1 << 1)) REP(1) { PHASE_VARS
            { pg8::Gemm g{xb, Wt_in, DM * 2, DM * 2, DM * 2, 0, 0}; pg8::StaticOrder<0> S; S.init(MROWS, OFF_G, G, bx);
              pg8::EpiZ E{Z, part, 0, 0, 1.0f};
              pg8::gemm_phase<pg8::EpiZ, pg8::StaticOrder<0>, false>(lds, g, S, E, tid); }
        }
        xcd_barrier(bar);
        if (PH_MASK & (1 << 2)) { PHASE_VARS
            REP(11) { LANE_VARS
                const float* cw = args.in[4] + (size_t)l * 3 * 512;
                for (int unit = vcu; unit < MROWS / 128; unit += G) {
                    const int c8 = 8 * lane;
                    float w[3][8];
#pragma unroll
                    for (int k = 0; k < 3; ++k) { const f32x4 w0 = *(const GAS f32x4*)(cw + k * 512 + c8), w1 = *(const GAS f32x4*)(cw + k * 512 + c8 + 4);
#pragma unroll
                        for (int e = 0; e < 4; ++e) { w[k][e] = w0[e]; w[k][4 + e] = w1[e]; } }
                    const int t0 = unit * 128 + wave * 16, tseq0 = t0 & (SEQ - 1);
                    float h2[8], h1[8];
                    { const int r2 = tseq0 >= 2 ? t0 - 2 : t0, r1 = tseq0 >= 1 ? t0 - 1 : t0; const float m2 = tseq0 >= 2 ? 1.f : 0.f, m1 = tseq0 >= 1 ? 1.f : 0.f;
                      float a2[8], x2[8], a1[8], x1[8];
                      unpack8(ldg16(Z + (size_t)r2 * ZP + OFF_A + 512 + c8), a2); unpack8(ldg16(Z + (size_t)r2 * ZP + OFF_A + 1024 + c8), x2);
                      unpack8(ldg16(Z + (size_t)r1 * ZP + OFF_A + 512 + c8), a1); unpack8(ldg16(Z + (size_t)r1 * ZP + OFF_A + 1024 + c8), x1);
#pragma unroll
                      for (int e = 0; e < 8; ++e) { h2[e] = a2[e] * x2[e] * m2; h1[e] = a1[e] * x1[e] * m1; } }
#pragma unroll
                    for (int gq = 0; gq < 4; ++gq) {
                        u32x4 rb[4], rc[4], rx[4];
#pragma unroll
                        for (int q = 0; q < 4; ++q) { const bf16_t* zp = Z + (size_t)(t0 + 4 * gq + q) * ZP + OFF_A + c8; rb[q] = ldg16(zp); rc[q] = ldg16(zp + 512); rx[q] = ldg16(zp + 1024); }
#pragma unroll
                        for (int q = 0; q < 4; ++q) {
                            float ab[8], ac[8], ax[8], o[8]; unpack8(rb[q], ab); unpack8(rc[q], ac); unpack8(rx[q], ax);
#pragma unroll
                            for (int e = 0; e < 8; ++e) { const float cx = ac[e] * ax[e]; o[e] = ab[e] * (w[0][e] * h2[e] + w[1][e] * h1[e] + w[2][e] * cx); h2[e] = h1[e]; h1[e] = cx; }
                            stg16(U + (size_t)(t0 + 4 * gq + q) * DM + c8, pack8(o));
                        }
                    }
                }
            }
            REP(12) { LANE_VARS
                const float* gqp = args.in[16] + (size_t)l * HD; const float* gkp = args.in[17] + (size_t)l * HD;
                float gq[8], gk[8];
#pragma unroll
                for (int e = 0; e < 8; ++e) { gq[e] = gqp[(8 * lane + e) & 127] * QSCALE; gk[e] = gkp[(8 * lane + e) & 127]; }
                LAS float* red = (LAS float*)lds;
                for (int unit = vcu; unit < MROWS / 128; unit += G) {
                    float ks[8];
#pragma unroll
                    for (int e = 0; e < 8; ++e) ks[e] = 0.f;
#pragma unroll 1
                    for (int i4 = 0; i4 < 16; i4 += 4) {
                        u32x4 rq4[4], rk4[4];
#pragma unroll
                        for (int q = 0; q < 4; ++q) { const bf16_t* qp = Z + (size_t)(unit * 128 + wave * 16 + i4 + q) * ZP + OFF_D + 8 * lane; rq4[q] = ldg16(qp); rk4[q] = ldg16(qp + 512); }
#pragma unroll
                        for (int q4 = 0; q4 < 4; ++q4) {
                            const int row = unit * 128 + wave * 16 + i4 + q4;
                            bf16_t* qp = Z + (size_t)row * ZP + OFF_D + 8 * lane; bf16_t* kp = qp + 512;
                            float q[8], k[8]; unpack8(rq4[q4], q); unpack8(rk4[q4], k);
                            float sq = 0.f, sk = 0.f;
#pragma unroll
                            for (int e = 0; e < 8; ++e) { sq += q[e] * q[e]; sk += k[e] * k[e]; }
#pragma unroll
                            for (int o = 1; o < 16; o <<= 1) { sq += __shfl_xor(sq, o); sk += __shfl_xor(sk, o); }
                            const float rq = __builtin_amdgcn_rsqf(sq * (1.f / HD) + EPS), rk = __builtin_amdgcn_rsqf(sk * (1.f / HD) + EPS);
#pragma unroll
                            for (int e = 0; e < 8; ++e) { q[e] = q[e] * rq * gq[e]; k[e] = k[e] * rk * gk[e]; ks[e] += k[e]; }
                            if (rep) { bf16_t* dq = U + (size_t)row * DM + 1536 + 8 * lane; stg16(dq, pack8(q)); stg16(dq, pack8(k)); } else { stg16(qp, pack8(q)); stg16(kp, pack8(k)); }
                        }
                    }
#pragma unroll
                    for (int e = 0; e < 8; ++e) red[wave * 512 + 8 * lane + e] = ks[e];
                    __syncthreads();
                    { float s = 0.f;
#pragma unroll
                      for (int w = 0; w < 8; ++w) s += red[w * 512 + tid];
                      (rep ? lslot : ksum)[(size_t)unit * 512 + tid] = s; }
                    __syncthreads();
                }
            }
            REP(13) { LANE_VARS
                const float* cw = args.in[6] + (size_t)l * 31 * 512; const float* cb = args.in[7] + (size_t)l * 512;
                const float* lng = args.in[8] + (size_t)l * 512; const float* lnb = args.in[9] + (size_t)l * 512;
                LAS unsigned char* P = lds;
                for (int unit = vcu; unit < MROWS / 64; unit += G) {
                    const int t0 = unit * 64, tseq0 = t0 & (SEQ - 1);
#pragma unroll 1
                    for (int i0 = 0; i0 < 12; i0 += 4) {
                        u32x4 rba[4], rsg[4];
#pragma unroll
                        for (int q = 0; q < 4; ++q) { const int idx = tid + 512 * (i0 + q), r = idx >> 6, ch = idx & 63; const bool ok = idx < 94 * 64 && (tseq0 - 30 + r >= 0);
                            const size_t grow = ok ? (size_t)(t0 - 30 + r) : (size_t)t0;
                            rba[q] = ldg16(Z + grow * ZP + OFF_B + 8 * ch); rsg[q] = ldg16(Z + grow * ZP + OFF_B + 512 + 8 * ch); }
#pragma unroll
                        for (int q = 0; q < 4; ++q) { const int idx = tid + 512 * (i0 + q), r = idx >> 6, ch = idx & 63; const bool ok = (tseq0 - 30 + r >= 0);
                            float ba[8], sg[8]; unpack8(rba[q], ba); unpack8(rsg[q], sg);
#pragma unroll
                            for (int e = 0; e < 8; ++e) ba[e] = ok ? ba[e] * sg[e] : 0.f;
                            if (idx < 94 * 64) *(LAS u32x4*)(P + r * 1024 + ch * 16) = pack8(ba); }
                    }
                    __syncthreads();
                    {
                        float w[31];
#pragma unroll
                        for (int k = 0; k < 31; ++k) w[k] = cw[k * 512 + tid];
                        const float bias = cb[tid];
                        LAS unsigned short* Pc = (LAS unsigned short*)P + tid;
                        for (int grp = 0; grp < 8; ++grp) {
                            float pv[38];
#pragma unroll
                            for (int i = 0; i < 38; ++i) pv[i] = __uint_as_float((unsigned)Pc[(grp * 8 + i) * 512] << 16);
                            float hb[8];
#pragma unroll
                            for (int o = 0; o < 8; ++o) { float a = bias;
#pragma unroll
                                for (int k = 0; k < 31; ++k) a += w[k] * pv[o + k];
                                hb[o] = a; }
#pragma unroll
                            for (int o = 0; o < 8; o += 2) { const unsigned pkd = pk2(hb[o], hb[o + 1]); Pc[(grp * 8 + o) * 512] = (unsigned short)(pkd & 0xffffu); Pc[(grp * 8 + o + 1) * 512] = (unsigned short)(pkd >> 16); }
                        }
                    }
                    __syncthreads();
                    {
                        float gg[8], bb[8];
#pragma unroll
                        for (int e = 0; e < 8; ++e) { gg[e] = lng[8 * lane + e]; bb[e] = lnb[8 * lane + e]; }
                        for (int i = 0; i < 8; ++i) {
                            const int tt = wave * 8 + i;
                            float x[8]; unpack8(*(const LAS u32x4*)(P + tt * 1024 + lane * 16), x);
                            float s1 = 0.f, s2 = 0.f;
#pragma unroll
                            for (int e = 0; e < 8; ++e) { s1 += x[e]; s2 += x[e] * x[e]; }
                            s1 = wave_sum(s1); s2 = wave_sum(s2);
                            const float mean = s1 * (1.f / 512), var = fmaxf(s2 * (1.f / 512) - mean * mean, 0.f), rstd = __builtin_amdgcn_rsqf(var + EPS);
#pragma unroll
                            for (int e = 0; e < 8; ++e) { const float y = (x[e] - mean) * rstd * gg[e] + bb[e]; x[e] = y * sigmoid_f(y); }
                            stg16(U + (size_t)(t0 + tt) * DM + 512 + 8 * lane, pack8(x));
                        }
                    }
                    __syncthreads();
                }
            }
            REP(14) { LANE_VARS
                const float* lng = args.in[11] + (size_t)l * 512; const float* lnb = args.in[12] + (size_t)l * 512;
                const float* bsp = args.in[14] + (size_t)l * 4 * 128;
                constexpr int VP = 136;
                LAS unsigned short* vvT = (LAS unsigned short*)lds;
                for (int unit = vcu; unit < MROWS / 128; unit += G) {
                    const int row0 = unit * 128;
                    {
                        float gg[8], bb[8];
#pragma unroll
                        for (int e = 0; e < 8; ++e) { gg[e] = lng[8 * lane + e]; bb[e] = lnb[8 * lane + e]; }
#pragma unroll 1
                        for (int i4 = 0; i4 < 16; i4 += 4) {
                            u32x4 rx4[4];
#pragma unroll
                            for (int q = 0; q < 4; ++q) rx4[q] = ldg16(Z + (size_t)(row0 + wave * 16 + i4 + q) * ZP + OFF_C + 512 + 8 * lane);
#pragma unroll
                            for (int q = 0; q < 4; ++q) {
                                const int t = wave * 16 + i4 + q;
                                float x[8]; unpack8(rx4[q], x);
                                float s1 = 0.f, s2 = 0.f;
#pragma unroll
                                for (int e = 0; e < 8; ++e) { s1 += x[e]; s2 += x[e] * x[e]; }
                                s1 = wave_sum(s1); s2 = wave_sum(s2);
                                const float mean = s1 * (1.f / 512), var = fmaxf(s2 * (1.f / 512) - mean * mean, 0.f), rstd = __builtin_amdgcn_rsqf(var + EPS);
#pragma unroll
                                for (int e = 0; e < 8; e += 2) {
                                    const unsigned pkd = pk2((x[e] - mean) * rstd * gg[e] + bb[e], (x[e + 1] - mean) * rstd * gg[e + 1] + bb[e + 1]);
                                    vvT[(8 * lane + e) * VP + t] = (unsigned short)(pkd & 0xffffu); vvT[(8 * lane + e + 1) * VP + t] = (unsigned short)(pkd >> 16);
                                }
                            }
                        }
                    }
                    __syncthreads();
                    {
                        const int grp = wave >> 1, th = wave & 1, l15 = lane & 15, l4 = lane >> 4;
                        bf16x8 bfr[4][4];
#pragma unroll
                        for (int tt = 0; tt < 4; ++tt)
#pragma unroll
                            for (int ks = 0; ks < 4; ++ks) bfr[tt][ks] = __builtin_bit_cast(bf16x8, ldg16(Wsb + (size_t)(grp * 128 + 64 * th + 16 * tt + l15) * 128 + 32 * ks + 8 * l4));
                        float bs4[4]; u32x2 un[4];
#pragma unroll
                        for (int tt = 0; tt < 4; ++tt) { const int t = 64 * th + 16 * tt + l15; bs4[tt] = bsp[grp * 128 + t]; un[tt] = *(const GAS u32x2*)(Z + (size_t)(row0 + t) * ZP + OFF_C + grp * 128 + 4 * l4); }
#pragma unroll
                        for (int ct = 0; ct < 8; ++ct) {
                            f32x4 acc4[4]; u32x2 uc[4];
#pragma unroll
                            for (int tt = 0; tt < 4; ++tt) { acc4[tt] = (f32x4){0.f, 0.f, 0.f, 0.f}; uc[tt] = un[tt]; }
                            if (ct < 7) {
#pragma unroll
                                for (int tt = 0; tt < 4; ++tt) { const int t = 64 * th + 16 * tt + l15; un[tt] = *(const GAS u32x2*)(Z + (size_t)(row0 + t) * ZP + OFF_C + grp * 128 + 16 * (ct + 1) + 4 * l4); } }
#pragma unroll
                            for (int ks = 0; ks < 4; ++ks) {
                                const bf16x8 a = *(const LAS bf16x8*)((const LAS unsigned char*)vvT + ((grp * 128 + 16 * ct + l15) * VP + 32 * ks + 8 * l4) * 2);
#pragma unroll
                                for (int tt = 0; tt < 4; ++tt) acc4[tt] = __builtin_amdgcn_mfma_f32_16x16x32_bf16(a, bfr[tt][ks], acc4[tt], 0, 0, 0);
                            }
                            const int c0 = grp * 128 + 16 * ct + 4 * l4;
#pragma unroll
                            for (int tt = 0; tt < 4; ++tt) {
                                const int t = 64 * th + 16 * tt + l15; const float bs = bs4[tt]; const u32x2 uw = uc[tt];
                                u32x2 ow; ow.x = pk2(bflo(uw.x) * (acc4[tt][0] + bs), bfhi(uw.x) * (acc4[tt][1] + bs)); ow.y = pk2(bflo(uw.y) * (acc4[tt][2] + bs), bfhi(uw.y) * (acc4[tt][3] + bs));
                                *(GAS u32x2*)(U + (size_t)(row0 + t) * DM + 1024 + c0) = ow;
                            }
                        }
                    }
                    __syncthreads();
                }
            }
        }
        xcd_barrier(bar);
        if (PH_MASK & (1 << 3)) REP(3) { PHASE_VARS
            LAS float* km = (LAS float*)lds;
            LAS unsigned* hist = (LAS unsigned*)(lds + 16384);
            unsigned* cntl = ctl + CW_CNT + l * 512 + (rep ? 2048 : 0);
            for (int unit0 = vcu, uk = 0; unit0 < BATCH * NH * 32; unit0 += G, ++uk) {
                const int unit = (uk & 1) ? (unit0 ^ 31) : unit0;
                const int i = unit & 31, h = (unit >> 5) & 3, b = unit >> 7;
                if (i == 0) continue;
                for (int e = tid; e < i * 128; e += 512) { const int j = e >> 7, d = e & 127; km[e] = ksum[(size_t)(b * 64 + 2 * j) * 512 + h * HD + d] + ksum[(size_t)(b * 64 + 2 * j + 1) * 512 + h * HD + d]; }
                if (tid < 96) hist[tid] = 0u;
                __syncthreads();
                const int ql = tid >> 1, half = tid & 1;
                const bf16_t* qp = Z + (size_t)(b * SEQ + i * 256 + ql) * ZP + OFF_D + h * HD + half * 64;
                float qv[64];
#pragma unroll
                for (int s = 0; s < 8; ++s) { float t8[8]; unpack8(ldg16(qp + 8 * s), t8);
#pragma unroll
                    for (int e = 0; e < 8; ++e) qv[8 * s + e] = t8[e]; }
                float v0 = -3.0e38f, v1 = -3.0e38f, v2 = -3.0e38f; int i0 = 0, i1 = 0, i2 = 0;
                for (int j = 0; j < i; ++j) {
                    const LAS f32x4* kp = (const LAS f32x4*)(km + j * 128 + half * 64);
                    float dot = 0.f;
#pragma unroll
                    for (int s = 0; s < 16; ++s) { const f32x4 kk = kp[s]; dot += qv[4 * s] * kk.x + qv[4 * s + 1] * kk.y + qv[4 * s + 2] * kk.z + qv[4 * s + 3] * kk.w; }
                    dot += __shfl_xor(dot, 1);
                    const bool g0 = dot > v0, g1 = dot > v1, g2 = dot > v2;
                    v2 = g1 ? v1 : (g2 ? dot : v2); i2 = g1 ? i1 : (g2 ? j : i2);
                    v1 = g0 ? v0 : (g1 ? dot : v1); i1 = g0 ? i0 : (g1 ? j : i1);
                    v0 = g0 ? dot : v0; i0 = g0 ? j : i0;
                }
                const int nsel = i < 3 ? i : 3;
                if (half == 0) { lds_add(&hist[i0], 1u); if (nsel > 1) lds_add(&hist[i1], 1u); if (nsel > 2) lds_add(&hist[i2], 1u); }
                __syncthreads();
                if (tid < 32) { const unsigned n = hist[tid]; if (n) hist[32 + tid] = __hip_atomic_fetch_add(cntl + (b * NH + h) * 32 + tid, n, __ATOMIC_RELAXED, __HIP_MEMORY_SCOPE_AGENT); }
                __syncthreads();
                if (half == 0) {
                    unsigned short* lb = (rep ? (unsigned short*)oslot : lists) + (size_t)((b * NH + h) * 32) * 8192;
                    const unsigned tq = (unsigned)(i * 256 + ql);
                    { const unsigned pos = hist[32 + i0] + lds_add(&hist[64 + i0], 1u); lb[(size_t)i0 * 8192 + pos] = (unsigned short)(tq); }
                    if (nsel > 1) { const unsigned pos = hist[32 + i1] + lds_add(&hist[64 + i1], 1u); lb[(size_t)i1 * 8192 + pos] = (unsigned short)(tq | (1u << 13)); }
                    if (nsel > 2) { const unsigned pos = hist[32 + i2] + lds_add(&hist[64 + i2], 1u); lb[(size_t)i2 * 8192 + pos] = (unsigned short)(tq | (2u << 13)); }
                }
                __syncthreads();
            }
        }
        xcd_barrier(bar);
        LAS unsigned char* ldsK = lds; LAS unsigned char* ldsV = lds + 65536; LAS float* tab = (LAS float*)(lds + 131072);
        LAS float* M2s = (LAS float*)(lds + 131072 + TABP * 4);
        LAS int* pre = (LAS int*)(lds + 131072 + TABP * 4 + 64);
        { LANE_VARS if (wave == 0) {
            const float* gqp = args.in[16] + (size_t)l * HD; const float* gkp = args.in[17] + (size_t)l * HD;
            const float gqm = wave_max(fmaxf(fabsf(gqp[lane]), fabsf(gqp[64 + lane]))), gkm = wave_max(fmaxf(fabsf(gkp[lane]), fabsf(gkp[64 + lane])));
#pragma unroll
            for (int h = 0; h < NH; ++h) { const float bm = wave_max(lane < 32 ? fabsf(args.in[1][lane * NH + h]) : 0.f); if (lane == 0) M2s[h] = (128.f * gqm * gkm * 0.08838834764831845f + bm) * LOG2E; }
        } }
        __syncthreads();
        if (PH_MASK & (1 << 4)) REP(4) { PHASE_VARS
            const unsigned* cntl = ctl + CW_CNT + l * 512;
            {
                const int c = (int)__hip_atomic_load(cntl + tid, __ATOMIC_RELAXED, __HIP_MEMORY_SCOPE_AGENT);
                const int nch = (c + 255) >> 8;
                int incl = nch;
#pragma unroll
                for (int o = 1; o < 64; o <<= 1) { const int t = __shfl_up(incl, o); if (lane >= o) incl += t; }
                LAS int* wtot = (LAS int*)(lds + 131072 + TABP * 4 + 32);
                if (lane == 63) wtot[wave] = incl;
                __syncthreads();
                int wbase = 0;
#pragma unroll
                for (int w = 0; w < 8; ++w) wbase += (w < wave) ? wtot[w] : 0;
                pre[tid] = wbase + incl - nch;
                if (tid == 511) pre[512] = wbase + incl;
                __syncthreads();
            }
            const int NI = pre[512];
            const int it0 = (int)(((long)vcu * NI) / G), it1 = (int)(((long)(vcu + 1) * NI) / G);
            int cur = -1;
            for (int it = it0; it < it1; ++it) {
                int lo = 0, hi2 = 511;
                while (lo < hi2) { const int mid = (lo + hi2 + 1) >> 1; if (pre[mid] <= it) lo = mid; else hi2 = mid - 1; }
                const int bhj = lo, chunk = it - pre[bhj];
                const int j = bhj & 31, h = (bhj >> 5) & 3, b = bhj >> 7;
                if (bhj != cur) { __syncthreads(); load_kv(Z, tabg, ldsK, ldsV, tab, M2s[h], b, h, j, tid); cur = bhj; __syncthreads(); }
                const int cnt = (int)__hip_atomic_load(cntl + bhj, __ATOMIC_RELAXED, __HIP_MEMORY_SCOPE_AGENT);
                const int e = chunk * 256 + wave * 32 + (lane & 31);
                const bool valid = e < cnt;
                const unsigned ent = lists[(size_t)bhj * 8192 + (valid ? e : chunk * 256)];
                const int tq = ent & 8191, rsel = ent >> 13;
                const size_t row = (size_t)b * SEQ + tq;
                bf16x8 qf[8];
                { const bf16_t* qp = Z + row * ZP + OFF_D + h * HD + 8 * (lane >> 5);
#pragma unroll
                  for (int s = 0; s < 8; ++s) qf[s] = __builtin_bit_cast(bf16x8, ldg16(qp + 16 * s)); }
                f32x16 o[4];
#pragma unroll
                for (int c = 0; c < 4; ++c)
#pragma unroll
                    for (int r = 0; r < 16; ++r) o[c][r] = 0.f;
                float lsum = 0.f;
                attn_core<false>(ldsK, ldsV, tab, qf, tq - j * 256, 4, lane, o, lsum);
                lsum += __shfl_xor(lsum, 32);
                store_o_bf16(valid ? (bf16_t*)oslot + ((size_t)rsel * MROWS + row) * 512 + h * HD : (bf16_t*)oslot + (size_t)3 * MROWS * 512 + (size_t)(tid & 63) * 128, o, 1.0f, lane >> 5);
                if (valid && lane < 32) lslot[((size_t)rsel * MROWS + row) * 4 + h] = lsum;
            }
        }
        xcd_barrier(bar);
        if (PH_MASK & (1 << 5)) REP(5) { PHASE_VARS
            for (int unit = vcu; unit < BATCH * NH * 32; unit += G) {
                const int i = unit & 31, h = (unit >> 5) & 3, b = unit >> 7;
                __syncthreads(); load_kv(Z, tabg, ldsK, ldsV, tab, M2s[h], b, h, i, tid); __syncthreads();
                const int ql = wave * 32 + (lane & 31);
                const size_t row = (size_t)b * SEQ + i * 256 + ql;
                bf16x8 qf[8];
                { const bf16_t* qp = Z + row * ZP + OFF_D + h * HD + 8 * (lane >> 5);
#pragma unroll
                  for (int s = 0; s < 8; ++s) qf[s] = __builtin_bit_cast(bf16x8, ldg16(qp + 16 * s)); }
                f32x16 o[4];
#pragma unroll
                for (int c = 0; c < 4; ++c)
#pragma unroll
                    for (int r = 0; r < 16; ++r) o[c][r] = 0.f;
                float lsum = 0.f;
                attn_core<true>(ldsK, ldsV, tab, qf, ql, (wave >> 1) + 1, lane, o, lsum);
                lsum += __shfl_xor(lsum, 32);
                const int nsel = i < 3 ? i : 3;
                for (int r = 0; r < nsel; ++r) {
                    lsum += lslot[((size_t)r * MROWS + row) * 4 + h];
                    load_add_o_bf16((const bf16_t*)oslot + ((size_t)r * MROWS + row) * 512 + h * HD, o, lane >> 5);
                }
                const float inv = 1.0f / lsum;
                store_o_bf16(U + row * DM + 1536 + h * HD, o, inv, lane >> 5);
            }
            __syncthreads();
        }
        if (PH_MASK & (1 << 1)) REP(1) { PHASE_VARS
            pg8::Gemm g{h8, Wg8, DM, DM, DM, 0, 0}; pg8::StaticOrder<0> S; S.init(MROWS, ZP - OFF_G, G, bx);
            pg8::EpiGate8 E{(unsigned char*)Z + OFF_G * 2, part, 1.0f / 64.0f};
            pg8::gemm_phase<pg8::EpiGate8, pg8::StaticOrder<0>, true>(lds, g, S, E, tid);
        }
        xcd_barrier(bar);
        if (PH_MASK & (1 << 6)) REP(6) { PHASE_VARS
            pg8::Gemm g{U, Wt_out, DM * 2, 512 * 2, 512 * 2, (size_t)512 * 2, (size_t)DM * 512 * 2}; pg8::StaticOrder<2> S; S.init(MROWS, DM, G, bx);
            pg8::EpiMerge E{(const unsigned char*)Z + OFF_G * 2, actA};
            pg8::gemm_phase<pg8::EpiMerge, pg8::StaticOrder<2>>(lds, g, S, E, tid);
        }
        xcd_barrier(bar);
        if (PH_MASK & (1 << 7)) REP(7) { PHASE_VARS const bool dry = ((DUP_MASK >> 7) & 1) && rep == 0;
            pg8::Gemm g{actA, Wt_o, DM * 2, DM * 2, DM * 2, 0, 0}; pg8::StaticOrder<0> S; S.init(MROWS, DM, G, bx);
            pg8::EpiResidB E{xb, dry ? (bf16_t*)oslot : xb, nullptr, dry ? lslot : part, nullptr, (LAS float*)(lds + 131072)};
            pg8::gemm_phase<pg8::EpiResidB, pg8::StaticOrder<0>>(lds, g, S, E, tid);
        }
        xcd_barrier(bar);
        if (PH_MASK & (1 << 9)) REP(9) { PHASE_VARS
            pg8::Gemm g{xb, Wt_mi, DM * 2, DM * 2, DM * 2, 0, 0}; pg8::StaticOrder<0> S; S.init(MROWS, DFF, G, bx);
            pg8::EpiRelu2 E{Z, DFF, part};
            pg8::gemm_phase<pg8::EpiRelu2, pg8::StaticOrder<0>>(lds, g, S, E, tid);
        }
        xcd_barrier(bar);
        if (PH_MASK & (1 << 10)) REP(10) { PHASE_VARS const bool dry = ((DUP_MASK >> 10) & 1) && rep == 0;
            pg8::Gemm g{Z, Wt_mo, DFF * 2, DFF * 2, DFF * 2, 0, 0}; pg8::StaticOrder<0> S; S.init(MROWS, DM, G, bx);
            pg8::EpiResidB E{xb, dry ? (bf16_t*)oslot : xb, dry ? (unsigned char*)oslot + 128 * MiB : h8, dry ? lslot : part, (l == DEPTH - 1 && !dry) ? xout : nullptr, (LAS float*)(lds + 131072)};
            pg8::gemm_phase<pg8::EpiResidB, pg8::StaticOrder<0>>(lds, g, S, E, tid);
        }
        xcd_barrier(bar);
    }
}

extern "C" void kernel_launch(void* const* d_in, const int* in_sizes, int n_in, void* d_out, int out_size, void* d_ws, size_t ws_size, hipStream_t stream) {
    static int grid = 0;
    if (grid == 0) {
        if (n_in != 23 || in_sizes[0] != MROWS * DM || out_size != MROWS * DM || ws_size < WS_END) {
            fprintf(stderr, "kernel_launch: unexpected shapes (n_in %d, in0 %d, out %d, ws %zu < %zu); nothing launched\n", n_in, n_in > 0 ? in_sizes[0] : -1, out_size, ws_size, (size_t)WS_END); grid = -1; return; }
        int dev = 0, cus = 0, per_cu = 0;
        if (hipGetDevice(&dev) != hipSuccess || hipDeviceGetAttribute(&cus, hipDeviceAttributeMultiprocessorCount, dev) != hipSuccess) { grid = -1; return; }
        if (hipFuncSetAttribute((const void*)fwd, hipFuncAttributeMaxDynamicSharedMemorySize, LDS_BYTES) != hipSuccess) { fprintf(stderr, "kernel_launch: hipFuncSetAttribute failed\n"); grid = -1; return; }
        if (hipOccupancyMaxActiveBlocksPerMultiprocessor(&per_cu, (const void*)fwd, 512, LDS_BYTES) != hipSuccess || per_cu < 1)
            fprintf(stderr, "kernel_launch: note: occupancy query reports %d workgroups per CU\n", per_cu);
        (void)hipGetLastError();
        grid = cus;
    }
    if (grid < 0) return;
    if (hipMemsetAsync((char*)d_ws + WS_CTL, 0, CTL_ZERO_BYTES, stream) != hipSuccess) { fprintf(stderr, "kernel_launch: memset failed\n"); return; }
    Args a{};
    for (int i = 0; i < 23; ++i) a.in[i] = (const float*)d_in[i];
    a.out = (float*)d_out; a.ws = (unsigned char*)d_ws;
    hipLaunchKernelGGL(fwd, dim3(grid), dim3(512), LDS_BYTES, stream, a);
}
```

```cpp
#include <hip/hip_runtime.h>
#include <cstdio>
#include <cstdint>

#define LAS __attribute__((address_space(3)))
#define GAS __attribute__((address_space(1)))
typedef unsigned short bf16_t;
typedef short bf16x8 __attribute__((ext_vector_type(8)));
typedef short s16x4 __attribute__((ext_vector_type(4)));
typedef float f32x4 __attribute__((ext_vector_type(4)));
typedef float f32x16 __attribute__((ext_vector_type(16)));
typedef unsigned u32x4 __attribute__((ext_vector_type(4)));
typedef unsigned u32x2 __attribute__((ext_vector_type(2)));

#ifndef PH_MASK
#define PH_MASK 0xFFFF
#endif
#ifndef DUP_MASK
#define DUP_MASK 0
#endif
#define REP(n) for (int rep = 0; rep <= ((DUP_MASK >> (n)) & 1); ++rep)
constexpr int DM = 2048, BATCH = 4, SEQ = 8192, DEPTH = 4, MROWS = BATCH * SEQ;
constexpr int OFF_A = 0, OFF_B = 1536, OFF_C = 2560, OFF_D = 3584, OFF_G = 5120, ZP = 13312;
constexpr int DFF = 8192, NH = 4, HD = 128;
constexpr float EPS = 1e-6f;
constexpr float LOG2E = 1.4426950408889634f;
constexpr float QSCALE = 0.08838834764831845f * 1.4426950408889634f;
constexpr int TABN = 1536;
constexpr int TABP = TABN + 128, TREV = TABN + 58;

__device__ __forceinline__ unsigned pk2(float lo, float hi) {
    typedef float f2_t __attribute__((ext_vector_type(2))); typedef __bf16 b2_t __attribute__((ext_vector_type(2)));
    f2_t v = {lo, hi}; b2_t b = __builtin_convertvector(v, b2_t); return __builtin_bit_cast(unsigned, b);
}
__device__ __forceinline__ float bflo(unsigned w) { return __uint_as_float(w << 16); }
__device__ __forceinline__ float bfhi(unsigned w) { return __uint_as_float(w & 0xffff0000u); }
__device__ __forceinline__ void unpack8(const u32x4 w, float (&f)[8]) {
    f[0] = bflo(w.x); f[1] = bfhi(w.x); f[2] = bflo(w.y); f[3] = bfhi(w.y); f[4] = bflo(w.z); f[5] = bfhi(w.z); f[6] = bflo(w.w); f[7] = bfhi(w.w);
}
__device__ __forceinline__ u32x4 pack8(const float (&f)[8]) { u32x4 w; w.x = pk2(f[0], f[1]); w.y = pk2(f[2], f[3]); w.z = pk2(f[4], f[5]); w.w = pk2(f[6], f[7]); return w; }
__device__ __forceinline__ float sigmoid_f(float x) { return __builtin_amdgcn_rcpf(1.0f + __builtin_amdgcn_exp2f(-x * LOG2E)); }
__device__ __forceinline__ float gelu_tanh_f(float x) {
    const float u2 = 1.5957691216057308f * (x + 0.044715f * x * x * x);
    return x * __builtin_amdgcn_rcpf(1.0f + __builtin_amdgcn_exp2f(-u2 * LOG2E));
}
__device__ __forceinline__ float wave_sum(float v) {
#pragma unroll
    for (int o = 1; o < 64; o <<= 1) v += __shfl_xor(v, o);
    return v;
}
__device__ __forceinline__ float wave_max(float v) {
#pragma unroll
    for (int o = 1; o < 64; o <<= 1) v = fmaxf(v, __shfl_xor(v, o));
    return v;
}
__device__ __forceinline__ unsigned lds_add(LAS unsigned* p, unsigned v) { return __hip_atomic_fetch_add(p, v, __ATOMIC_RELAXED, __HIP_MEMORY_SCOPE_WORKGROUP); }
__device__ __forceinline__ int opaque_tid() { int t = threadIdx.x; asm volatile("" : "+v"(t)); return t; }
__device__ __forceinline__ unsigned char* opaque_ptr(unsigned char* p) { asm volatile("" : "+s"(p)); return p; }
__device__ __forceinline__ u32x4 ldg16(const bf16_t* p) { return *(const GAS u32x4*)p; }
__device__ __forceinline__ void stg16(bf16_t* p, u32x4 v) { *(GAS u32x4*)p = v; }

namespace pg8 {
constexpr int BM = 256, BK = 64, HALF = 128, HTB = HALF * BK * 2, STAGE_BYTES = 8 * HTB, NXCD = 8, WGM = 4;
__host__ __device__ __forceinline__ int lds_byte(int r, int c) { const int st = (r >> 4) * 2 + (c >> 5), rr = r & 15, cc = c & 31, ob = rr * 64 + cc * 2; return st * 1024 + (ob ^ (((ob >> 9) & 1) << 5)); }
__host__ __device__ __forceinline__ void stage_rc(int b, int& R, int& C) { const int st = b / 1024, sb = b % 1024, swz = sb ^ (((sb >> 9) & 1) << 5); R = (st >> 1) * 16 + swz / 64; C = (st & 1) * 32 + (swz % 64) / 2; }
__host__ __device__ __forceinline__ int perm32(int rho) { const int n = rho >> 4, i = rho & 15; return 8 * (i >> 2) + 4 * n + (i & 3); }

typedef int v8i_t __attribute__((ext_vector_type(8)));
typedef v8i_t v8i_a16 __attribute__((aligned(16)));
__device__ __forceinline__ v8i_t cat8(const u32x4 a, const u32x4 b) { return (v8i_t){(int)a.x, (int)a.y, (int)a.z, (int)a.w, (int)b.x, (int)b.y, (int)b.z, (int)b.w}; }
struct Unit { int pm, pn, seg; };
struct Gemm { const void* A; const void* Bt; int lda_b, ldb_b, Kb; size_t a_seg, b_seg; };

template <int NSEG_LOG2> struct StaticOrder {
    int nM, nN, nwg, G, c;
    __device__ void init(int M, int N, int G_, int c_) { nM = M / BM; nN = N / BM; nwg = nM * nN; G = G_; c = c_; }
    __device__ bool next(int i, Unit& u) const {
        const int ti = i >> NSEG_LOG2;
        const long L = (long)ti * G + c; if (L >= nwg) return false;
        int wgid = (int)L; { const int q = nwg / NXCD, r = nwg % NXCD, xcd = wgid % NXCD, off = wgid / NXCD; wgid = (xcd < r ? xcd * (q + 1) : r * (q + 1) + (xcd - r) * q) + off; }
        const int nig = WGM * nN, gid = wgid / nig, fm = gid * WGM, gsz = (nM - fm) < WGM ? (nM - fm) : WGM;
        u.pm = fm + ((wgid % nig) % gsz); u.pn = (wgid % nig) / gsz; u.seg = i & ((1 << NSEG_LOG2) - 1); return true;
    }
};

typedef f32x4 Acc[2][2][4][2];
template <class V, int NDW> __device__ __forceinline__ void store_pair(void* pe, void* po, int odd, V w0, V w1) {
    V A, B;
#pragma unroll
    for (int d = 0; d < NDW; ++d) { const unsigned snd = odd ? w0[d] : w1[d]; const unsigned rcv = (unsigned)__builtin_amdgcn_mov_dpp((int)snd, 0xB1, 0xF, 0xF, true);
        A[d] = odd ? rcv : w0[d]; B[d] = odd ? w1[d] : rcv; }
    *(GAS V*)pe = A; *(GAS V*)po = B;
}
__device__ __forceinline__ void rows_rstd(const float* part, int row0, float scale, float (&rsv)[2][4]) {
    f32x4 pa[2][4], pb[2][4];
#pragma unroll
    for (int ai = 0; ai < 2; ++ai)
#pragma unroll
        for (int m = 0; m < 4; ++m) { const float* p = part + (size_t)(row0 + ai * HALF + m * 16) * 8; pa[ai][m] = *(const GAS f32x4*)p; pb[ai][m] = *(const GAS f32x4*)(p + 4); }
    asm volatile("" ::: "memory");
#pragma unroll
    for (int ai = 0; ai < 2; ++ai)
#pragma unroll
        for (int m = 0; m < 4; ++m) { const f32x4 a = pa[ai][m], b = pb[ai][m];
            rsv[ai][m] = __builtin_amdgcn_rsqf((((a.x + a.y) + (a.z + a.w)) + ((b.x + b.y) + (b.z + b.w))) * (1.0f / DM) + EPS) * scale; }
}

struct EpiZ {
    static constexpr bool PERM = true;
    bf16_t* O; const float* part; int col_base; int gates; float pre;
    __device__ __forceinline__ bool keep(const Unit&) const { return false; }
    __device__ __forceinline__ void operator()(Acc& acc, const Unit& u, int wr, int wc, int fr, int fq) const {
        const int row0 = u.pm * BM + wr * 64 + fr, col0 = col_base + u.pn * BM + wc * 64 + 8 * fq;
        const int pn = u.pn;
        const int act = gates ? 1 : ((pn == 8 || pn == 9) ? 1 : ((pn >= 10 && pn < 14) ? 2 : 0));
        float rsv[2][4]; rows_rstd(part, row0, pre, rsv);
#pragma unroll
        for (int ai = 0; ai < 2; ++ai)
#pragma unroll
            for (int m = 0; m < 4; ++m) { const int row = row0 + ai * HALF + m * 16; const int odd = fr & 1; bf16_t* rowp = O + (size_t)(row - odd) * ZP + col0 + 32 * odd;
                const float rs = rsv[ai][m]; const float nl2 = -LOG2E * rs; u32x4 wv[2];
#pragma unroll
                for (int bj = 0; bj < 2; ++bj) { f32x4 v0 = acc[ai][bj][m][0], v1 = acc[ai][bj][m][1];
                    if (act == 1) {
#pragma unroll
                        for (int j = 0; j < 4; ++j) { v0[j] = __builtin_amdgcn_rcpf(1.0f + __builtin_amdgcn_exp2f(v0[j] * nl2)); v1[j] = __builtin_amdgcn_rcpf(1.0f + __builtin_amdgcn_exp2f(v1[j] * nl2)); } }
                    else if (act == 2) {
#pragma unroll
                        for (int j = 0; j < 4; ++j) { v0[j] = gelu_tanh_f(v0[j] * rs); v1[j] = gelu_tanh_f(v1[j] * rs); } }
                    else { v0 *= rs; v1 *= rs; }
                    u32x4 w; w.x = pk2(v0[0], v0[1]); w.y = pk2(v0[2], v0[3]); w.z = pk2(v1[0], v1[1]); w.w = pk2(v1[2], v1[3]); wv[bj] = w; }
                store_pair<u32x4, 4>(rowp, rowp + ZP, odd, wv[0], wv[1]); }
    }
};
struct EpiGate8 {
    static constexpr bool PERM = true;
    unsigned char* G8; const float* part; float pre;
    __device__ __forceinline__ bool keep(const Unit&) const { return false; }
    __device__ __forceinline__ void operator()(Acc& acc, const Unit& u, int wr, int wc, int fr, int fq) const {
        const int row0 = u.pm * BM + wr * 64 + fr, col0 = u.pn * BM + wc * 64 + 8 * fq;
        float rsv[2][4]; rows_rstd(part, row0, pre, rsv);
#pragma unroll
        for (int ai = 0; ai < 2; ++ai)
#pragma unroll
            for (int m = 0; m < 4; ++m) { const int row = row0 + ai * HALF + m * 16; const int odd = fr & 1; unsigned char* rowp = G8 + (size_t)(row - odd) * (ZP * 2) + col0 + 32 * odd;
                const float nl2 = -LOG2E * rsv[ai][m]; u32x2 wv[2]; float cl = -7.98868469f; asm volatile("" : "+v"(cl));
#pragma unroll
                for (int bj = 0; bj < 2; ++bj) { const f32x4 v0 = acc[ai][bj][m][0], v1 = acc[ai][bj][m][1]; u32x2 w = (u32x2){0u, 0u};
                    typedef float f32x2_t __attribute__((ext_vector_type(2))); const f32x2_t nn = {nl2, nl2}, cc = {cl, cl};
                    const f32x2_t ta = __builtin_elementwise_fma((f32x2_t){v0[0], v0[1]}, nn, cc), tb = __builtin_elementwise_fma((f32x2_t){v0[2], v0[3]}, nn, cc), tc = __builtin_elementwise_fma((f32x2_t){v1[0], v1[1]}, nn, cc), td = __builtin_elementwise_fma((f32x2_t){v1[2], v1[3]}, nn, cc);
                    const f32x4 t0 = {ta[0], ta[1], tb[0], tb[1]}, t1 = {tc[0], tc[1], td[0], td[1]}; f32x4 e0, e1;
#pragma unroll
                    for (int j = 0; j < 4; ++j) { e0[j] = __builtin_amdgcn_exp2f(t0[j]); e1[j] = __builtin_amdgcn_exp2f(t1[j]); }
                    e0 += 1.0f / 254.0f; e1 += 1.0f / 254.0f;
#pragma unroll
                    for (int j = 0; j < 4; ++j) {
                        w.x = __builtin_amdgcn_cvt_pk_u8_f32(__builtin_amdgcn_rcpf(e0[j]), j, w.x);
                        w.y = __builtin_amdgcn_cvt_pk_u8_f32(__builtin_amdgcn_rcpf(e1[j]), j, w.y); }
                    w.x += 0x01010101u; w.y += 0x01010101u;
                    wv[bj] = w; }
                store_pair<u32x2, 2>(rowp, rowp + ZP * 2, odd, wv[0], wv[1]); }
    }
};
struct EpiLin {
    static constexpr bool PERM = true;
    bf16_t* scratch;
    __device__ __forceinline__ bool keep(const Unit&) const { return false; }
    __device__ __forceinline__ void operator()(Acc& acc, const Unit& u, int wr, int wc, int fr, int fq) const {
        bf16_t* base = scratch + (size_t)((u.pm * 52 + u.pn) & 1023) * 65536 + (size_t)((wr * 4 + wc) * 16) * 512 + (fr + 16 * fq) * 8;
#pragma unroll
        for (int ai = 0; ai < 2; ++ai)
#pragma unroll
            for (int m = 0; m < 4; ++m)
#pragma unroll
                for (int bj = 0; bj < 2; ++bj) { const f32x4 v0 = acc[ai][bj][m][0], v1 = acc[ai][bj][m][1];
                    u32x4 w; w.x = pk2(v0[0], v0[1]); w.y = pk2(v0[2], v0[3]); w.z = pk2(v1[0], v1[1]); w.w = pk2(v1[2], v1[3]);
                    *(GAS u32x4*)(base + ((ai * 4 + m) * 2 + bj) * 512) = w; }
    }
};
struct EpiNull {
    static constexpr bool PERM = true;
    __device__ __forceinline__ bool keep(const Unit&) const { return false; }
    __device__ __forceinline__ void operator()(Acc& acc, const Unit& u, int wr, int wc, int fr, int fq) const {
#pragma unroll
        for (int ai = 0; ai < 2; ++ai)
#pragma unroll
            for (int bj = 0; bj < 2; ++bj)
#pragma unroll
                for (int m = 0; m < 4; ++m)
#pragma unroll
                    for (int n = 0; n < 2; ++n) asm volatile("" :: "v"(acc[ai][bj][m][n]));
    }
};
struct EpiRelu2 {
    static constexpr bool PERM = true;
    bf16_t* O; int ldc; const float* part;
    __device__ __forceinline__ bool keep(const Unit&) const { return false; }
    __device__ __forceinline__ void operator()(Acc& acc, const Unit& u, int wr, int wc, int fr, int fq) const {
        const int row0 = u.pm * BM + wr * 64 + fr, col0 = u.pn * BM + wc * 64 + 8 * fq;
        float rsv[2][4]; rows_rstd(part, row0, 1.0f, rsv);
#pragma unroll
        for (int ai = 0; ai < 2; ++ai)
#pragma unroll
            for (int m = 0; m < 4; ++m) { const int row = row0 + ai * HALF + m * 16; const int odd = fr & 1; bf16_t* rowp = O + (size_t)(row - odd) * ldc + col0 + 32 * odd; const float rs = rsv[ai][m]; u32x4 wv[2];
#pragma unroll
                for (int bj = 0; bj < 2; ++bj) { f32x4 v0 = acc[ai][bj][m][0], v1 = acc[ai][bj][m][1];
#pragma unroll
                    for (int j = 0; j < 4; ++j) { const float a = __builtin_amdgcn_fmed3f(v0[j], 0.f, 3.0e38f) * rs, b = __builtin_amdgcn_fmed3f(v1[j], 0.f, 3.0e38f) * rs; v0[j] = a * a; v1[j] = b * b; }
                    u32x4 w; w.x = pk2(v0[0], v0[1]); w.y = pk2(v0[2], v0[3]); w.z = pk2(v1[0], v1[1]); w.w = pk2(v1[2], v1[3]); wv[bj] = w; }
                store_pair<u32x4, 4>(rowp, rowp + ldc, odd, wv[0], wv[1]); }
    }
};
struct EpiResidB {
    static constexpr bool PERM = true;
    const bf16_t* xr; bf16_t* xb; unsigned char* x8; float* part; float* outf; LAS float* red;
    __device__ __forceinline__ bool keep(const Unit&) const { return false; }
    __device__ __forceinline__ void operator()(Acc& acc, const Unit& u, int wr, int wc, int fr, int fq) const {
        const int row0 = u.pm * BM + wr * 64 + fr, col0 = u.pn * BM + wc * 64 + 8 * fq;
#pragma unroll
        for (int ai = 0; ai < 2; ++ai) {
            u32x4 rv[4][2];
#pragma unroll
            for (int m = 0; m < 4; ++m)
#pragma unroll
                for (int bj = 0; bj < 2; ++bj) rv[m][bj] = *(const GAS u32x4*)(xr + (size_t)(row0 + ai * HALF + m * 16) * DM + col0 + bj * 32);
#pragma unroll
            for (int m = 0; m < 4; ++m) { const int row = row0 + ai * HALF + m * 16; const int odd = fr & 1; const size_t off = (size_t)row * DM + col0, offp = (size_t)(row - odd) * DM + col0 + 32 * odd; float ss = 0.f;
                u32x4 wv[2]; u32x2 fv[2];
#pragma unroll
                for (int bj = 0; bj < 2; ++bj) {
                    float v[8]; unpack8(rv[m][bj], v);
#pragma unroll
                    for (int e = 0; e < 8; ++e) { v[e] += acc[ai][bj][m][e >> 2][e & 3]; ss += v[e] * v[e]; }
                    if (outf) { *(GAS f32x4*)(outf + off + bj * 32) = (f32x4){v[0], v[1], v[2], v[3]}; *(GAS f32x4*)(outf + off + bj * 32 + 4) = (f32x4){v[4], v[5], v[6], v[7]}; }
                    else { wv[bj] = pack8(v);
                        if (x8) { int t = __builtin_amdgcn_cvt_pk_fp8_f32(v[0], v[1], 0, false); t = __builtin_amdgcn_cvt_pk_fp8_f32(v[2], v[3], t, true); fv[bj].x = (unsigned)t;
                            t = __builtin_amdgcn_cvt_pk_fp8_f32(v[4], v[5], 0, false); t = __builtin_amdgcn_cvt_pk_fp8_f32(v[6], v[7], t, true); fv[bj].y = (unsigned)t; } }
                }
                if (!outf) { store_pair<u32x4, 4>(xb + offp, xb + offp + DM, odd, wv[0], wv[1]); if (x8) store_pair<u32x2, 2>(x8 + offp, x8 + offp + DM, odd, fv[0], fv[1]); }
                ss += __shfl_xor(ss, 16); ss += __shfl_xor(ss, 32);
                if (fq == 0) red[wc * 256 + ai * HALF + wr * 64 + m * 16 + fr] = ss;
            }
        }
        asm volatile("s_waitcnt lgkmcnt(0)" ::: "memory"); __builtin_amdgcn_s_barrier(); asm volatile("" ::: "memory");
        { const int t = (wr * 4 + wc) * 64 + fr + 16 * fq;
          if (t < 256 && !outf) part[(size_t)(u.pm * BM + t) * 8 + u.pn] = (red[t] + red[256 + t]) + (red[512 + t] + red[768 + t]); }
        asm volatile("s_waitcnt lgkmcnt(0)" ::: "memory"); __builtin_amdgcn_s_barrier(); asm volatile("" ::: "memory");
    }
};
struct EpiMerge {
    static constexpr bool PERM = true;
    const unsigned char* G;
    bf16_t* O;
    __device__ __forceinline__ bool keep(const Unit& u) const { return u.seg < 3; }
    __device__ __forceinline__ void operator()(Acc& acc, const Unit& u, int wr, int wc, int fr, int fq) const {
        const int row0 = u.pm * BM + wr * 64 + fr, col0 = u.pn * BM + wc * 64 + 8 * fq;
        const int seg = u.seg;
        const unsigned char* gp0 = G + (size_t)row0 * (ZP * 2) + seg * DM + col0;
        u32x2 ga[4][2][2], gb[4][2][2];
#define MG_LOAD(buf, q, TWO) do { _Pragma("unroll") for (int mm = 0; mm < 2; ++mm) _Pragma("unroll") for (int bj = 0; bj < 2; ++bj) { \
            const unsigned char* p_ = gp0 + (size_t)(((q) >> 1) * HALF + (((q) & 1) * 2 + mm) * 16) * (ZP * 2) + bj * 32; \
            ga[buf][mm][bj] = *(const GAS u32x2*)p_; if (TWO) gb[buf][mm][bj] = *(const GAS u32x2*)(p_ + DM); } } while (0)
#define MG_U8(w, e) ((float)((((e) < 4 ? (w).x : (w).y) >> (8 * ((e) & 3))) & 0xffu))
#define MG_SCALE(buf, q) do { _Pragma("unroll") for (int mm = 0; mm < 2; ++mm) _Pragma("unroll") for (int bj = 0; bj < 2; ++bj) { \
            const int ai_ = (q) >> 1, m_ = ((q) & 1) * 2 + mm; const u32x2 a_ = ga[buf][mm][bj], b_ = gb[buf][mm][bj]; \
            _Pragma("unroll") for (int e = 0; e < 8; ++e) acc[ai_][bj][m_][e >> 2][e & 3] *= MG_U8(a_, e) * __builtin_amdgcn_rcpf(MG_U8(b_, e)); } } while (0)
#define MG_STORE(buf, q) do { _Pragma("unroll") for (int mm = 0; mm < 2; ++mm) _Pragma("unroll") for (int bj = 0; bj < 2; ++bj) { \
            const int ai_ = (q) >> 1, m_ = ((q) & 1) * 2 + mm; const u32x2 a_ = ga[buf][mm][bj]; float v_[8]; \
            _Pragma("unroll") for (int e = 0; e < 8; ++e) v_[e] = acc[ai_][bj][m_][e >> 2][e & 3] * (MG_U8(a_, e) * (1.0f / 255.0f)); \
            *(GAS u32x4*)(O + (size_t)(row0 + ai_ * HALF + m_ * 16) * DM + col0 + bj * 32) = pack8(v_); } } while (0)
        if (seg < 3) {
            MG_LOAD(0, 0, true); MG_LOAD(1, 1, true); MG_LOAD(2, 2, true); MG_LOAD(3, 3, true); asm volatile("" ::: "memory");
            MG_SCALE(0, 0); MG_SCALE(1, 1); MG_SCALE(2, 2); MG_SCALE(3, 3);
        } else {
            MG_LOAD(0, 0, false); MG_LOAD(1, 1, false); MG_LOAD(2, 2, false); MG_LOAD(3, 3, false); asm volatile("" ::: "memory");
            MG_STORE(0, 0); MG_STORE(1, 1); MG_STORE(2, 2); MG_STORE(3, 3);
        }
#undef MG_SCALE
#undef MG_STORE
#undef MG_U8
#undef MG_LOAD
    }
};

template <class Epi, class Sched, bool FP8 = false>
__device__ __forceinline__ void gemm_phase(LAS unsigned char* lds, const Gemm g, const Sched& S, const Epi& E, const int tid) {
    const int wid = __builtin_amdgcn_readfirstlane(tid >> 6), lane = tid & 63, wr = wid >> 2, wc = wid & 3, fr = lane & 15, fq = lane >> 4;
    const int nt = g.Kb / 128;
    unsigned voffA[2], voffB[2];
#pragma unroll
    for (int i = 0; i < 2; ++i) { int R, C; stage_rc(tid * 16 + i * 8192, R, C); const int Rb = 64 * (R >> 5) + perm32(R & 31);
        voffA[i] = (unsigned)(R * g.lda_b + C * 2); voffB[i] = (unsigned)(Rb * g.ldb_b + C * 2); }
    const size_t kstep = (size_t)(BK * 2);
    const size_t hstepA = (size_t)HALF * g.lda_b, hstepB = (size_t)32 * g.ldb_b, tstepB = (size_t)BM * g.ldb_b;
    const unsigned ldsw = (unsigned)wid * 1024u;
    const int aoff = lds_byte(wr * 64 + fr, fq * 8), boff = lds_byte(wc * 32 + fr, fq * 8);
#define PG8_APTR(u) ((const char*)g.A + (size_t)(u).pm * 2 * hstepA + (size_t)(u).seg * g.a_seg)
#define PG8_BPTR(u) ((const char*)g.Bt + (size_t)(u).pn * tstepB + (size_t)(u).seg * g.b_seg)
#define PG8_SA(b, h) (((b) * 2 + (h)) * HTB)
#define PG8_SB(b, h) ((4 + (b) * 2 + (h)) * HTB)
#define PG8_STAGE(bufoff, gbase, voff) do { _Pragma("unroll") for (int _i = 0; _i < 2; ++_i) \
        __builtin_amdgcn_global_load_lds((const unsigned*)((const char*)(gbase) + (voff)[_i]), (LAS unsigned*)(lds + (bufoff) + ldsw + _i * 8192), 16, 0, 0); } while (0)
#define PG8_LDA(dst, b, h) do { _Pragma("unroll") for (int m = 0; m < 4; ++m) { \
        if constexpr (FP8) dst##8[m] = cat8(*(const LAS u32x4*)(lds + PG8_SA(b, h) + aoff + m * 2048), *(const LAS u32x4*)(lds + PG8_SA(b, h) + aoff + m * 2048 + 1024)); \
        else { _Pragma("unroll") for (int k = 0; k < 2; ++k) dst[m][k] = *(const LAS bf16x8*)(lds + PG8_SA(b, h) + aoff + m * 2048 + k * 1024); } } } while (0)
#define PG8_LDB(dst, b, h) do { _Pragma("unroll") for (int n = 0; n < 2; ++n) { \
        if constexpr (FP8) dst##8[n] = cat8(*(const LAS u32x4*)(lds + PG8_SB(b, h) + boff + n * 2048), *(const LAS u32x4*)(lds + PG8_SB(b, h) + boff + n * 2048 + 1024)); \
        else { _Pragma("unroll") for (int k = 0; k < 2; ++k) dst[n][k] = *(const LAS bf16x8*)(lds + PG8_SB(b, h) + boff + n * 2048 + k * 1024); } } } while (0)
#define PG8_MMA(ai, bj, At, Bt) do { __builtin_amdgcn_s_setprio(1); \
        if constexpr (FP8) { _Pragma("unroll") for (int m = 0; m < 4; ++m) _Pragma("unroll") for (int n = 0; n < 2; ++n) \
            asm volatile("v_mfma_f32_16x16x128_f8f6f4 %0, %1, %2, %0" : "+v"(acc[ai][bj][m][n]) : "v"(Bt##8[n]), "v"(At##8[m])); } \
        else { _Pragma("unroll") for (int m = 0; m < 4; ++m) _Pragma("unroll") for (int n = 0; n < 2; ++n) _Pragma("unroll") for (int k = 0; k < 2; ++k) \
            acc[ai][bj][m][n] = __builtin_amdgcn_mfma_f32_16x16x32_bf16(Bt[n][k], At[m][k], acc[ai][bj][m][n], 0, 0, 0); } \
        __builtin_amdgcn_s_setprio(0); } while (0)
#define PG8_WAIT_V(n) asm volatile("s_waitcnt vmcnt(" #n ")" ::: "memory")
#define PG8_WAIT_L(n) asm volatile("s_waitcnt lgkmcnt(" #n ")" ::: "memory")
#define PG8_BAR __builtin_amdgcn_s_barrier()
#define PG8_SCHED __builtin_amdgcn_sched_barrier(0)
    Unit cur, nxt; int ui = 0;
    if (!S.next(0, cur)) return;
    Acc acc;
#pragma unroll
    for (int a = 0; a < 2; ++a)
#pragma unroll
        for (int b = 0; b < 2; ++b)
#pragma unroll
            for (int m = 0; m < 4; ++m)
#pragma unroll
                for (int n = 0; n < 2; ++n) acc[a][b][m][n] = (f32x4){0.f, 0.f, 0.f, 0.f};
    bf16x8 At[4][2], B0[2][2], B1[2][2]; v8i_t At8[4], B08[2], B18[2];
    const char* cA = PG8_APTR(cur); const char* cB = PG8_BPTR(cur);
    PG8_STAGE(PG8_SB(0, 0), cB, voffB); PG8_STAGE(PG8_SB(0, 1), cB + hstepB, voffB); PG8_STAGE(PG8_SA(0, 0), cA, voffA); PG8_STAGE(PG8_SA(0, 1), cA + hstepA, voffA);
    if (wr == 1) PG8_BAR;
    PG8_WAIT_V(2); PG8_BAR;
    PG8_STAGE(PG8_SB(1, 0), cB + kstep, voffB); PG8_STAGE(PG8_SA(1, 0), cA + kstep, voffA); PG8_STAGE(PG8_SB(1, 1), cB + hstepB + kstep, voffB);
    PG8_WAIT_V(6); PG8_BAR;
    for (;;) {
        const bool has_next = S.next(ui + 1, nxt);
        const char* nA = has_next ? PG8_APTR(nxt) : cA; const char* nB = has_next ? PG8_BPTR(nxt) : cB;
        for (int t = 0; t < nt; t += 2) {
            const bool last = (t == nt - 2);
            const char* a1 = cA + (size_t)(t + 1) * kstep;
            const char* a2 = last ? nA : cA + (size_t)(t + 2) * kstep; const char* b2 = last ? nB : cB + (size_t)(t + 2) * kstep;
            const char* a3 = a2 + kstep; const char* b3 = b2 + kstep;
            PG8_LDB(B0, 0, 0); PG8_LDB(B1, 0, 1); PG8_SCHED; PG8_LDA(At, 0, 0); PG8_STAGE(PG8_SA(1, 1), a1 + hstepA, voffA);
            PG8_WAIT_V(8); PG8_WAIT_L(0); PG8_BAR; PG8_MMA(0, 0, At, B0); PG8_MMA(0, 1, At, B1); PG8_BAR; PG8_SCHED;
            PG8_LDA(At, 0, 1); PG8_STAGE(PG8_SB(0, 0), b2, voffB); PG8_STAGE(PG8_SB(0, 1), b2 + hstepB, voffB); PG8_STAGE(PG8_SA(0, 0), a2, voffA);
            PG8_WAIT_V(8); PG8_WAIT_L(0); PG8_BAR; PG8_MMA(1, 0, At, B0); PG8_MMA(1, 1, At, B1); PG8_BAR; PG8_SCHED;
            PG8_LDB(B0, 1, 0); PG8_LDB(B1, 1, 1); PG8_SCHED; PG8_LDA(At, 1, 0); PG8_STAGE(PG8_SA(0, 1), a2 + hstepA, voffA);
            PG8_WAIT_V(8); PG8_WAIT_L(0); PG8_BAR; PG8_MMA(0, 0, At, B0); PG8_MMA(0, 1, At, B1); PG8_BAR; PG8_SCHED;
            PG8_LDA(At, 1, 1); PG8_STAGE(PG8_SB(1, 0), b3, voffB); PG8_STAGE(PG8_SB(1, 1), b3 + hstepB, voffB); PG8_STAGE(PG8_SA(1, 0), a3, voffA);
            PG8_WAIT_V(8); PG8_WAIT_L(0); PG8_BAR; PG8_MMA(1, 0, At, B0); PG8_MMA(1, 1, At, B1); PG8_BAR; PG8_SCHED;
        }
        if (wr == 0) PG8_BAR;
        if constexpr (FP8) { asm volatile("s_nop 15\n\ts_nop 15" ::: "memory"); __builtin_amdgcn_sched_barrier(0); }
        E(acc, cur, wr, wc, fr, fq);
        if (!has_next) break;
        if (!E.keep(cur)) {
#pragma unroll
            for (int a = 0; a < 2; ++a)
#pragma unroll
                for (int b = 0; b < 2; ++b)
#pragma unroll
                    for (int m = 0; m < 4; ++m)
#pragma unroll
                        for (int n = 0; n < 2; ++n) acc[a][b][m][n] = (f32x4){0.f, 0.f, 0.f, 0.f};
        }
        cur = nxt; cA = nA; cB = nB; ++ui;
        if (wr == 1) PG8_BAR;
    }
    PG8_WAIT_V(0);
    PG8_BAR;
#undef PG8_APTR
#undef PG8_BPTR
#undef PG8_SA
#undef PG8_SB
#undef PG8_STAGE
#undef PG8_LDA
#undef PG8_LDB
#undef PG8_MMA
#undef PG8_WAIT_V
#undef PG8_WAIT_L
#undef PG8_BAR
#undef PG8_SCHED
}
}

constexpr size_t MiB = 1u << 20;
constexpr size_t WS_CTL = 0, CTL_ZERO_BYTES = 1 * MiB;
constexpr size_t WS_KSUM = 1 * MiB;
constexpr size_t WS_TAB = 1 * MiB + 512 * 1024;
constexpr size_t WS_WSB = 1 * MiB + 768 * 1024;
constexpr size_t WS_LIST = 2 * MiB;
constexpr size_t WS_LSLOT = 10 * MiB;
constexpr size_t WS_W = 16 * MiB;
constexpr size_t W_IN_OFF = 0, W_OUT_OFF = 52 * MiB, W_O_OFF = 60 * MiB, W_MI_OFF = 68 * MiB, W_MO_OFF = 100 * MiB;
constexpr size_t WS_ACTA = 148 * MiB;
constexpr size_t WS_U = 276 * MiB;
constexpr size_t WS_Z = 404 * MiB;
constexpr size_t WS_OSLOT = 1236 * MiB;
constexpr size_t WS_H8 = 1428 * MiB;
constexpr size_t WS_XB = 1492 * MiB;
constexpr size_t WS_END = 1620 * MiB;
constexpr size_t WS_PART = 12 * MiB;
constexpr size_t W_G8_OFF = 20 * MiB;
constexpr int CW_TMO = 0, CW_BAR = 4096, CW_CNT = 16384;

constexpr int MISC_OFF = 143360;
constexpr int LDS_BYTES = 147456;

#define XB_TMO      128
#define XB_XCNT(j)  (256  + 64 * (j))
#define XB_XSUB(j)  (1280 + 64 * (j))
#define XB_XGEN(j)  (2304 + 64 * (j))
#define XB_TOP      3328
#define XB_TOPGEN   3392
#define XCD_BAR_WORDS 3456
#define XB_SPIN_CAP (1u << 18)
__device__ __forceinline__ unsigned xb_ld(unsigned* p)              { return __hip_atomic_load(p, __ATOMIC_RELAXED, __HIP_MEMORY_SCOPE_AGENT); }
__device__ __forceinline__ unsigned xb_add(unsigned* p, unsigned v) { return __hip_atomic_fetch_add(p, v, __ATOMIC_RELAXED, __HIP_MEMORY_SCOPE_AGENT); }
__device__ __forceinline__ unsigned xb_xcc_id() { return (unsigned)__builtin_amdgcn_s_getreg((3 << 11) | 20) & 0xFu; }
#define XB_SPIN(cond, bar) do { unsigned _sp = 0; while (cond) { __builtin_amdgcn_s_sleep(1); \
    if ((++_sp & 255u) == 0u) { if (xb_ld(&(bar)[XB_TMO])) break; if (_sp > XB_SPIN_CAP) { atomicAdd(&(bar)[XB_TMO], 1u); break; } } } } while (0)
struct XcdBarrier { unsigned* bar; unsigned x; volatile LAS unsigned* st; };
__device__ __forceinline__ XcdBarrier xcd_barrier_post(unsigned* bar, volatile LAS unsigned* st) {
    XcdBarrier b; b.bar = bar; b.x = xb_xcc_id(); b.st = st;
    if (threadIdx.x == 0) (void)xb_add(&bar[XB_XCNT(b.x)], 1u);
    return b;
}
__device__ __forceinline__ void xcd_barrier_complete(unsigned* bar, unsigned x, unsigned& nloc, unsigned& nx) {
    const unsigned G = gridDim.x * gridDim.y * gridDim.z;
    unsigned sum, cnt, mine, sp = 0u;
    for (;;) {
        sum = 0u; cnt = 0u; mine = 0u;
#pragma unroll
        for (unsigned j = 0; j < 16; ++j) { const unsigned c = xb_ld(&bar[XB_XCNT(j)]); sum += c; cnt += (c > 0u) ? 1u : 0u; mine = (j == x) ? c : mine; }
        if (sum == G) break;
        __builtin_amdgcn_s_sleep(1);
        if ((++sp & 255u) == 0u) { if (xb_ld(&bar[XB_TMO])) break; if (sp > XB_SPIN_CAP) { atomicAdd(&bar[XB_TMO], 1u); break; } }
    }
    nloc = mine > 0u ? mine : 1u; nx = cnt > 0u ? cnt : 1u;
}
__device__ __forceinline__ void xcd_barrier(const XcdBarrier& b) {
    asm volatile("s_waitcnt vmcnt(0)" ::: "memory");
    __syncthreads();
    if (threadIdx.x == 0) {
        unsigned* bar = b.bar;
        __builtin_amdgcn_s_waitcnt(0);
        unsigned nloc = b.st[0], nx = b.st[1];
        if (nloc == 0u) { xcd_barrier_complete(bar, b.x, nloc, nx); b.st[0] = nloc; b.st[1] = nx; }
        const unsigned old = xb_add(&bar[XB_XSUB(b.x)], 1u);
        const unsigned gen = old / nloc;
        if (old + 1u == (gen + 1u) * nloc) {
            __builtin_amdgcn_fence(__ATOMIC_RELEASE, "agent");
            asm volatile("s_waitcnt vmcnt(0)" ::: "memory");
            const unsigned og = xb_add(&bar[XB_TOP], 1u);
            const unsigned tg = og / nx;
            if (og + 1u == (tg + 1u) * nx) xb_add(&bar[XB_TOPGEN], 1u);
            else XB_SPIN(xb_ld(&bar[XB_TOPGEN]) == tg, bar);
            __builtin_amdgcn_fence(__ATOMIC_ACQUIRE, "agent");
            xb_add(&bar[XB_XGEN(b.x)], 1u);
            asm volatile("s_waitcnt vmcnt(0)" ::: "memory");
        } else {
            XB_SPIN(xb_ld(&bar[XB_XGEN(b.x)]) == gen, bar);
            __builtin_amdgcn_fence(__ATOMIC_ACQUIRE, "agent");
            asm volatile("s_waitcnt vmcnt(0)" ::: "memory");
        }
    }
    __syncthreads();
}

struct Args { const float* in[23]; float* out; unsigned char* ws; };
#define LDS_WAIT() asm volatile("s_waitcnt lgkmcnt(0)" ::: "memory")

template <bool FP8>
__device__ __forceinline__ void transpose_item(const float* W, const float* gk, int K, int N, void* WTv, int n_first, LAS float* scr, int item, int lane) {
    const int nblk = N / 64, kb = item / nblk, nb = item % nblk, k0 = 64 * kb, n0 = 64 * nb;
    const int lr = lane >> 4, lc = lane & 15;
    f32x4 v[16];
#pragma unroll
    for (int i = 0; i < 16; ++i) v[i] = *(const GAS f32x4*)(W + (size_t)(k0 + 4 * i + lr) * N + n0 + 4 * lc);
#pragma unroll
    for (int i = 0; i < 16; ++i) { const int kk = 4 * i + lr; *(LAS f32x4*)(scr + kk * 68 + 4 * (lc ^ ((kk >> 3) & 7))) = v[i]; }
    LDS_WAIT(); asm volatile("" ::: "memory");
    if constexpr (!FP8) {
        bf16_t* WT = (bf16_t*)WTv; const int c = lane & 7;
        float g8[8];
#pragma unroll
        for (int e = 0; e < 8; ++e) g8[e] = gk ? gk[k0 + 8 * c + e] : 1.0f;
#pragma unroll
        for (int j = 0; j < 8; ++j) { const int n = (lane >> 3) + 8 * j; const LAS float* sp = scr + (8 * c) * 68 + 4 * ((n >> 2) ^ c) + (n & 3);
            u32x4 o; o.x = pk2(sp[0 * 68] * g8[0], sp[1 * 68] * g8[1]); o.y = pk2(sp[2 * 68] * g8[2], sp[3 * 68] * g8[3]); o.z = pk2(sp[4 * 68] * g8[4], sp[5 * 68] * g8[5]); o.w = pk2(sp[6 * 68] * g8[6], sp[7 * 68] * g8[7]);
            *(GAS u32x4*)(WT + (size_t)(n0 - n_first + n) * K + k0 + 8 * c) = o; }
    } else {
        unsigned char* W8 = (unsigned char*)WTv; const int c = lane & 3;
        float g16[16];
#pragma unroll
        for (int e = 0; e < 16; ++e) g16[e] = gk[k0 + 16 * c + e] * 64.f;
#pragma unroll
        for (int j = 0; j < 4; ++j) { const int n = (lane >> 2) + 16 * j; float t[16];
#pragma unroll
            for (int e = 0; e < 16; ++e) t[e] = scr[(16 * c + e) * 68 + 4 * ((n >> 2) ^ ((2 * c + (e >> 3)) & 7)) + (n & 3)] * g16[e];
            u32x4 o;
#pragma unroll
            for (int q = 0; q < 4; ++q) { int w = __builtin_amdgcn_cvt_pk_fp8_f32(t[4 * q], t[4 * q + 1], 0, false); w = __builtin_amdgcn_cvt_pk_fp8_f32(t[4 * q + 2], t[4 * q + 3], w, true); o[q] = (unsigned)w; }
            *(GAS u32x4*)(W8 + (size_t)(n0 - n_first + n) * K + k0 + 16 * c) = o; }
    }
    LDS_WAIT(); asm volatile("" ::: "memory");
}

__device__ __forceinline__ int rel_bucket(int n) {
    if (n < 16) return n;
    int b = 16;
    b += (n >= 22); b += (n >= 30); b += (n >= 40); b += (n >= 54); b += (n >= 73); b += (n >= 99); b += (n >= 134); b += (n >= 182);
    b += (n >= 246); b += (n >= 332); b += (n >= 450); b += (n >= 609); b += (n >= 825); b += (n >= 1117); b += (n >= 1513);
    return b;
}

__device__ __forceinline__ void x_rows_in(const float* x, bf16_t* xb, unsigned char* x8, float* part, int gw, int ngw, int lane) {
    for (int m = gw; m < MROWS; m += ngw) {
        const GAS f32x4* xr = (const GAS f32x4*)(x + (size_t)m * DM) + lane;
        f32x4 v[8]; float s = 0.f;
#pragma unroll
        for (int j = 0; j < 8; ++j) { v[j] = xr[64 * j]; s += (v[j].x * v[j].x + v[j].y * v[j].y) + (v[j].z * v[j].z + v[j].w * v[j].w); }
        s = wave_sum(s);
        GAS u32x2* o8 = (GAS u32x2*)(xb + (size_t)m * DM) + lane;
#pragma unroll
        for (int j = 0; j < 8; ++j) { u32x2 w; w.x = pk2(v[j].x, v[j].y); w.y = pk2(v[j].z, v[j].w); o8[64 * j] = w;
            int f = __builtin_amdgcn_cvt_pk_fp8_f32(v[j].x, v[j].y, 0, false); f = __builtin_amdgcn_cvt_pk_fp8_f32(v[j].z, v[j].w, f, true); *((GAS unsigned*)(x8 + (size_t)m * DM) + lane + 64 * j) = (unsigned)f; }
        if (lane < 8) part[(size_t)m * 8 + lane] = lane == 0 ? s : 0.f;
    }
}

__device__ __forceinline__ unsigned off_b(unsigned row, unsigned ch) { return 256u * row + 16u * (ch ^ (((row & 3) << 2) | ((row >> 2) & 3))); }
__device__ __forceinline__ s16x4 vtr(const LAS unsigned char* p) { typedef short v4i16_t __attribute__((ext_vector_type(4))); return __builtin_bit_cast(s16x4, __builtin_amdgcn_ds_read_tr16_b64_v4i16((LAS v4i16_t*)p)); }
__device__ __forceinline__ int crow(int r, int hi) { return (r & 3) + 8 * (r >> 2) + 4 * hi; }

__device__ __forceinline__ void store_o_bf16(bf16_t* p, const f32x16 (&o)[4], float scale, int hi) {
#pragma unroll
    for (int c = 0; c < 4; ++c)
#pragma unroll
        for (int kp = 0; kp < 2; ++kp) {
            unsigned ax = pk2(o[c][8 * kp] * scale, o[c][8 * kp + 1] * scale), ay = pk2(o[c][8 * kp + 2] * scale, o[c][8 * kp + 3] * scale);
            unsigned bx = pk2(o[c][8 * kp + 4] * scale, o[c][8 * kp + 5] * scale), by = pk2(o[c][8 * kp + 6] * scale, o[c][8 * kp + 7] * scale);
            auto r0 = __builtin_amdgcn_permlane32_swap(ax, bx, false, false); auto r1 = __builtin_amdgcn_permlane32_swap(ay, by, false, false);
            *(GAS u32x4*)(p + 32 * c + 16 * kp + 8 * hi) = (u32x4){r0[0], r1[0], r0[1], r1[1]};
        }
}
__device__ __forceinline__ void load_add_o_bf16(const bf16_t* p, f32x16 (&o)[4], int hi) {
    u32x4 L[4][2];
#pragma unroll
    for (int c = 0; c < 4; ++c)
#pragma unroll
        for (int kp = 0; kp < 2; ++kp) L[c][kp] = *(const GAS u32x4*)(p + 32 * c + 16 * kp + 8 * hi);
#pragma unroll
    for (int c = 0; c < 4; ++c)
#pragma unroll
        for (int kp = 0; kp < 2; ++kp) {
            auto r0 = __builtin_amdgcn_permlane32_swap(L[c][kp].x, L[c][kp].z, false, false); auto r1 = __builtin_amdgcn_permlane32_swap(L[c][kp].y, L[c][kp].w, false, false);
            o[c][8 * kp] += bflo(r0[0]); o[c][8 * kp + 1] += bfhi(r0[0]); o[c][8 * kp + 2] += bflo(r1[0]); o[c][8 * kp + 3] += bfhi(r1[0]);
            o[c][8 * kp + 4] += bflo(r0[1]); o[c][8 * kp + 5] += bfhi(r0[1]); o[c][8 * kp + 6] += bflo(r1[1]); o[c][8 * kp + 7] += bfhi(r1[1]);
        }
}

template <bool CAUSAL>
__device__ __forceinline__ void attn_core(const LAS unsigned char* ldsK, const LAS unsigned char* ldsV, const LAS float* tab, const bf16x8 (&qf)[8], int qrel, int ntiles, int lane, f32x16 (&o)[4], float& lsum) {
    const int r32 = lane & 31, hi = lane >> 5, blk16 = (lane >> 4) & 1, q4 = (lane & 15) >> 2, p4 = lane & 3;
    unsigned vlow[2], vc[4];
#pragma unroll
    for (int t = 0; t < 2; ++t) vlow[t] = 256u * (8 * t + 4 * hi + q4) + 16u * ((unsigned)(2 * blk16 + (p4 >> 1)) ^ (unsigned)((2 * t + hi) & 3)) + 8u * (p4 & 1);
#pragma unroll
    for (int c = 0; c < 4; ++c) vc[c] = 64u * (unsigned)(c ^ q4);
    unsigned koff[8], voff[2][4];
    unsigned vrel = (unsigned)(ldsV - ldsK); asm volatile("" : "+v"(vrel));
#pragma unroll
    for (int s = 0; s < 8; ++s) koff[s] = off_b(r32, 2 * s + hi);
#pragma unroll
    for (int t = 0; t < 2; ++t)
#pragma unroll
        for (int c = 0; c < 4; ++c) voff[t][c] = vrel + vlow[t] + vc[c];
    for (int kt = 0; kt < ntiles; ++kt) {
        const int dbase = qrel - 64 * kt - 4 * hi;
        const LAS float* tq = tab + (TREV - (dbase < 0 ? 0 : (dbase > TREV ? TREV : dbase)));
        f32x16 s0, s1;
#pragma unroll
        for (int r = 0; r < 16; ++r) { s0[r] = tq[(r & 3) + 8 * (r >> 2)]; s1[r] = tq[32 + (r & 3) + 8 * (r >> 2)]; }
        const unsigned kb = 16384u * (unsigned)kt;
        bf16x8 a0 = *(const LAS bf16x8*)(ldsK + (koff[0] + kb)), a1 = *(const LAS bf16x8*)(ldsK + (koff[0] + kb) + 8192);
#pragma unroll
        for (int s = 0; s < 8; ++s) {
            bf16x8 n0 = a0, n1 = a1;
            if (s < 7) { const LAS unsigned char* ka = ldsK + (koff[s + 1] + kb); n0 = *(const LAS bf16x8*)ka; n1 = *(const LAS bf16x8*)(ka + 8192); }
            __builtin_amdgcn_sched_barrier(0x6);
            s0 = __builtin_amdgcn_mfma_f32_32x32x16_bf16(a0, qf[s], s0, 0, 0, 0);
            s1 = __builtin_amdgcn_mfma_f32_32x32x16_bf16(a1, qf[s], s1, 0, 0, 0);
            __builtin_amdgcn_sched_barrier(0x6);
            a0 = n0; a1 = n1;
        }
#pragma unroll
        for (int r = 0; r < 16; ++r) {
            float p0 = __builtin_amdgcn_exp2f(s0[r]), p1 = __builtin_amdgcn_exp2f(s1[r]);
            if (CAUSAL) { const int e0 = (r & 3) + 8 * (r >> 2); p0 = dbase < e0 ? 0.f : p0; p1 = dbase < e0 + 32 ? 0.f : p1; }
            s0[r] = p0; s1[r] = p1;
        }
        bf16x8 pf[4];
        typedef __bf16 bf16x2_t __attribute__((ext_vector_type(2)));
        const bf16x2_t ones = __builtin_bit_cast(bf16x2_t, 0x3f803f80u);
#pragma unroll
        for (int s = 0; s < 2; ++s) {
            u32x4 w0, w1;
            w0.x = pk2(s0[8 * s + 0], s0[8 * s + 1]); w0.y = pk2(s0[8 * s + 2], s0[8 * s + 3]); w0.z = pk2(s0[8 * s + 4], s0[8 * s + 5]); w0.w = pk2(s0[8 * s + 6], s0[8 * s + 7]);
            w1.x = pk2(s1[8 * s + 0], s1[8 * s + 1]); w1.y = pk2(s1[8 * s + 2], s1[8 * s + 3]); w1.z = pk2(s1[8 * s + 4], s1[8 * s + 5]); w1.w = pk2(s1[8 * s + 6], s1[8 * s + 7]);
#pragma unroll
            for (int d = 0; d < 4; ++d) { const unsigned u0 = w0[d], u1 = w1[d];
                lsum = __builtin_amdgcn_fdot2_f32_bf16(__builtin_bit_cast(bf16x2_t, u0), ones, lsum, false); lsum = __builtin_amdgcn_fdot2_f32_bf16(__builtin_bit_cast(bf16x2_t, u1), ones, lsum, false); }
            pf[s] = __builtin_bit_cast(bf16x8, w0); pf[2 + s] = __builtin_bit_cast(bf16x8, w1);
        }
        s16x4 lo = vtr(ldsK + (voff[0][0] + kb)), hh = vtr(ldsK + (voff[1][0] + kb));
#pragma unroll
        for (int i = 0; i < 16; ++i) { const int c = i >> 2, ks = i & 3;
            s16x4 nlo = lo, nhh = hh;
            if (i < 15) { const int c2 = (i + 1) >> 2, ks2 = (i + 1) & 3; nlo = vtr(ldsK + (voff[0][c2] + kb) + 4096 * ks2); nhh = vtr(ldsK + (voff[1][c2] + kb) + 4096 * ks2); }
            __builtin_amdgcn_sched_barrier(0x6);
            const bf16x8 vf = (bf16x8){lo[0], lo[1], lo[2], lo[3], hh[0], hh[1], hh[2], hh[3]};
            o[c] = __builtin_amdgcn_mfma_f32_32x32x16_bf16(vf, pf[ks], o[c], 0, 0, 0);
            __builtin_amdgcn_sched_barrier(0x6);
            lo = nlo; hh = nhh;
        }
    }
}

__device__ __forceinline__ void load_kv(const bf16_t* Z, const float* tabg, LAS unsigned char* ldsK, LAS unsigned char* ldsV, LAS float* tab, float M2, int b, int h, int j, int tid) {
    const bf16_t* kbase = Z + (size_t)(b * SEQ + j * 256) * ZP + OFF_D + 512 + h * HD;
#pragma unroll
    for (int i = 0; i < 8; ++i) { const int idx = tid + 512 * i, row = idx >> 4, ch = idx & 15;
        const u32x4 kv = ldg16(kbase + (size_t)row * ZP + 8 * ch), vv = ldg16(kbase + (size_t)row * ZP + 512 + 8 * ch);
        *(LAS u32x4*)(ldsK + off_b(row, ch)) = kv; *(LAS u32x4*)(ldsV + off_b(row, ch)) = vv; }
    for (int i = tid; i < TABP; i += 512) { const int d = TREV - i; tab[i] = tabg[h * TABN + (d < 0 ? 0 : (d > TABN - 1 ? TABN - 1 : d))] - M2; }
}

__global__ void __launch_bounds__(512, 2) fwd(Args args) {
    extern __shared__ __attribute__((aligned(16))) unsigned char lds_raw[];
    LAS unsigned char* lds = (LAS unsigned char*)lds_raw;
    volatile LAS unsigned* MISC = (volatile LAS unsigned*)(lds + MISC_OFF);
    const int G = gridDim.x, bx = blockIdx.x;
    const int vcu = (G % 8 == 0) ? (bx % 8) * (G / 8) + bx / 8 : bx;
    const int ngw = G * 8;
    { const int tid0 = threadIdx.x; for (int u = tid0; u < (LDS_BYTES - MISC_OFF) / 4; u += 512) ((LAS unsigned*)(lds + MISC_OFF))[u] = 0u; }
    __syncthreads();
    XcdBarrier bar = xcd_barrier_post((unsigned*)(args.ws + WS_CTL) + CW_BAR, MISC + 8);
    float* xout = args.out;
#define LANE_VARS const int tid = opaque_tid(); const int lane = tid & 63; const int wave = __builtin_amdgcn_readfirstlane(tid >> 6); const int gw = vcu * 8 + wave; (void)tid; (void)lane; (void)wave; (void)gw;
#define PHASE_VARS \
    const int tid = opaque_tid(); const int lane = tid & 63; const int wave = __builtin_amdgcn_readfirstlane(tid >> 6); const int gw = vcu * 8 + wave; \
    unsigned char* ws = opaque_ptr(args.ws); unsigned* ctl = (unsigned*)(ws + WS_CTL); \
    float* ksum = (float*)(ws + WS_KSUM); float* tabg = (float*)(ws + WS_TAB); bf16_t* Wsb = (bf16_t*)(ws + WS_WSB); \
    unsigned short* lists = (unsigned short*)(ws + WS_LIST); float* lslot = (float*)(ws + WS_LSLOT); \
    bf16_t* Wt_in = (bf16_t*)(ws + WS_W + W_IN_OFF); bf16_t* Wt_out = (bf16_t*)(ws + WS_W + W_OUT_OFF); bf16_t* Wt_o = (bf16_t*)(ws + WS_W + W_O_OFF); \
    bf16_t* Wt_mi = (bf16_t*)(ws + WS_W + W_MI_OFF); bf16_t* Wt_mo = (bf16_t*)(ws + WS_W + W_MO_OFF); \
    unsigned char* h8 = ws + WS_H8; unsigned char* Wg8 = ws + WS_W + W_G8_OFF; bf16_t* xb = (bf16_t*)(ws + WS_XB); float* part = (float*)(ws + WS_PART); (void)h8; (void)Wg8; (void)xb; (void)part; \
    bf16_t* actA = (bf16_t*)(ws + WS_ACTA); bf16_t* U = (bf16_t*)(ws + WS_U); bf16_t* Z = (bf16_t*)(ws + WS_Z); float* oslot = (float*)(ws + WS_OSLOT); \
    (void)tid; (void)lane; (void)wave; (void)gw; (void)ctl; (void)ksum; (void)tabg; (void)Wsb; (void)lists; (void)lslot; (void)Wt_in; (void)Wt_out; (void)Wt_o; (void)Wt_mi; (void)Wt_mo; (void)actA; (void)U; (void)Z; (void)oslot;

    for (int l = 0; l < DEPTH; ++l) {
        if (PH_MASK & (1 << 0)) REP(0) { PHASE_VARS
            LAS float* scr = (LAS float*)(lds + wave * 17408);
            constexpr int I_IN = (DM / 64) * (ZP / 64), I_OUT1 = (512 / 64) * (DM / 64), I_O = (DM / 64) * (DM / 64), I_MI = (DM / 64) * (DFF / 64), I_MO = (DFF / 64) * (DM / 64);
            constexpr int NITEMS = I_IN + 4 * I_OUT1 + I_O + I_MI + I_MO;
            const float* w_in = args.in[3] + (size_t)l * DM * ZP;
            const float* w_oa = args.in[5] + (size_t)l * 512 * DM; const float* w_ob = args.in[10] + (size_t)l * 512 * DM;
            const float* w_oc = args.in[15] + (size_t)l * 512 * DM; const float* w_od = args.in[18] + (size_t)l * 512 * DM;
            const float* gmix = args.in[2] + (size_t)l * DM; const float* gmlp = args.in[20] + (size_t)l * DM;
            const float* w_o = args.in[19] + (size_t)l * DM * DM; const float* w_mi = args.in[21] + (size_t)l * DM * DFF; const float* w_mo = args.in[22] + (size_t)l * DFF * DM;
            for (int it = gw; it < NITEMS; it += ngw) {
                int r = it;
                if (r < I_IN) { if ((r % (ZP / 64)) < OFF_G / 64) transpose_item<false>(w_in, gmix, DM, ZP, Wt_in, 0, scr, r, lane); else transpose_item<true>(w_in, gmix, DM, ZP, Wg8, OFF_G, scr, r, lane); continue; } r -= I_IN;
                if (r < I_OUT1) { transpose_item<false>(w_oa, nullptr, 512, DM, Wt_out, 0, scr, r, lane); continue; } r -= I_OUT1;
                if (r < I_OUT1) { transpose_item<false>(w_ob, nullptr, 512, DM, Wt_out + (size_t)DM * 512, 0, scr, r, lane); continue; } r -= I_OUT1;
                if (r < I_OUT1) { transpose_item<false>(w_oc, nullptr, 512, DM, Wt_out + (size_t)2 * DM * 512, 0, scr, r, lane); continue; } r -= I_OUT1;
                if (r < I_OUT1) { transpose_item<false>(w_od, nullptr, 512, DM, Wt_out + (size_t)3 * DM * 512, 0, scr, r, lane); continue; } r -= I_OUT1;
                if (r < I_O) { transpose_item<false>(w_o, nullptr, DM, DM, Wt_o, 0, scr, r, lane); continue; } r -= I_O;
                if (r < I_MI) { transpose_item<false>(w_mi, gmlp, DM, DFF, Wt_mi, 0, scr, r, lane); continue; } r -= I_MI;
                transpose_item<false>(w_mo, nullptr, DFF, DM, Wt_mo, 0, scr, r, lane);
            }
            const float* wsp = args.in[13] + (size_t)l * 4 * 128 * 128;
            for (int e = bx * 512 + tid; e < 4 * 128 * 128; e += G * 512) { const int t = (e >> 7) & 127, s = e & 127; Wsb[e] = (bf16_t)(pk2(s <= t ? wsp[e] : 0.f, 0.f) & 0xffffu); }
            if (l == 0) for (int e = bx * 512 + tid; e < NH * TABN; e += G * 512) { const int h = e / TABN, d = e % TABN; tabg[e] = args.in[1][rel_bucket(d) * NH + h] * LOG2E; }
            if (l == 0) x_rows_in(args.in[0], xb, h8, part, gw, ngw, lane);
        }
        xcd_barrier(bar);
        if (PH_MASK & (1 << 1)) REP(1) { PHASE_VARS
            { pg8::Gemm g{xb, Wt_in, DM * 2, DM * 2, DM * 2, 0, 0}; pg8::StaticOrder<0> S; S.init(MROWS, OFF_G, G, bx);
              pg8::EpiZ E{Z, part, 0, 0, 1.0f};
              pg8::gemm_phase<pg8::EpiZ, pg8::StaticOrder<0>, false>(lds, g, S, E, tid); }
        }
        xcd_barrier(bar);
        if (PH_MASK & (1 << 2)) { PHASE_VARS
            REP(11) { LANE_VARS
                const float* cw = args.in[4] + (size_t)l * 3 * 512;
                for (int unit = vcu; unit < MROWS / 128; unit += G) {
                    const int c8 = 8 * lane;
                    float w[3][8];
#pragma unroll
                    for (int k = 0; k < 3; ++k) { const f32x4 w0 = *(const GAS f32x4*)(cw + k * 512 + c8), w1 = *(const GAS f32x4*)(cw + k * 512 + c8 + 4);
#pragma unroll
                        for (int e = 0; e < 4; ++e) { w[k][e] = w0[e]; w[k][4 + e] = w1[e]; } }
                    const int t0 = unit * 128 + wave * 16, tseq0 = t0 & (SEQ - 1);
                    float h2[8], h1[8];
                    { const int r2 = tseq0 >= 2 ? t0 - 2 : t0, r1 = tseq0 >= 1 ? t0 - 1 : t0; const float m2 = tseq0 >= 2 ? 1.f : 0.f, m1 = tseq0 >= 1 ? 1.f : 0.f;
                      float a2[8], x2[8], a1[8], x1[8];
                      unpack8(ldg16(Z + (size_t)r2 * ZP + OFF_A + 512 + c8), a2); unpack8(ldg16(Z + (size_t)r2 * ZP + OFF_A + 1024 + c8), x2);
                      unpack8(ldg16(Z + (size_t)r1 * ZP + OFF_A + 512 + c8), a1); unpack8(ldg16(Z + (size_t)r1 * ZP + OFF_A + 1024 + c8), x1);
#pragma unroll
                      for (int e = 0; e < 8; ++e) { h2[e] = a2[e] * x2[e] * m2; h1[e] = a1[e] * x1[e] * m1; } }
#pragma unroll
                    for (int gq = 0; gq < 4; ++gq) {
                        u32x4 rb[4], rc[4], rx[4];
#pragma unroll
                        for (int q = 0; q < 4; ++q) { const bf16_t* zp = Z + (size_t)(t0 + 4 * gq + q) * ZP + OFF_A + c8; rb[q] = ldg16(zp); rc[q] = ldg16(zp + 512); rx[q] = ldg16(zp + 1024); }
#pragma unroll
                        for (int q = 0; q < 4; ++q) {
                            float ab[8], ac[8], ax[8], o[8]; unpack8(rb[q], ab); unpack8(rc[q], ac); unpack8(rx[q], ax);
#pragma unroll
                            for (int e = 0; e < 8; ++e) { const float cx = ac[e] * ax[e]; o[e] = ab[e] * (w[0][e] * h2[e] + w[1][e] * h1[e] + w[2][e] * cx); h2[e] = h1[e]; h1[e] = cx; }
                            stg16(U + (size_t)(t0 + 4 * gq + q) * DM + c8, pack8(o));
                        }
                    }
                }
            }
            REP(12) { LANE_VARS
                const float* gqp = args.in[16] + (size_t)l * HD; const float* gkp = args.in[17] + (size_t)l * HD;
                float gq[8], gk[8];
#pragma unroll
                for (int e = 0; e < 8; ++e) { gq[e] = gqp[(8 * lane + e) & 127] * QSCALE; gk[e] = gkp[(8 * lane + e) & 127]; }
                LAS float* red = (LAS float*)lds;
                for (int unit = vcu; unit < MROWS / 128; unit += G) {
                    float ks[8];
#pragma unroll
                    for (int e = 0; e < 8; ++e) ks[e] = 0.f;
#pragma unroll 1
                    for (int i4 = 0; i4 < 16; i4 += 4) {
                        u32x4 rq4[4], rk4[4];
#pragma unroll
                        for (int q = 0; q < 4; ++q) { const bf16_t* qp = Z + (size_t)(unit * 128 + wave * 16 + i4 + q) * ZP + OFF_D + 8 * lane; rq4[q] = ldg16(qp); rk4[q] = ldg16(qp + 512); }
#pragma unroll
                        for (int q4 = 0; q4 < 4; ++q4) {
                            const int row = unit * 128 + wave * 16 + i4 + q4;
                            bf16_t* qp = Z + (size_t)row * ZP + OFF_D + 8 * lane; bf16_t* kp = qp + 512;
                            float q[8], k[8]; unpack8(rq4[q4], q); unpack8(rk4[q4], k);
                            float sq = 0.f, sk = 0.f;
#pragma unroll
                            for (int e = 0; e < 8; ++e) { sq += q[e] * q[e]; sk += k[e] * k[e]; }
#pragma unroll
                            for (int o = 1; o < 16; o <<= 1) { sq += __shfl_xor(sq, o); sk += __shfl_xor(sk, o); }
                            const float rq = __builtin_amdgcn_rsqf(sq * (1.f / HD) + EPS), rk = __builtin_amdgcn_rsqf(sk * (1.f / HD) + EPS);
#pragma unroll
                            for (int e = 0; e < 8; ++e) { q[e] = q[e] * rq * gq[e]; k[e] = k[e] * rk * gk[e]; ks[e] += k[e]; }
                            if (rep) { bf16_t* dq = U + (size_t)row * DM + 1536 + 8 * lane; stg16(dq, pack8(q)); stg16(dq, pack8(k)); } else { stg16(qp, pack8(q)); stg16(kp, pack8(k)); }
                        }
                    }
#pragma unroll
                    for (int e = 0; e < 8; ++e) red[wave * 512 + 8 * lane + e] = ks[e];
                    __syncthreads();
                    { float s = 0.f;
#pragma unroll
                      for (int w = 0; w < 8; ++w) s += red[w * 512 + tid];
                      (rep ? lslot : ksum)[(size_t)unit * 512 + tid] = s; }
                    __syncthreads();
                }
            }
            REP(13) { LANE_VARS
                const float* cw = args.in[6] + (size_t)l * 31 * 512; const float* cb = args.in[7] + (size_t)l * 512;
                const float* lng = args.in[8] + (size_t)l * 512; const float* lnb = args.in[9] + (size_t)l * 512;
                LAS unsigned char* P = lds;
                for (int unit = vcu; unit < MROWS / 64; unit += G) {
                    const int t0 = unit * 64, tseq0 = t0 & (SEQ - 1);
#pragma unroll 1
                    for (int i0 = 0; i0 < 12; i0 += 4) {
                        u32x4 rba[4], rsg[4];
#pragma unroll
                        for (int q = 0; q < 4; ++q) { const int idx = tid + 512 * (i0 + q), r = idx >> 6, ch = idx & 63; const bool ok = idx < 94 * 64 && (tseq0 - 30 + r >= 0);
                            const size_t grow = ok ? (size_t)(t0 - 30 + r) : (size_t)t0;
                            rba[q] = ldg16(Z + grow * ZP + OFF_B + 8 * ch); rsg[q] = ldg16(Z + grow * ZP + OFF_B + 512 + 8 * ch); }
#pragma unroll
                        for (int q = 0; q < 4; ++q) { const int idx = tid + 512 * (i0 + q), r = idx >> 6, ch = idx & 63; const bool ok = (tseq0 - 30 + r >= 0);
                            float ba[8], sg[8]; unpack8(rba[q], ba); unpack8(rsg[q], sg);
#pragma unroll
                            for (int e = 0; e < 8; ++e) ba[e] = ok ? ba[e] * sg[e] : 0.f;
                            if (idx < 94 * 64) *(LAS u32x4*)(P + r * 1024 + ch * 16) = pack8(ba); }
                    }
                    __syncthreads();
                    {
                        float w[31];
#pragma unroll
                        for (int k = 0; k < 31; ++k) w[k] = cw[k * 512 + tid];
                        const float bias = cb[tid];
                        LAS unsigned short* Pc = (LAS unsigned short*)P + tid;
                        for (int grp = 0; grp < 8; ++grp) {
                            float pv[38];
#pragma unroll
                            for (int i = 0; i < 38; ++i) pv[i] = __uint_as_float((unsigned)Pc[(grp * 8 + i) * 512] << 16);
                            float hb[8];
#pragma unroll
                            for (int o = 0; o < 8; ++o) { float a = bias;
#pragma unroll
                                for (int k = 0; k < 31; ++k) a += w[k] * pv[o + k];
                                hb[o] = a; }
#pragma unroll
                            for (int o = 0; o < 8; o += 2) { const unsigned pkd = pk2(hb[o], hb[o + 1]); Pc[(grp * 8 + o) * 512] = (unsigned short)(pkd & 0xffffu); Pc[(grp * 8 + o + 1) * 512] = (unsigned short)(pkd >> 16); }
                        }
                    }
                    __syncthreads();
                    {
                        float gg[8], bb[8];
#pragma unroll
                        for (int e = 0; e < 8; ++e) { gg[e] = lng[8 * lane + e]; bb[e] = lnb[8 * lane + e]; }
                        for (int i = 0; i < 8; ++i) {
                            const int tt = wave * 8 + i;
                            float x[8]; unpack8(*(const LAS u32x4*)(P + tt * 1024 + lane * 16), x);
                            float s1 = 0.f, s2 = 0.f;
#pragma unroll
                            for (int e = 0; e < 8; ++e) { s1 += x[e]; s2 += x[e] * x[e]; }
                            s1 = wave_sum(s1); s2 = wave_sum(s2);
                            const float mean = s1 * (1.f / 512), var = fmaxf(s2 * (1.f / 512) - mean * mean, 0.f), rstd = __builtin_amdgcn_rsqf(var + EPS);
#pragma unroll
                            for (int e = 0; e < 8; ++e) { const float y = (x[e] - mean) * rstd * gg[e] + bb[e]; x[e] = y * sigmoid_f(y); }
                            stg16(U + (size_t)(t0 + tt) * DM + 512 + 8 * lane, pack8(x));
                        }
                    }
                    __syncthreads();
                }
            }
            REP(14) { LANE_VARS
                const float* lng = args.in[11] + (size_t)l * 512; const float* lnb = args.in[12] + (size_t)l * 512;
                const float* bsp = args.in[14] + (size_t)l * 4 * 128;
                constexpr int VP = 136;
                LAS unsigned short* vvT = (LAS unsigned short*)lds;
                for (int unit = vcu; unit < MROWS / 128; unit += G) {
                    const int row0 = unit * 128;
                    {
                        float gg[8], bb[8];
#pragma unroll
                        for (int e = 0; e < 8; ++e) { gg[e] = lng[8 * lane + e]; bb[e] = lnb[8 * lane + e]; }
#pragma unroll 1
                        for (int i4 = 0; i4 < 16; i4 += 4) {
                            u32x4 rx4[4];
#pragma unroll
                            for (int q = 0; q < 4; ++q) rx4[q] = ldg16(Z + (size_t)(row0 + wave * 16 + i4 + q) * ZP + OFF_C + 512 + 8 * lane);
#pragma unroll
                            for (int q = 0; q < 4; ++q) {
                                const int t = wave * 16 + i4 + q;
                                float x[8]; unpack8(rx4[q], x);
                                float s1 = 0.f, s2 = 0.f;
#pragma unroll
                                for (int e = 0; e < 8; ++e) { s1 += x[e]; s2 += x[e] * x[e]; }
                                s1 = wave_sum(s1); s2 = wave_sum(s2);
                                const float mean = s1 * (1.f / 512), var = fmaxf(s2 * (1.f / 512) - mean * mean, 0.f), rstd = __builtin_amdgcn_rsqf(var + EPS);
#pragma unroll
                                for (int e = 0; e < 8; e += 2) {
                                    const unsigned pkd = pk2((x[e] - mean) * rstd * gg[e] + bb[e], (x[e + 1] - mean) * rstd * gg[e + 1] + bb[e + 1]);
                                    vvT[(8 * lane + e) * VP + t] = (unsigned short)(pkd & 0xffffu); vvT[(8 * lane + e + 1) * VP + t] = (unsigned short)(pkd >> 16);
                                }
                            }
                        }
                    }
                    __syncthreads();
                    {
                        const int grp = wave >> 1, th = wave & 1, l15 = lane & 15, l4 = lane >> 4;
                        bf16x8 bfr[4][4];
#pragma unroll
                        for (int tt = 0; tt < 4; ++tt)
#pragma unroll
                            for (int ks = 0; ks < 4; ++ks) bfr[tt][ks] = __builtin_bit_cast(bf16x8, ldg16(Wsb + (size_t)(grp * 128 + 64 * th + 16 * tt + l15) * 128 + 32 * ks + 8 * l4));
                        float bs4[4]; u32x2 un[4];
#pragma unroll
                        for (int tt = 0; tt < 4; ++tt) { const int t = 64 * th + 16 * tt + l15; bs4[tt] = bsp[grp * 128 + t]; un[tt] = *(const GAS u32x2*)(Z + (size_t)(row0 + t) * ZP + OFF_C + grp * 128 + 4 * l4); }
#pragma unroll
                        for (int ct = 0; ct < 8; ++ct) {
                            f32x4 acc4[4]; u32x2 uc[4];
#pragma unroll
                            for (int tt = 0; tt < 4; ++tt) { acc4[tt] = (f32x4){0.f, 0.f, 0.f, 0.f}; uc[tt] = un[tt]; }
                            if (ct < 7) {
#pragma unroll
                                for (int tt = 0; tt < 4; ++tt) { const int t = 64 * th + 16 * tt + l15; un[tt] = *(const GAS u32x2*)(Z + (size_t)(row0 + t) * ZP + OFF_C + grp * 128 + 16 * (ct + 1) + 4 * l4); } }
#pragma unroll
                            for (int ks = 0; ks < 4; ++ks) {
                                const bf16x8 a = *(const LAS bf16x8*)((const LAS unsigned char*)vvT + ((grp * 128 + 16 * ct + l15) * VP + 32 * ks + 8 * l4) * 2);
#pragma unroll
                                for (int tt = 0; tt < 4; ++tt) acc4[tt] = __builtin_amdgcn_mfma_f32_16x16x32_bf16(a, bfr[tt][ks], acc4[tt], 0, 0, 0);
                            }
                            const int c0 = grp * 128 + 16 * ct + 4 * l4;
#pragma unroll
                            for (int tt = 0; tt < 4; ++tt) {
                                const int t = 64 * th + 16 * tt + l15; const float bs = bs4[tt]; const u32x2 uw = uc[tt];
                                u32x2 ow; ow.x = pk2(bflo(uw.x) * (acc4[tt][0] + bs), bfhi(uw.x) * (acc4[tt][1] + bs)); ow.y = pk2(bflo(uw.y) * (acc4[tt][2] + bs), bfhi(uw.y) * (acc4[tt][3] + bs));
                                *(GAS u32x2*)(U + (size_t)(row0 + t) * DM + 1024 + c0) = ow;
                            }
                        }
                    }
                    __syncthreads();
                }
            }
        }
        xcd_barrier(bar);
        if (PH_MASK & (1 << 3)) REP(3) { PHASE_VARS
            LAS float* km = (LAS float*)lds;
            LAS unsigned* hist = (LAS unsigned*)(lds + 16384);
            unsigned* cntl = ctl + CW_CNT + l * 512 + (rep ? 2048 : 0);
            for (int unit0 = vcu, uk = 0; unit0 < BATCH * NH * 32; unit0 += G, ++uk) {
                const int unit = (uk & 1) ? (unit0 ^ 31) : unit0;
                const int i = unit & 31, h = (unit >> 5) & 3, b = unit >> 7;
                if (i == 0) continue;
                for (int e = tid; e < i * 128; e += 512) { const int j = e >> 7, d = e & 127; km[e] = ksum[(size_t)(b * 64 + 2 * j) * 512 + h * HD + d] + ksum[(size_t)(b * 64 + 2 * j + 1) * 512 + h * HD + d]; }
                if (tid < 96) hist[tid] = 0u;
                __syncthreads();
                const int ql = tid >> 1, half = tid & 1;
                const bf16_t* qp = Z + (size_t)(b * SEQ + i * 256 + ql) * ZP + OFF_D + h * HD + half * 64;
                float qv[64];
#pragma unroll
                for (int s = 0; s < 8; ++s) { float t8[8]; unpack8(ldg16(qp + 8 * s), t8);
#pragma unroll
                    for (int e = 0; e < 8; ++e) qv[8 * s + e] = t8[e]; }
                float v0 = -3.0e38f, v1 = -3.0e38f, v2 = -3.0e38f; int i0 = 0, i1 = 0, i2 = 0;
                for (int j = 0; j < i; ++j) {
                    const LAS f32x4* kp = (const LAS f32x4*)(km + j * 128 + half * 64);
                    float dot = 0.f;
#pragma unroll
                    for (int s = 0; s < 16; ++s) { const f32x4 kk = kp[s]; dot += qv[4 * s] * kk.x + qv[4 * s + 1] * kk.y + qv[4 * s + 2] * kk.z + qv[4 * s + 3] * kk.w; }
                    dot += __shfl_xor(dot, 1);
                    const bool g0 = dot > v0, g1 = dot > v1, g2 = dot > v2;
                    v2 = g1 ? v1 : (g2 ? dot : v2); i2 = g1 ? i1 : (g2 ? j : i2);
                    v1 = g0 ? v0 : (g1 ? dot : v1); i1 = g0 ? i0 : (g1 ? j : i1);
                    v0 = g0 ? dot : v0; i0 = g0 ? j : i0;
                }
                const int nsel = i < 3 ? i : 3;
                if (half == 0) { lds_add(&hist[i0], 1u); if (nsel > 1) lds_add(&hist[i1], 1u); if (nsel > 2) lds_add(&hist[i2], 1u); }
                __syncthreads();
                if (tid < 32) { const unsigned n = hist[tid]; if (n) hist[32 + tid] = __hip_atomic_fetch_add(cntl + (b * NH + h) * 32 + tid, n, __ATOMIC_RELAXED, __HIP_MEMORY_SCOPE_AGENT); }
                __syncthreads();
                if (half == 0) {
                    unsigned short* lb = (rep ? (unsigned short*)oslot : lists) + (size_t)((b * NH + h) * 32) * 8192;
                    const unsigned tq = (unsigned)(i * 256 + ql);
                    { const unsigned pos = hist[32 + i0] + lds_add(&hist[64 + i0], 1u); lb[(size_t)i0 * 8192 + pos] = (unsigned short)(tq); }
                    if (nsel > 1) { const unsigned pos = hist[32 + i1] + lds_add(&hist[64 + i1], 1u); lb[(size_t)i1 * 8192 + pos] = (unsigned short)(tq | (1u << 13)); }
                    if (nsel > 2) { const unsigned pos = hist[32 + i2] + lds_add(&hist[64 + i2], 1u); lb[(size_t)i2 * 8192 + pos] = (unsigned short)(tq | (2u << 13)); }
                }
                __syncthreads();
            }
        }
        xcd_barrier(bar);
        LAS unsigned char* ldsK = lds; LAS unsigned char* ldsV = lds + 65536; LAS float* tab = (LAS float*)(lds + 131072);
        LAS float* M2s = (LAS float*)(lds + 131072 + TABP * 4);
        LAS int* pre = (LAS int*)(lds + 131072 + TABP * 4 + 64);
        { LANE_VARS if (wave == 0) {
            const float* gqp = args.in[16] + (size_t)l * HD; const float* gkp = args.in[17] + (size_t)l * HD;
            const float gqm = wave_max(fmaxf(fabsf(gqp[lane]), fabsf(gqp[64 + lane]))), gkm = wave_max(fmaxf(fabsf(gkp[lane]), fabsf(gkp[64 + lane])));
#pragma unroll
            for (int h = 0; h < NH; ++h) { const float bm = wave_max(lane < 32 ? fabsf(args.in[1][lane * NH + h]) : 0.f); if (lane == 0) M2s[h] = (128.f * gqm * gkm * 0.08838834764831845f + bm) * LOG2E; }
        } }
        __syncthreads();
        if (PH_MASK & (1 << 4)) REP(4) { PHASE_VARS
            const unsigned* cntl = ctl + CW_CNT + l * 512;
            {
                const int c = (int)__hip_atomic_load(cntl + tid, __ATOMIC_RELAXED, __HIP_MEMORY_SCOPE_AGENT);
                const int nch = (c + 255) >> 8;
                int incl = nch;
#pragma unroll
                for (int o = 1; o < 64; o <<= 1) { const int t = __shfl_up(incl, o); if (lane >= o) incl += t; }
                LAS int* wtot = (LAS int*)(lds + 131072 + TABP * 4 + 32);
                if (lane == 63) wtot[wave] = incl;
                __syncthreads();
                int wbase = 0;
#pragma unroll
                for (int w = 0; w < 8; ++w) wbase += (w < wave) ? wtot[w] : 0;
                pre[tid] = wbase + incl - nch;
                if (tid == 511) pre[512] = wbase + incl;
                __syncthreads();
            }
            const int NI = pre[512];
            const int it0 = (int)(((long)vcu * NI) / G), it1 = (int)(((long)(vcu + 1) * NI) / G);
            int cur = -1;
            for (int it = it0; it < it1; ++it) {
                int lo = 0, hi2 = 511;
                while (lo < hi2) { const int mid = (lo + hi2 + 1) >> 1; if (pre[mid] <= it) lo = mid; else hi2 = mid - 1; }
                const int bhj = lo, chunk = it - pre[bhj];
                const int j = bhj & 31, h = (bhj >> 5) & 3, b = bhj >> 7;
                if (bhj != cur) { __syncthreads(); load_kv(Z, tabg, ldsK, ldsV, tab, M2s[h], b, h, j, tid); cur = bhj; __syncthreads(); }
                const int cnt = (int)__hip_atomic_load(cntl + bhj, __ATOMIC_RELAXED, __HIP_MEMORY_SCOPE_AGENT);
                const int e = chunk * 256 + wave * 32 + (lane & 31);
                const bool valid = e < cnt;
                const unsigned ent = lists[(size_t)bhj * 8192 + (valid ? e : chunk * 256)];
                const int tq = ent & 8191, rsel = ent >> 13;
                const size_t row = (size_t)b * SEQ + tq;
                bf16x8 qf[8];
                { const bf16_t* qp = Z + row * ZP + OFF_D + h * HD + 8 * (lane >> 5);
#pragma unroll
                  for (int s = 0; s < 8; ++s) qf[s] = __builtin_bit_cast(bf16x8, ldg16(qp + 16 * s)); }
                f32x16 o[4];
#pragma unroll
                for (int c = 0; c < 4; ++c)
#pragma unroll
                    for (int r = 0; r < 16; ++r) o[c][r] = 0.f;
                float lsum = 0.f;
                attn_core<false>(ldsK, ldsV, tab, qf, tq - j * 256, 4, lane, o, lsum);
                lsum += __shfl_xor(lsum, 32);
                store_o_bf16(valid ? (bf16_t*)oslot + ((size_t)rsel * MROWS + row) * 512 + h * HD : (bf16_t*)oslot + (size_t)3 * MROWS * 512 + (size_t)(tid & 63) * 128, o, 1.0f, lane >> 5);
                if (valid && lane < 32) lslot[((size_t)rsel * MROWS + row) * 4 + h] = lsum;
            }
        }
        xcd_barrier(bar);
        if (PH_MASK & (1 << 5)) REP(5) { PHASE_VARS
            for (int unit = vcu; unit < BATCH * NH * 32; unit += G) {
                const int i = unit & 31, h = (unit >> 5) & 3, b = unit >> 7;
                __syncthreads(); load_kv(Z, tabg, ldsK, ldsV, tab, M2s[h], b, h, i, tid); __syncthreads();
                const int ql = wave * 32 + (lane & 31);
                const size_t row = (size_t)b * SEQ + i * 256 + ql;
                bf16x8 qf[8];
                { const bf16_t* qp = Z + row * ZP + OFF_D + h * HD + 8 * (lane >> 5);
#pragma unroll
                  for (int s = 0; s < 8; ++s) qf[s] = __builtin_bit_cast(bf16x8, ldg16(qp + 16 * s)); }
                f32x16 o[4];
#pragma unroll
                for (int c = 0; c < 4; ++c)
#pragma unroll
                    for (int r = 0; r < 16; ++r) o[c][r] = 0.f;
                float lsum = 0.f;
                attn_core<true>(ldsK, ldsV, tab, qf, ql, (wave >> 1) + 1, lane, o, lsum);
                lsum += __shfl_xor(lsum, 32);
                const int nsel = i < 3 ? i : 3;
                for (int r = 0; r < nsel; ++r) {
                    lsum += lslot[((size_t)r * MROWS + row) * 4 + h];
                    load_add_o_bf16((const bf16_t*)oslot + ((size_t)r * MROWS + row) * 512 + h * HD, o, lane >> 5);
                }
                const float inv = 1.0f / lsum;
                store_o_bf16(U + row * DM + 1536 + h * HD, o, inv, lane >> 5);
            }
            __syncthreads();
        }
        if (PH_MASK & (1 << 1)) REP(1) { PHASE_VARS
            pg8::Gemm g{h8, Wg8, DM, DM, DM, 0, 0}; pg8::StaticOrder<0> S; S.init(MROWS, ZP - OFF_G, G, bx);
            pg8::EpiGate8 E{(unsigned char*)Z + OFF_G * 2, part, 1.0f / 64.0f};
            pg8::gemm_phase<pg8::EpiGate8, pg8::StaticOrder<0>, true>(lds, g, S, E, tid);
        }
        xcd_barrier(bar);
        if (PH_MASK & (1 << 6)) REP(6) { PHASE_VARS
            pg8::Gemm g{U, Wt_out, DM * 2, 512 * 2, 512 * 2, (size_t)512 * 2, (size_t)DM * 512 * 2}; pg8::StaticOrder<2> S; S.init(MROWS, DM, G, bx);
            pg8::EpiMerge E{(const unsigned char*)Z + OFF_G * 2, actA};
            pg8::gemm_phase<pg8::EpiMerge, pg8::StaticOrder<2>>(lds, g, S, E, tid);
        }
        xcd_barrier(bar);
        if (PH_MASK & (1 << 7)) REP(7) { PHASE_VARS const bool dry = ((DUP_MASK >> 7) & 1) && rep == 0;
            pg8::Gemm g{actA, Wt_o, DM * 2, DM * 2, DM * 2, 0, 0}; pg8::StaticOrder<0> S; S.init(MROWS, DM, G, bx);
            pg8::EpiResidB E{xb, dry ? (bf16_t*)oslot : xb, nullptr, dry ? lslot : part, nullptr, (LAS float*)(lds + 131072)};
            pg8::gemm_phase<pg8::EpiResidB, pg8::StaticOrder<0>>(lds, g, S, E, tid);
        }
        xcd_barrier(bar);
        if (PH_MASK & (1 << 9)) REP(9) { PHASE_VARS
            pg8::Gemm g{xb, Wt_mi, DM * 2, DM * 2, DM * 2, 0, 0}; pg8::StaticOrder<0> S; S.init(MROWS, DFF, G, bx);
            pg8::EpiRelu2 E{Z, DFF, part};
            pg8::gemm_phase<pg8::EpiRelu2, pg8::StaticOrder<0>>(lds, g, S, E, tid);
        }
        xcd_barrier(bar);
        if (PH_MASK & (1 << 10)) REP(10) { PHASE_VARS const bool dry = ((DUP_MASK >> 10) & 1) && rep == 0;
            pg8::Gemm g{Z, Wt_mo, DFF * 2, DFF * 2, DFF * 2, 0, 0}; pg8::StaticOrder<0> S; S.init(MROWS, DM, G, bx);
            pg8::EpiResidB E{xb, dry ? (bf16_t*)oslot : xb, dry ? (unsigned char*)oslot + 128 * MiB : h8, dry ? lslot : part, (l == DEPTH - 1 && !dry) ? xout : nullptr, (LAS float*)(lds + 131072)};
            pg8::gemm_phase<pg8::EpiResidB, pg8::StaticOrder<0>>(lds, g, S, E, tid);
        }
        xcd_barrier(bar);
    }
}

extern "C" void kernel_launch(void* const* d_in, const int* in_sizes, int n_in, void* d_out, int out_size, void* d_ws, size_t ws_size, hipStream_t stream) {
    static int grid = 0;
    if (grid == 0) {
        if (n_in != 23 || in_sizes[0] != MROWS * DM || out_size != MROWS * DM || ws_size < WS_END) {
            fprintf(stderr, "kernel_launch: unexpected shapes (n_in %d, in0 %d, out %d, ws %zu < %zu); nothing launched\n", n_in, n_in > 0 ? in_sizes[0] : -1, out_size, ws_size, (size_t)WS_END); grid = -1; return; }
        int dev = 0, cus = 0, per_cu = 0;
        if (hipGetDevice(&dev) != hipSuccess || hipDeviceGetAttribute(&cus, hipDeviceAttributeMultiprocessorCount, dev) != hipSuccess) { grid = -1; return; }
        if (hipFuncSetAttribute((const void*)fwd, hipFuncAttributeMaxDynamicSharedMemorySize, LDS_BYTES) != hipSuccess) { fprintf(stderr, "kernel_launch: hipFuncSetAttribute failed\n"); grid = -1; return; }
        if (hipOccupancyMaxActiveBlocksPerMultiprocessor(&per_cu, (const void*)fwd, 512, LDS_BYTES) != hipSuccess || per_cu < 1)
            fprintf(stderr, "kernel_launch: note: occupancy query reports %d workgroups per CU\n", per_cu);
        (void)hipGetLastError();
        grid = cus;
    }
    if (grid < 0) return;
    if (hipMemsetAsync((char*)d_ws + WS_CTL, 0, CTL_ZERO_BYTES, stream) != hipSuccess) { fprintf(stderr, "kernel_launch: memset failed\n"); return; }
    Args a{};
    for (int i = 0; i < 23; ++i) a.in[i] = (const float*)d_in[i];
    a.out = (float*)d_out; a.ws = (unsigned char*)d_ws;
    hipLaunchKernelGGL(fwd, dim3(grid), dim3(512), LDS_BYTES, stream, a);
}
```

```cpp
#include <hip/hip_runtime.h>
#include <cstdio>
#include <cstdint>

#define LAS __attribute__((address_space(3)))
#define GAS __attribute__((address_space(1)))
typedef unsigned short bf16_t;
typedef short bf16x8 __attribute__((ext_vector_type(8)));
typedef short s16x4 __attribute__((ext_vector_type(4)));
typedef float f32x4 __attribute__((ext_vector_type(4)));
typedef float f32x16 __attribute__((ext_vector_type(16)));
typedef unsigned u32x4 __attribute__((ext_vector_type(4)));
typedef unsigned u32x2 __attribute__((ext_vector_type(2)));

#ifndef PH_MASK
#define PH_MASK 0xFFFF
#endif
#ifndef DUP_MASK
#define DUP_MASK 0
#endif
#define REP(n) for (int rep = 0; rep <= ((DUP_MASK >> (n)) & 1); ++rep)
constexpr int DM = 2048, BATCH = 4, SEQ = 8192, DEPTH = 4, MROWS = BATCH * SEQ;
constexpr int OFF_A = 0, OFF_B = 1536, OFF_C = 2560, OFF_D = 3584, OFF_G = 5120, ZP = 13312;
constexpr int DFF = 8192, NH = 4, HD = 128;
constexpr float EPS = 1e-6f;
constexpr float LOG2E = 1.4426950408889634f;
constexpr float QSCALE = 0.08838834764831845f * 1.4426950408889634f;
constexpr int TABN = 1536;
constexpr int TABP = TABN + 128, TREV = TABN + 58;

__device__ __forceinline__ unsigned pk2(float lo, float hi) {
    typedef float f2_t __attribute__((ext_vector_type(2))); typedef __bf16 b2_t __attribute__((ext_vector_type(2)));
    f2_t v = {lo, hi}; b2_t b = __builtin_convertvector(v, b2_t); return __builtin_bit_cast(unsigned, b);
}
__device__ __forceinline__ float bflo(unsigned w) { return __uint_as_float(w << 16); }
__device__ __forceinline__ float bfhi(unsigned w) { return __uint_as_float(w & 0xffff0000u); }
__device__ __forceinline__ void unpack8(const u32x4 w, float (&f)[8]) {
    f[0] = bflo(w.x); f[1] = bfhi(w.x); f[2] = bflo(w.y); f[3] = bfhi(w.y); f[4] = bflo(w.z); f[5] = bfhi(w.z); f[6] = bflo(w.w); f[7] = bfhi(w.w);
}
__device__ __forceinline__ u32x4 pack8(const float (&f)[8]) { u32x4 w; w.x = pk2(f[0], f[1]); w.y = pk2(f[2], f[3]); w.z = pk2(f[4], f[5]); w.w = pk2(f[6], f[7]); return w; }
__device__ __forceinline__ float sigmoid_f(float x) { return __builtin_amdgcn_rcpf(1.0f + __builtin_amdgcn_exp2f(-x * LOG2E)); }
__device__ __forceinline__ float gelu_tanh_f(float x) {
    const float u2 = 1.5957691216057308f * (x + 0.044715f * x * x * x);
    return x * __builtin_amdgcn_rcpf(1.0f + __builtin_amdgcn_exp2f(-u2 * LOG2E));
}
__device__ __forceinline__ float wave_sum(float v) {
#pragma unroll
    for (int o = 1; o < 64; o <<= 1) v += __shfl_xor(v, o);
    return v;
}
__device__ __forceinline__ float wave_max(float v) {
#pragma unroll
    for (int o = 1; o < 64; o <<= 1) v = fmaxf(v, __shfl_xor(v, o));
    return v;
}
__device__ __forceinline__ unsigned lds_add(LAS unsigned* p, unsigned v) { return __hip_atomic_fetch_add(p, v, __ATOMIC_RELAXED, __HIP_MEMORY_SCOPE_WORKGROUP); }
__device__ __forceinline__ int opaque_tid() { int t = threadIdx.x; asm volatile("" : "+v"(t)); return t; }
__device__ __forceinline__ unsigned char* opaque_ptr(unsigned char* p) { asm volatile("" : "+s"(p)); return p; }
__device__ __forceinline__ u32x4 ldg16(const bf16_t* p) { return *(const GAS u32x4*)p; }
__device__ __forceinline__ void stg16(bf16_t* p, u32x4 v) { *(GAS u32x4*)p = v; }

namespace pg8 {
constexpr int BM = 256, BK = 64, HALF = 128, HTB = HALF * BK * 2, STAGE_BYTES = 8 * HTB, NXCD = 8, WGM = 4;
__host__ __device__ __forceinline__ int lds_byte(int r, int c) { const int st = (r >> 4) * 2 + (c >> 5), rr = r & 15, cc = c & 31, ob = rr * 64 + cc * 2; return st * 1024 + (ob ^ (((ob >> 9) & 1) << 5)); }
__host__ __device__ __forceinline__ void stage_rc(int b, int& R, int& C) { const int st = b / 1024, sb = b % 1024, swz = sb ^ (((sb >> 9) & 1) << 5); R = (st >> 1) * 16 + swz / 64; C = (st & 1) * 32 + (swz % 64) / 2; }
__host__ __device__ __forceinline__ int perm32(int rho) { const int n = rho >> 4, i = rho & 15; return 8 * (i >> 2) + 4 * n + (i & 3); }

typedef int v8i_t __attribute__((ext_vector_type(8)));
typedef v8i_t v8i_a16 __attribute__((aligned(16)));
__device__ __forceinline__ v8i_t cat8(const u32x4 a, const u32x4 b) { return (v8i_t){(int)a.x, (int)a.y, (int)a.z, (int)a.w, (int)b.x, (int)b.y, (int)b.z, (int)b.w}; }
struct Unit { int pm, pn, seg; };
struct Gemm { const void* A; const void* Bt; int lda_b, ldb_b, Kb; size_t a_seg, b_seg; };

template <int NSEG_LOG2> struct StaticOrder {
    int nM, nN, nwg, G, c;
    __device__ void init(int M, int N, int G_, int c_) { nM = M / BM; nN = N / BM; nwg = nM * nN; G = G_; c = c_; }
    __device__ bool next(int i, Unit& u) const {
        const int ti = i >> NSEG_LOG2;
        const long L = (long)ti * G + c; if (L >= nwg) return false;
        int wgid = (int)L; { const int q = nwg / NXCD, r = nwg % NXCD, xcd = wgid % NXCD, off = wgid / NXCD; wgid = (xcd < r ? xcd * (q + 1) : r * (q + 1) + (xcd - r) * q) + off; }
        const int nig = WGM * nN, gid = wgid / nig, fm = gid * WGM, gsz = (nM - fm) < WGM ? (nM - fm) : WGM;
        u.pm = fm + ((wgid % nig) % gsz); u.pn = (wgid % nig) / gsz; u.seg = i & ((1 << NSEG_LOG2) - 1); return true;
    }
};

typedef f32x4 Acc[2][2][4][2];
template <class V, int NDW> __device__ __forceinline__ void store_pair(void* pe, void* po, int odd, V w0, V w1) {
    V A, B;
#pragma unroll
    for (int d = 0; d < NDW; ++d) { const unsigned snd = odd ? w0[d] : w1[d]; const unsigned rcv = (unsigned)__builtin_amdgcn_mov_dpp((int)snd, 0xB1, 0xF, 0xF, true);
        A[d] = odd ? rcv : w0[d]; B[d] = odd ? w1[d] : rcv; }
    *(GAS V*)pe = A; *(GAS V*)po = B;
}
__device__ __forceinline__ void rows_rstd(const float* part, int row0, float scale, float (&rsv)[2][4]) {
    f32x4 pa[2][4], pb[2][4];
#pragma unroll
    for (int ai = 0; ai < 2; ++ai)
#pragma unroll
        for (int m = 0; m < 4; ++m) { const float* p = part + (size_t)(row0 + ai * HALF + m * 16) * 8; pa[ai][m] = *(const GAS f32x4*)p; pb[ai][m] = *(const GAS f32x4*)(p + 4); }
    asm volatile("" ::: "memory");
#pragma unroll
    for (int ai = 0; ai < 2; ++ai)
#pragma unroll
        for (int m = 0; m < 4; ++m) { const f32x4 a = pa[ai][m], b = pb[ai][m];
            rsv[ai][m] = __builtin_amdgcn_rsqf((((a.x + a.y) + (a.z + a.w)) + ((b.x + b.y) + (b.z + b.w))) * (1.0f / DM) + EPS) * scale; }
}

constexpr int RS_OFF0 = 135168, RS_OFF1 = 147456;
__device__ __forceinline__ void rows_rstd_lds(const LAS float* rs, int rl, float scale, float (&rsv)[2][4]) {
#pragma unroll
    for (int ai = 0; ai < 2; ++ai)
#pragma unroll
        for (int m = 0; m < 4; ++m) { const LAS float* p = rs + (rl + ai * HALF + m * 16) * 8; const f32x4 a = *(const LAS f32x4*)p, b = *(const LAS f32x4*)(p + 4);
            rsv[ai][m] = __builtin_amdgcn_rsqf((((a.x + a.y) + (a.z + a.w)) + ((b.x + b.y) + (b.z + b.w))) * (1.0f / DM) + EPS) * scale; }
}
struct EpiZ {
    static constexpr bool PERM = true;
    static constexpr bool NEEDS_RS = true;
    bf16_t* O; const float* part; int col_base; int gates; float pre;
    __device__ __forceinline__ bool keep(const Unit&) const { return false; }
    __device__ __forceinline__ void operator()(Acc& acc, const Unit& u, int wr, int wc, int fr, int fq, const LAS float* rs) const {
        const int row0 = u.pm * BM + wr * 64 + fr, col0 = col_base + u.pn * BM + wc * 64 + 8 * fq;
        const int pn = u.pn;
        const int act = gates ? 1 : ((pn == 8 || pn == 9) ? 1 : ((pn >= 10 && pn < 14) ? 2 : 0));
        float rsv[2][4]; rows_rstd_lds(rs, wr * 64 + fr, pre, rsv);
#pragma unroll
        for (int ai = 0; ai < 2; ++ai)
#pragma unroll
            for (int m = 0; m < 4; ++m) { const int row = row0 + ai * HALF + m * 16; const int odd = fr & 1; bf16_t* rowp = O + (size_t)(row - odd) * ZP + col0 + 32 * odd;
                const float rs = rsv[ai][m]; const float nl2 = -LOG2E * rs; u32x4 wv[2];
#pragma unroll
                for (int bj = 0; bj < 2; ++bj) { f32x4 v0 = acc[ai][bj][m][0], v1 = acc[ai][bj][m][1];
                    if (act == 1) {
#pragma unroll
                        for (int j = 0; j < 4; ++j) { v0[j] = __builtin_amdgcn_rcpf(1.0f + __builtin_amdgcn_exp2f(v0[j] * nl2)); v1[j] = __builtin_amdgcn_rcpf(1.0f + __builtin_amdgcn_exp2f(v1[j] * nl2)); } }
                    else if (act == 2) {
#pragma unroll
                        for (int j = 0; j < 4; ++j) { v0[j] = gelu_tanh_f(v0[j] * rs); v1[j] = gelu_tanh_f(v1[j] * rs); } }
                    else { v0 *= rs; v1 *= rs; }
                    u32x4 w; w.x = pk2(v0[0], v0[1]); w.y = pk2(v0[2], v0[3]); w.z = pk2(v1[0], v1[1]); w.w = pk2(v1[2], v1[3]); wv[bj] = w; }
                store_pair<u32x4, 4>(rowp, rowp + ZP, odd, wv[0], wv[1]); }
    }
};
struct EpiGate8 {
    static constexpr bool PERM = true;
    static constexpr bool NEEDS_RS = true;
    unsigned char* G8; const float* part; float pre;
    __device__ __forceinline__ bool keep(const Unit&) const { return false; }
    __device__ __forceinline__ void operator()(Acc& acc, const Unit& u, int wr, int wc, int fr, int fq, const LAS float* rs) const {
        const int row0 = u.pm * BM + wr * 64 + fr, col0 = u.pn * BM + wc * 64 + 8 * fq;
        float rsv[2][4]; rows_rstd_lds(rs, wr * 64 + fr, pre, rsv);
#pragma unroll
        for (int ai = 0; ai < 2; ++ai)
#pragma unroll
            for (int m = 0; m < 4; ++m) { const int row = row0 + ai * HALF + m * 16; const int odd = fr & 1; unsigned char* rowp = G8 + (size_t)(row - odd) * (ZP * 2) + col0 + 32 * odd;
                const float nl2 = -LOG2E * rsv[ai][m]; u32x2 wv[2]; float cl = -7.98868469f; asm volatile("" : "+v"(cl));
#pragma unroll
                for (int bj = 0; bj < 2; ++bj) { const f32x4 v0 = acc[ai][bj][m][0], v1 = acc[ai][bj][m][1]; u32x2 w = (u32x2){0u, 0u};
                    typedef float f32x2_t __attribute__((ext_vector_type(2))); const f32x2_t nn = {nl2, nl2}, cc = {cl, cl};
                    const f32x2_t ta = __builtin_elementwise_fma((f32x2_t){v0[0], v0[1]}, nn, cc), tb = __builtin_elementwise_fma((f32x2_t){v0[2], v0[3]}, nn, cc), tc = __builtin_elementwise_fma((f32x2_t){v1[0], v1[1]}, nn, cc), td = __builtin_elementwise_fma((f32x2_t){v1[2], v1[3]}, nn, cc);
                    const f32x4 t0 = {ta[0], ta[1], tb[0], tb[1]}, t1 = {tc[0], tc[1], td[0], td[1]}; f32x4 e0, e1;
#pragma unroll
                    for (int j = 0; j < 4; ++j) { e0[j] = __builtin_amdgcn_exp2f(t0[j]); e1[j] = __builtin_amdgcn_exp2f(t1[j]); }
                    e0 += 1.0f / 254.0f; e1 += 1.0f / 254.0f;
#pragma unroll
                    for (int j = 0; j < 4; ++j) {
                        w.x = __builtin_amdgcn_cvt_pk_u8_f32(__builtin_amdgcn_rcpf(e0[j]), j, w.x);
                        w.y = __builtin_amdgcn_cvt_pk_u8_f32(__builtin_amdgcn_rcpf(e1[j]), j, w.y); }
                    w.x += 0x01010101u; w.y += 0x01010101u;
                    wv[bj] = w; }
                store_pair<u32x2, 2>(rowp, rowp + ZP * 2, odd, wv[0], wv[1]); }
    }
};
struct EpiLin {
    static constexpr bool PERM = true;
    static constexpr bool NEEDS_RS = false;
    bf16_t* scratch;
    __device__ __forceinline__ bool keep(const Unit&) const { return false; }
    __device__ __forceinline__ void operator()(Acc& acc, const Unit& u, int wr, int wc, int fr, int fq, const LAS float* rs) const {
        bf16_t* base = scratch + (size_t)((u.pm * 52 + u.pn) & 1023) * 65536 + (size_t)((wr * 4 + wc) * 16) * 512 + (fr + 16 * fq) * 8;
#pragma unroll
        for (int ai = 0; ai < 2; ++ai)
#pragma unroll
            for (int m = 0; m < 4; ++m)
#pragma unroll
                for (int bj = 0; bj < 2; ++bj) { const f32x4 v0 = acc[ai][bj][m][0], v1 = acc[ai][bj][m][1];
                    u32x4 w; w.x = pk2(v0[0], v0[1]); w.y = pk2(v0[2], v0[3]); w.z = pk2(v1[0], v1[1]); w.w = pk2(v1[2], v1[3]);
                    *(GAS u32x4*)(base + ((ai * 4 + m) * 2 + bj) * 512) = w; }
    }
};
struct EpiNull {
    static constexpr bool PERM = true;
    static constexpr bool NEEDS_RS = false;
    __device__ __forceinline__ bool keep(const Unit&) const { return false; }
    __device__ __forceinline__ void operator()(Acc& acc, const Unit& u, int wr, int wc, int fr, int fq, const LAS float* rs) const {
#pragma unroll
        for (int ai = 0; ai < 2; ++ai)
#pragma unroll
            for (int bj = 0; bj < 2; ++bj)
#pragma unroll
                for (int m = 0; m < 4; ++m)
#pragma unroll
                    for (int n = 0; n < 2; ++n) asm volatile("" :: "v"(acc[ai][bj][m][n]));
    }
};
struct EpiRelu2 {
    static constexpr bool PERM = true;
    static constexpr bool NEEDS_RS = true;
    bf16_t* O; int ldc; const float* part;
    __device__ __forceinline__ bool keep(const Unit&) const { return false; }
    __device__ __forceinline__ void operator()(Acc& acc, const Unit& u, int wr, int wc, int fr, int fq, const LAS float* rs) const {
        const int row0 = u.pm * BM + wr * 64 + fr, col0 = u.pn * BM + wc * 64 + 8 * fq;
        float rsv[2][4]; rows_rstd_lds(rs, wr * 64 + fr, 1.0f, rsv);
#pragma unroll
        for (int ai = 0; ai < 2; ++ai)
#pragma unroll
            for (int m = 0; m < 4; ++m) { const int row = row0 + ai * HALF + m * 16; const int odd = fr & 1; bf16_t* rowp = O + (size_t)(row - odd) * ldc + col0 + 32 * odd; const float rs = rsv[ai][m]; u32x4 wv[2];
#pragma unroll
                for (int bj = 0; bj < 2; ++bj) { f32x4 v0 = acc[ai][bj][m][0], v1 = acc[ai][bj][m][1];
#pragma unroll
                    for (int j = 0; j < 4; ++j) { const float a = __builtin_amdgcn_fmed3f(v0[j], 0.f, 3.0e38f) * rs, b = __builtin_amdgcn_fmed3f(v1[j], 0.f, 3.0e38f) * rs; v0[j] = a * a; v1[j] = b * b; }
                    u32x4 w; w.x = pk2(v0[0], v0[1]); w.y = pk2(v0[2], v0[3]); w.z = pk2(v1[0], v1[1]); w.w = pk2(v1[2], v1[3]); wv[bj] = w; }
                store_pair<u32x4, 4>(rowp, rowp + ldc, odd, wv[0], wv[1]); }
    }
};
struct EpiResidB {
    static constexpr bool PERM = true;
    static constexpr bool NEEDS_RS = false;
    const bf16_t* xr; bf16_t* xb; unsigned char* x8; float* part; float* outf; LAS float* red;
    __device__ __forceinline__ bool keep(const Unit&) const { return false; }
    __device__ __forceinline__ void operator()(Acc& acc, const Unit& u, int wr, int wc, int fr, int fq, const LAS float* rs) const {
        const int row0 = u.pm * BM + wr * 64 + fr, col0 = u.pn * BM + wc * 64 + 8 * fq;
#pragma unroll
        for (int ai = 0; ai < 2; ++ai) {
            u32x4 rv[4][2];
#pragma unroll
            for (int m = 0; m < 4; ++m)
#pragma unroll
                for (int bj = 0; bj < 2; ++bj) rv[m][bj] = *(const GAS u32x4*)(xr + (size_t)(row0 + ai * HALF + m * 16) * DM + col0 + bj * 32);
#pragma unroll
            for (int m = 0; m < 4; ++m) { const int row = row0 + ai * HALF + m * 16; const int odd = fr & 1; const size_t off = (size_t)row * DM + col0, offp = (size_t)(row - odd) * DM + col0 + 32 * odd; float ss = 0.f;
                u32x4 wv[2]; u32x2 fv[2];
#pragma unroll
                for (int bj = 0; bj < 2; ++bj) {
                    float v[8]; unpack8(rv[m][bj], v);
#pragma unroll
                    for (int e = 0; e < 8; ++e) { v[e] += acc[ai][bj][m][e >> 2][e & 3]; ss += v[e] * v[e]; }
                    if (outf) { *(GAS f32x4*)(outf + off + bj * 32) = (f32x4){v[0], v[1], v[2], v[3]}; *(GAS f32x4*)(outf + off + bj * 32 + 4) = (f32x4){v[4], v[5], v[6], v[7]}; }
                    else { wv[bj] = pack8(v);
                        if (x8) { int t = __builtin_amdgcn_cvt_pk_fp8_f32(v[0], v[1], 0, false); t = __builtin_amdgcn_cvt_pk_fp8_f32(v[2], v[3], t, true); fv[bj].x = (unsigned)t;
                            t = __builtin_amdgcn_cvt_pk_fp8_f32(v[4], v[5], 0, false); t = __builtin_amdgcn_cvt_pk_fp8_f32(v[6], v[7], t, true); fv[bj].y = (unsigned)t; } }
                }
                if (!outf) { store_pair<u32x4, 4>(xb + offp, xb + offp + DM, odd, wv[0], wv[1]); if (x8) store_pair<u32x2, 2>(x8 + offp, x8 + offp + DM, odd, fv[0], fv[1]); }
                ss += __shfl_xor(ss, 16); ss += __shfl_xor(ss, 32);
                if (fq == 0) red[wc * 256 + ai * HALF + wr * 64 + m * 16 + fr] = ss;
            }
        }
        asm volatile("s_waitcnt lgkmcnt(0)" ::: "memory"); __builtin_amdgcn_s_barrier(); asm volatile("" ::: "memory");
        { const int t = (wr * 4 + wc) * 64 + fr + 16 * fq;
          if (t < 256 && !outf) part[(size_t)(u.pm * BM + t) * 8 + u.pn] = (red[t] + red[256 + t]) + (red[512 + t] + red[768 + t]); }
        asm volatile("s_waitcnt lgkmcnt(0)" ::: "memory"); __builtin_amdgcn_s_barrier(); asm volatile("" ::: "memory");
    }
};
struct EpiMerge {
    static constexpr bool PERM = true;
    static constexpr bool NEEDS_RS = false;
    const unsigned char* G;
    bf16_t* O;
    __device__ __forceinline__ bool keep(const Unit& u) const { return u.seg < 3; }
    __device__ __forceinline__ void operator()(Acc& acc, const Unit& u, int wr, int wc, int fr, int fq, const LAS float* rs) const {
        const int row0 = u.pm * BM + wr * 64 + fr, col0 = u.pn * BM + wc * 64 + 8 * fq;
        const int seg = u.seg;
        const unsigned char* gp0 = G + (size_t)row0 * (ZP * 2) + seg * DM + col0;
        u32x2 ga[4][2][2], gb[4][2][2];
#define MG_LOAD(buf, q, TWO) do { _Pragma("unroll") for (int mm = 0; mm < 2; ++mm) _Pragma("unroll") for (int bj = 0; bj < 2; ++bj) { \
            const unsigned char* p_ = gp0 + (size_t)(((q) >> 1) * HALF + (((q) & 1) * 2 + mm) * 16) * (ZP * 2) + bj * 32; \
            ga[buf][mm][bj] = *(const GAS u32x2*)p_; if (TWO) gb[buf][mm][bj] = *(const GAS u32x2*)(p_ + DM); } } while (0)
#define MG_U8(w, e) ((float)((((e) < 4 ? (w).x : (w).y) >> (8 * ((e) & 3))) & 0xffu))
#define MG_SCALE(buf, q) do { _Pragma("unroll") for (int mm = 0; mm < 2; ++mm) _Pragma("unroll") for (int bj = 0; bj < 2; ++bj) { \
            const int ai_ = (q) >> 1, m_ = ((q) & 1) * 2 + mm; const u32x2 a_ = ga[buf][mm][bj], b_ = gb[buf][mm][bj]; \
            _Pragma("unroll") for (int e = 0; e < 8; ++e) acc[ai_][bj][m_][e >> 2][e & 3] *= MG_U8(a_, e) * __builtin_amdgcn_rcpf(MG_U8(b_, e)); } } while (0)
#define MG_STORE(buf, q) do { _Pragma("unroll") for (int mm = 0; mm < 2; ++mm) _Pragma("unroll") for (int bj = 0; bj < 2; ++bj) { \
            const int ai_ = (q) >> 1, m_ = ((q) & 1) * 2 + mm; const u32x2 a_ = ga[buf][mm][bj]; float v_[8]; \
            _Pragma("unroll") for (int e = 0; e < 8; ++e) v_[e] = acc[ai_][bj][m_][e >> 2][e & 3] * (MG_U8(a_, e) * (1.0f / 255.0f)); \
            *(GAS u32x4*)(O + (size_t)(row0 + ai_ * HALF + m_ * 16) * DM + col0 + bj * 32) = pack8(v_); } } while (0)
        if (seg < 3) {
            MG_LOAD(0, 0, true); MG_LOAD(1, 1, true); MG_LOAD(2, 2, true); MG_LOAD(3, 3, true); asm volatile("" ::: "memory");
            MG_SCALE(0, 0); MG_SCALE(1, 1); MG_SCALE(2, 2); MG_SCALE(3, 3);
        } else {
            MG_LOAD(0, 0, false); MG_LOAD(1, 1, false); MG_LOAD(2, 2, false); MG_LOAD(3, 3, false); asm volatile("" ::: "memory");
            MG_STORE(0, 0); MG_STORE(1, 1); MG_STORE(2, 2); MG_STORE(3, 3);
        }
#undef MG_SCALE
#undef MG_STORE
#undef MG_U8
#undef MG_LOAD
    }
};

template <class Epi, class Sched, bool FP8 = false>
__device__ __forceinline__ void gemm_phase(LAS unsigned char* lds, const Gemm g, const Sched& S, const Epi& E, const int tid) {
    const int wid = __builtin_amdgcn_readfirstlane(tid >> 6), lane = tid & 63, wr = wid >> 2, wc = wid & 3, fr = lane & 15, fq = lane >> 4;
    const int nt = g.Kb / 128;
    unsigned voffA[2], voffB[2];
#pragma unroll
    for (int i = 0; i < 2; ++i) { int R, C; stage_rc(tid * 16 + i * 8192, R, C); const int Rb = 64 * (R >> 5) + perm32(R & 31);
        voffA[i] = (unsigned)(R * g.lda_b + C * 2); voffB[i] = (unsigned)(Rb * g.ldb_b + C * 2); }
    const size_t kstep = (size_t)(BK * 2);
    const size_t hstepA = (size_t)HALF * g.lda_b, hstepB = (size_t)32 * g.ldb_b, tstepB = (size_t)BM * g.ldb_b;
    const unsigned ldsw = (unsigned)wid * 1024u;
    const int aoff = lds_byte(wr * 64 + fr, fq * 8), boff = lds_byte(wc * 32 + fr, fq * 8);
#define PG8_APTR(u) ((const char*)g.A + (size_t)(u).pm * 2 * hstepA + (size_t)(u).seg * g.a_seg)
#define PG8_BPTR(u) ((const char*)g.Bt + (size_t)(u).pn * tstepB + (size_t)(u).seg * g.b_seg)
#define PG8_SA(b, h) (((b) * 2 + (h)) * HTB)
#define PG8_SB(b, h) ((4 + (b) * 2 + (h)) * HTB)
#define PG8_STAGE(bufoff, gbase, voff) do { _Pragma("unroll") for (int _i = 0; _i < 2; ++_i) \
        __builtin_amdgcn_global_load_lds((const unsigned*)((const char*)(gbase) + (voff)[_i]), (LAS unsigned*)(lds + (bufoff) + ldsw + _i * 8192), 16, 0, 0); } while (0)
#define PG8_LDA(dst, b, h) do { _Pragma("unroll") for (int m = 0; m < 4; ++m) { \
        if constexpr (FP8) dst##8[m] = cat8(*(const LAS u32x4*)(lds + PG8_SA(b, h) + aoff + m * 2048), *(const LAS u32x4*)(lds + PG8_SA(b, h) + aoff + m * 2048 + 1024)); \
        else { _Pragma("unroll") for (int k = 0; k < 2; ++k) dst[m][k] = *(const LAS bf16x8*)(lds + PG8_SA(b, h) + aoff + m * 2048 + k * 1024); } } } while (0)
#define PG8_LDB(dst, b, h) do { _Pragma("unroll") for (int n = 0; n < 2; ++n) { \
        if constexpr (FP8) dst##8[n] = cat8(*(const LAS u32x4*)(lds + PG8_SB(b, h) + boff + n * 2048), *(const LAS u32x4*)(lds + PG8_SB(b, h) + boff + n * 2048 + 1024)); \
        else { _Pragma("unroll") for (int k = 0; k < 2; ++k) dst[n][k] = *(const LAS bf16x8*)(lds + PG8_SB(b, h) + boff + n * 2048 + k * 1024); } } } while (0)
#define PG8_MMA(ai, bj, At, Bt) do { __builtin_amdgcn_s_setprio(1); \
        if constexpr (FP8) { _Pragma("unroll") for (int m = 0; m < 4; ++m) _Pragma("unroll") for (int n = 0; n < 2; ++n) \
            asm volatile("v_mfma_f32_16x16x128_f8f6f4 %0, %1, %2, %0" : "+v"(acc[ai][bj][m][n]) : "v"(Bt##8[n]), "v"(At##8[m])); } \
        else { _Pragma("unroll") for (int m = 0; m < 4; ++m) _Pragma("unroll") for (int n = 0; n < 2; ++n) _Pragma("unroll") for (int k = 0; k < 2; ++k) \
            acc[ai][bj][m][n] = __builtin_amdgcn_mfma_f32_16x16x32_bf16(Bt[n][k], At[m][k], acc[ai][bj][m][n], 0, 0, 0); } \
        __builtin_amdgcn_s_setprio(0); } while (0)
#define PG8_WAIT_V(n) asm volatile("s_waitcnt vmcnt(" #n ")" ::: "memory")
#define PG8_WAIT_L(n) asm volatile("s_waitcnt lgkmcnt(" #n ")" ::: "memory")
#define PG8_BAR __builtin_amdgcn_s_barrier()
#define PG8_SCHED __builtin_amdgcn_sched_barrier(0)
    Unit cur, nxt; int ui = 0;
    if (!S.next(0, cur)) return;
    Acc acc;
#pragma unroll
    for (int a = 0; a < 2; ++a)
#pragma unroll
        for (int b = 0; b < 2; ++b)
#pragma unroll
            for (int m = 0; m < 4; ++m)
#pragma unroll
                for (int n = 0; n < 2; ++n) acc[a][b][m][n] = (f32x4){0.f, 0.f, 0.f, 0.f};
    bf16x8 At[4][2], B0[2][2], B1[2][2]; v8i_t At8[4], B08[2], B18[2];
    const char* cA = PG8_APTR(cur); const char* cB = PG8_BPTR(cur);
#define PG8_RS(par, pm_) do { if constexpr (Epi::NEEDS_RS) __builtin_amdgcn_global_load_lds((const unsigned*)(E.part + (size_t)(pm_) * BM * 8 + wid * 256 + lane * 4), \
        (LAS unsigned*)(lds + ((par) ? RS_OFF1 : RS_OFF0) + ldsw), 16, 0, 0); } while (0)
    PG8_RS(0, cur.pm);
    PG8_STAGE(PG8_SB(0, 0), cB, voffB); PG8_STAGE(PG8_SB(0, 1), cB + hstepB, voffB); PG8_STAGE(PG8_SA(0, 0), cA, voffA); PG8_STAGE(PG8_SA(0, 1), cA + hstepA, voffA);
    if (wr == 1) PG8_BAR;
    PG8_WAIT_V(2); PG8_BAR;
    PG8_STAGE(PG8_SB(1, 0), cB + kstep, voffB); PG8_STAGE(PG8_SA(1, 0), cA + kstep, voffA); PG8_STAGE(PG8_SB(1, 1), cB + hstepB + kstep, voffB);
    PG8_WAIT_V(6); PG8_BAR;
    for (;;) {
        const bool has_next = S.next(ui + 1, nxt);
        const char* nA = has_next ? PG8_APTR(nxt) : cA; const char* nB = has_next ? PG8_BPTR(nxt) : cB;
        for (int t = 0; t < nt; t += 2) {
            const bool last = (t == nt - 2);
            const char* a1 = cA + (size_t)(t + 1) * kstep;
            const char* a2 = last ? nA : cA + (size_t)(t + 2) * kstep; const char* b2 = last ? nB : cB + (size_t)(t + 2) * kstep;
            const char* a3 = a2 + kstep; const char* b3 = b2 + kstep;
            PG8_LDB(B0, 0, 0); PG8_LDB(B1, 0, 1); PG8_SCHED; PG8_LDA(At, 0, 0); PG8_STAGE(PG8_SA(1, 1), a1 + hstepA, voffA);
            PG8_WAIT_V(8); PG8_WAIT_L(0); PG8_BAR; PG8_MMA(0, 0, At, B0); PG8_MMA(0, 1, At, B1); PG8_BAR; PG8_SCHED;
            PG8_LDA(At, 0, 1); PG8_STAGE(PG8_SB(0, 0), b2, voffB); PG8_STAGE(PG8_SB(0, 1), b2 + hstepB, voffB); PG8_STAGE(PG8_SA(0, 0), a2, voffA);
            PG8_WAIT_V(8); PG8_WAIT_L(0); PG8_BAR; PG8_MMA(1, 0, At, B0); PG8_MMA(1, 1, At, B1); PG8_BAR; PG8_SCHED;
            PG8_LDB(B0, 1, 0); PG8_LDB(B1, 1, 1); PG8_SCHED; PG8_LDA(At, 1, 0); PG8_STAGE(PG8_SA(0, 1), a2 + hstepA, voffA);
            PG8_WAIT_V(8); PG8_WAIT_L(0); PG8_BAR; PG8_MMA(0, 0, At, B0); PG8_MMA(0, 1, At, B1); PG8_BAR; PG8_SCHED;
            PG8_LDA(At, 1, 1); PG8_STAGE(PG8_SB(1, 0), b3, voffB); PG8_STAGE(PG8_SB(1, 1), b3 + hstepB, voffB); PG8_STAGE(PG8_SA(1, 0), a3, voffA);
            PG8_WAIT_V(8); PG8_WAIT_L(0); PG8_BAR; PG8_MMA(1, 0, At, B0); PG8_MMA(1, 1, At, B1); PG8_BAR; PG8_SCHED;
        }
        if (wr == 0) PG8_BAR;
        if (has_next) PG8_RS((ui + 1) & 1, nxt.pm);
        if constexpr (FP8) { asm volatile("s_nop 15\n\ts_nop 15" ::: "memory"); __builtin_amdgcn_sched_barrier(0); }
        E(acc, cur, wr, wc, fr, fq, (const LAS float*)(lds + ((ui & 1) ? RS_OFF1 : RS_OFF0)));
        if (!has_next) break;
        if (!E.keep(cur)) {
#pragma unroll
            for (int a = 0; a < 2; ++a)
#pragma unroll
                for (int b = 0; b < 2; ++b)
#pragma unroll
                    for (int m = 0; m < 4; ++m)
#pragma unroll
                        for (int n = 0; n < 2; ++n) acc[a][b][m][n] = (f32x4){0.f, 0.f, 0.f, 0.f};
        }
        cur = nxt; cA = nA; cB = nB; ++ui;
        if (wr == 1) PG8_BAR;
    }
    PG8_WAIT_V(0);
    PG8_BAR;
#undef PG8_APTR
#undef PG8_BPTR
#undef PG8_SA
#undef PG8_SB
#undef PG8_STAGE
#undef PG8_RS
#undef PG8_LDA
#undef PG8_LDB
#undef PG8_MMA
#undef PG8_WAIT_V
#undef PG8_WAIT_L
#undef PG8_BAR
#undef PG8_SCHED
}
}

constexpr size_t MiB = 1u << 20;
constexpr size_t WS_CTL = 0, CTL_ZERO_BYTES = 1 * MiB;
constexpr size_t WS_KSUM = 1 * MiB;
constexpr size_t WS_TAB = 1 * MiB + 512 * 1024;
constexpr size_t WS_WSB = 1 * MiB + 768 * 1024;
constexpr size_t WS_LIST = 2 * MiB;
constexpr size_t WS_LSLOT = 10 * MiB;
constexpr size_t WS_W = 16 * MiB;
constexpr size_t W_IN_OFF = 0, W_OUT_OFF = 52 * MiB, W_O_OFF = 60 * MiB, W_MI_OFF = 68 * MiB, W_MO_OFF = 100 * MiB;
constexpr size_t WS_ACTA = 148 * MiB;
constexpr size_t WS_U = 276 * MiB;
constexpr size_t WS_Z = 404 * MiB;
constexpr size_t WS_OSLOT = 1236 * MiB;
constexpr size_t WS_H8 = 1428 * MiB;
constexpr size_t WS_XB = 1492 * MiB;
constexpr size_t WS_END = 1620 * MiB;
constexpr size_t WS_PART = 12 * MiB;
constexpr size_t W_G8_OFF = 20 * MiB;
constexpr int CW_TMO = 0, CW_BAR = 4096, CW_CNT = 16384;

constexpr int MISC_OFF = 143360;
constexpr int LDS_BYTES = 155648;

#define XB_TMO      128
#define XB_XCNT(j)  (256  + 64 * (j))
#define XB_XSUB(j)  (1280 + 64 * (j))
#define XB_XGEN(j)  (2304 + 64 * (j))
#define XB_TOP      3328
#define XB_TOPGEN   3392
#define XCD_BAR_WORDS 3456
#define XB_SPIN_CAP (1u << 18)
__device__ __forceinline__ unsigned xb_ld(unsigned* p)              { return __hip_atomic_load(p, __ATOMIC_RELAXED, __HIP_MEMORY_SCOPE_AGENT); }
__device__ __forceinline__ unsigned xb_add(unsigned* p, unsigned v) { return __hip_atomic_fetch_add(p, v, __ATOMIC_RELAXED, __HIP_MEMORY_SCOPE_AGENT); }
__device__ __forceinline__ unsigned xb_xcc_id() { return (unsigned)__builtin_amdgcn_s_getreg((3 << 11) | 20) & 0xFu; }
#define XB_SPIN(cond, bar) do { unsigned _sp = 0; while (cond) { __builtin_amdgcn_s_sleep(1); \
    if ((++_sp & 255u) == 0u) { if (xb_ld(&(bar)[XB_TMO])) break; if (_sp > XB_SPIN_CAP) { atomicAdd(&(bar)[XB_TMO], 1u); break; } } } } while (0)
struct XcdBarrier { unsigned* bar; unsigned x; volatile LAS unsigned* st; };
__device__ __forceinline__ XcdBarrier xcd_barrier_post(unsigned* bar, volatile LAS unsigned* st) {
    XcdBarrier b; b.bar = bar; b.x = xb_xcc_id(); b.st = st;
    if (threadIdx.x == 0) (void)xb_add(&bar[XB_XCNT(b.x)], 1u);
    return b;
}
__device__ __forceinline__ void xcd_barrier_complete(unsigned* bar, unsigned x, unsigned& nloc, unsigned& nx) {
    const unsigned G = gridDim.x * gridDim.y * gridDim.z;
    unsigned sum, cnt, mine, sp = 0u;
    for (;;) {
        sum = 0u; cnt = 0u; mine = 0u;
#pragma unroll
        for (unsigned j = 0; j < 16; ++j) { const unsigned c = xb_ld(&bar[XB_XCNT(j)]); sum += c; cnt += (c > 0u) ? 1u : 0u; mine = (j == x) ? c : mine; }
        if (sum == G) break;
        __builtin_amdgcn_s_sleep(1);
        if ((++sp & 255u) == 0u) { if (xb_ld(&bar[XB_TMO])) break; if (sp > XB_SPIN_CAP) { atomicAdd(&bar[XB_TMO], 1u); break; } }
    }
    nloc = mine > 0u ? mine : 1u; nx = cnt > 0u ? cnt : 1u;
}
__device__ __forceinline__ void xcd_barrier(const XcdBarrier& b) {
    asm volatile("s_waitcnt vmcnt(0)" ::: "memory");
    __syncthreads();
    if (threadIdx.x == 0) {
        unsigned* bar = b.bar;
        __builtin_amdgcn_s_waitcnt(0);
        unsigned nloc = b.st[0], nx = b.st[1];
        if (nloc == 0u) { xcd_barrier_complete(bar, b.x, nloc, nx); b.st[0] = nloc; b.st[1] = nx; }
        const unsigned old = xb_add(&bar[XB_XSUB(b.x)], 1u);
        const unsigned gen = old / nloc;
        if (old + 1u == (gen + 1u) * nloc) {
            __builtin_amdgcn_fence(__ATOMIC_RELEASE, "agent");
            asm volatile("s_waitcnt vmcnt(0)" ::: "memory");
            const unsigned og = xb_add(&bar[XB_TOP], 1u);
            const unsigned tg = og / nx;
            if (og + 1u == (tg + 1u) * nx) xb_add(&bar[XB_TOPGEN], 1u);
            else XB_SPIN(xb_ld(&bar[XB_TOPGEN]) == tg, bar);
            __builtin_amdgcn_fence(__ATOMIC_ACQUIRE, "agent");
            xb_add(&bar[XB_XGEN(b.x)], 1u);
            asm volatile("s_waitcnt vmcnt(0)" ::: "memory");
        } else {
            XB_SPIN(xb_ld(&bar[XB_XGEN(b.x)]) == gen, bar);
            __builtin_amdgcn_fence(__ATOMIC_ACQUIRE, "agent");
            asm volatile("s_waitcnt vmcnt(0)" ::: "memory");
        }
    }
    __syncthreads();
}

struct Args { const float* in[23]; float* out; unsigned char* ws; };
#define LDS_WAIT() asm volatile("s_waitcnt lgkmcnt(0)" ::: "memory")

template <bool FP8>
__device__ __forceinline__ void transpose_item(const float* W, const float* gk, int K, int N, void* WTv, int n_first, LAS float* scr, int item, int lane) {
    const int nblk = N / 64, kb = item / nblk, nb = item % nblk, k0 = 64 * kb, n0 = 64 * nb;
    const int lr = lane >> 4, lc = lane & 15;
    f32x4 v[16];
#pragma unroll
    for (int i = 0; i < 16; ++i) v[i] = *(const GAS f32x4*)(W + (size_t)(k0 + 4 * i + lr) * N + n0 + 4 * lc);
#pragma unroll
    for (int i = 0; i < 16; ++i) { const int kk = 4 * i + lr; *(LAS f32x4*)(scr + kk * 68 + 4 * (lc ^ ((kk >> 3) & 7))) = v[i]; }
    LDS_WAIT(); asm volatile("" ::: "memory");
    if constexpr (!FP8) {
        bf16_t* WT = (bf16_t*)WTv; const int c = lane & 7;
        float g8[8];
#pragma unroll
        for (int e = 0; e < 8; ++e) g8[e] = gk ? gk[k0 + 8 * c + e] : 1.0f;
#pragma unroll
        for (int j = 0; j < 8; ++j) { const int n = (lane >> 3) + 8 * j; const LAS float* sp = scr + (8 * c) * 68 + 4 * ((n >> 2) ^ c) + (n & 3);
            u32x4 o; o.x = pk2(sp[0 * 68] * g8[0], sp[1 * 68] * g8[1]); o.y = pk2(sp[2 * 68] * g8[2], sp[3 * 68] * g8[3]); o.z = pk2(sp[4 * 68] * g8[4], sp[5 * 68] * g8[5]); o.w = pk2(sp[6 * 68] * g8[6], sp[7 * 68] * g8[7]);
            *(GAS u32x4*)(WT + (size_t)(n0 - n_first + n) * K + k0 + 8 * c) = o; }
    } else {
        unsigned char* W8 = (unsigned char*)WTv; const int c = lane & 3;
        float g16[16];
#pragma unroll
        for (int e = 0; e < 16; ++e) g16[e] = gk[k0 + 16 * c + e] * 64.f;
#pragma unroll
        for (int j = 0; j < 4; ++j) { const int n = (lane >> 2) + 16 * j; float t[16];
#pragma unroll
            for (int e = 0; e < 16; ++e) t[e] = scr[(16 * c + e) * 68 + 4 * ((n >> 2) ^ ((2 * c + (e >> 3)) & 7)) + (n & 3)] * g16[e];
            u32x4 o;
#pragma unroll
            for (int q = 0; q < 4; ++q) { int w = __builtin_amdgcn_cvt_pk_fp8_f32(t[4 * q], t[4 * q + 1], 0, false); w = __builtin_amdgcn_cvt_pk_fp8_f32(t[4 * q + 2], t[4 * q + 3], w, true); o[q] = (unsigned)w; }
            *(GAS u32x4*)(W8 + (size_t)(n0 - n_first + n) * K + k0 + 16 * c) = o; }
    }
    LDS_WAIT(); asm volatile("" ::: "memory");
}

__device__ __forceinline__ int rel_bucket(int n) {
    if (n < 16) return n;
    int b = 16;
    b += (n >= 22); b += (n >= 30); b += (n >= 40); b += (n >= 54); b += (n >= 73); b += (n >= 99); b += (n >= 134); b += (n >= 182);
    b += (n >= 246); b += (n >= 332); b += (n >= 450); b += (n >= 609); b += (n >= 825); b += (n >= 1117); b += (n >= 1513);
    return b;
}

__device__ __forceinline__ void x_rows_in(const float* x, bf16_t* xb, unsigned char* x8, float* part, int gw, int ngw, int lane) {
    for (int m = gw; m < MROWS; m += ngw) {
        const GAS f32x4* xr = (const GAS f32x4*)(x + (size_t)m * DM) + lane;
        f32x4 v[8]; float s = 0.f;
#pragma unroll
        for (int j = 0; j < 8; ++j) { v[j] = xr[64 * j]; s += (v[j].x * v[j].x + v[j].y * v[j].y) + (v[j].z * v[j].z + v[j].w * v[j].w); }
        s = wave_sum(s);
        GAS u32x2* o8 = (GAS u32x2*)(xb + (size_t)m * DM) + lane;
#pragma unroll
        for (int j = 0; j < 8; ++j) { u32x2 w; w.x = pk2(v[j].x, v[j].y); w.y = pk2(v[j].z, v[j].w); o8[64 * j] = w;
            int f = __builtin_amdgcn_cvt_pk_fp8_f32(v[j].x, v[j].y, 0, false); f = __builtin_amdgcn_cvt_pk_fp8_f32(v[j].z, v[j].w, f, true); *((GAS unsigned*)(x8 + (size_t)m * DM) + lane + 64 * j) = (unsigned)f; }
        if (lane < 8) part[(size_t)m * 8 + lane] = lane == 0 ? s : 0.f;
    }
}

__device__ __forceinline__ unsigned off_b(unsigned row, unsigned ch) { return 256u * row + 16u * (ch ^ (((row & 3) << 2) | ((row >> 2) & 3))); }
__device__ __forceinline__ s16x4 vtr(const LAS unsigned char* p) { typedef short v4i16_t __attribute__((ext_vector_type(4))); return __builtin_bit_cast(s16x4, __builtin_amdgcn_ds_read_tr16_b64_v4i16((LAS v4i16_t*)p)); }
__device__ __forceinline__ int crow(int r, int hi) { return (r & 3) + 8 * (r >> 2) + 4 * hi; }

__device__ __forceinline__ void store_o_bf16(bf16_t* p, const f32x16 (&o)[4], float scale, int hi) {
#pragma unroll
    for (int c = 0; c < 4; ++c)
#pragma unroll
        for (int kp = 0; kp < 2; ++kp) {
            unsigned ax = pk2(o[c][8 * kp] * scale, o[c][8 * kp + 1] * scale), ay = pk2(o[c][8 * kp + 2] * scale, o[c][8 * kp + 3] * scale);
            unsigned bx = pk2(o[c][8 * kp + 4] * scale, o[c][8 * kp + 5] * scale), by = pk2(o[c][8 * kp + 6] * scale, o[c][8 * kp + 7] * scale);
            auto r0 = __builtin_amdgcn_permlane32_swap(ax, bx, false, false); auto r1 = __builtin_amdgcn_permlane32_swap(ay, by, false, false);
            *(GAS u32x4*)(p + 32 * c + 16 * kp + 8 * hi) = (u32x4){r0[0], r1[0], r0[1], r1[1]};
        }
}
__device__ __forceinline__ void load_add_o_bf16(const bf16_t* p, f32x16 (&o)[4], int hi) {
    u32x4 L[4][2];
#pragma unroll
    for (int c = 0; c < 4; ++c)
#pragma unroll
        for (int kp = 0; kp < 2; ++kp) L[c][kp] = *(const GAS u32x4*)(p + 32 * c + 16 * kp + 8 * hi);
#pragma unroll
    for (int c = 0; c < 4; ++c)
#pragma unroll
        for (int kp = 0; kp < 2; ++kp) {
            auto r0 = __builtin_amdgcn_permlane32_swap(L[c][kp].x, L[c][kp].z, false, false); auto r1 = __builtin_amdgcn_permlane32_swap(L[c][kp].y, L[c][kp].w, false, false);
            o[c][8 * kp] += bflo(r0[0]); o[c][8 * kp + 1] += bfhi(r0[0]); o[c][8 * kp + 2] += bflo(r1[0]); o[c][8 * kp + 3] += bfhi(r1[0]);
            o[c][8 * kp + 4] += bflo(r0[1]); o[c][8 * kp + 5] += bfhi(r0[1]); o[c][8 * kp + 6] += bflo(r1[1]); o[c][8 * kp + 7] += bfhi(r1[1]);
        }
}

template <bool CAUSAL>
__device__ __forceinline__ void attn_core(const LAS unsigned char* ldsK, const LAS unsigned char* ldsV, const LAS float* tab, const bf16x8 (&qf)[8], int qrel, int ntiles, int lane, f32x16 (&o)[4], float& lsum) {
    const int r32 = lane & 31, hi = lane >> 5, blk16 = (lane >> 4) & 1, q4 = (lane & 15) >> 2, p4 = lane & 3;
    unsigned vlow[2], vc[4];
#pragma unroll
    for (int t = 0; t < 2; ++t) vlow[t] = 256u * (8 * t + 4 * hi + q4) + 16u * ((unsigned)(2 * blk16 + (p4 >> 1)) ^ (unsigned)((2 * t + hi) & 3)) + 8u * (p4 & 1);
#pragma unroll
    for (int c = 0; c < 4; ++c) vc[c] = 64u * (unsigned)(c ^ q4);
    unsigned koff[8], voff[2][4];
    unsigned vrel = (unsigned)(ldsV - ldsK); asm volatile("" : "+v"(vrel));
#pragma unroll
    for (int s = 0; s < 8; ++s) koff[s] = off_b(r32, 2 * s + hi);
#pragma unroll
    for (int t = 0; t < 2; ++t)
#pragma unroll
        for (int c = 0; c < 4; ++c) voff[t][c] = vrel + vlow[t] + vc[c];
    for (int kt = 0; kt < ntiles; ++kt) {
        const int dbase = qrel - 64 * kt - 4 * hi;
        const LAS float* tq = tab + (TREV - (dbase < 0 ? 0 : (dbase > TREV ? TREV : dbase)));
        f32x16 s0, s1;
#pragma unroll
        for (int r = 0; r < 16; ++r) { s0[r] = tq[(r & 3) + 8 * (r >> 2)]; s1[r] = tq[32 + (r & 3) + 8 * (r >> 2)]; }
        const unsigned kb = 16384u * (unsigned)kt;
        bf16x8 a0 = *(const LAS bf16x8*)(ldsK + (koff[0] + kb)), a1 = *(const LAS bf16x8*)(ldsK + (koff[0] + kb) + 8192);
#pragma unroll
        for (int s = 0; s < 8; ++s) {
            bf16x8 n0 = a0, n1 = a1;
            if (s < 7) { const LAS unsigned char* ka = ldsK + (koff[s + 1] + kb); n0 = *(const LAS bf16x8*)ka; n1 = *(const LAS bf16x8*)(ka + 8192); }
            __builtin_amdgcn_sched_barrier(0x6);
            s0 = __builtin_amdgcn_mfma_f32_32x32x16_bf16(a0, qf[s], s0, 0, 0, 0);
            s1 = __builtin_amdgcn_mfma_f32_32x32x16_bf16(a1, qf[s], s1, 0, 0, 0);
            __builtin_amdgcn_sched_barrier(0x6);
            a0 = n0; a1 = n1;
        }
#pragma unroll
        for (int r = 0; r < 16; ++r) {
            float p0 = __builtin_amdgcn_exp2f(s0[r]), p1 = __builtin_amdgcn_exp2f(s1[r]);
            if (CAUSAL) { const int e0 = (r & 3) + 8 * (r >> 2); p0 = dbase < e0 ? 0.f : p0; p1 = dbase < e0 + 32 ? 0.f : p1; }
            s0[r] = p0; s1[r] = p1;
        }
        bf16x8 pf[4];
        typedef __bf16 bf16x2_t __attribute__((ext_vector_type(2)));
        const bf16x2_t ones = __builtin_bit_cast(bf16x2_t, 0x3f803f80u);
#pragma unroll
        for (int s = 0; s < 2; ++s) {
            u32x4 w0, w1;
            w0.x = pk2(s0[8 * s + 0], s0[8 * s + 1]); w0.y = pk2(s0[8 * s + 2], s0[8 * s + 3]); w0.z = pk2(s0[8 * s + 4], s0[8 * s + 5]); w0.w = pk2(s0[8 * s + 6], s0[8 * s + 7]);
            w1.x = pk2(s1[8 * s + 0], s1[8 * s + 1]); w1.y = pk2(s1[8 * s + 2], s1[8 * s + 3]); w1.z = pk2(s1[8 * s + 4], s1[8 * s + 5]); w1.w = pk2(s1[8 * s + 6], s1[8 * s + 7]);
#pragma unroll
            for (int d = 0; d < 4; ++d) { const unsigned u0 = w0[d], u1 = w1[d];
                lsum = __builtin_amdgcn_fdot2_f32_bf16(__builtin_bit_cast(bf16x2_t, u0), ones, lsum, false); lsum = __builtin_amdgcn_fdot2_f32_bf16(__builtin_bit_cast(bf16x2_t, u1), ones, lsum, false); }
            pf[s] = __builtin_bit_cast(bf16x8, w0); pf[2 + s] = __builtin_bit_cast(bf16x8, w1);
        }
        s16x4 lo = vtr(ldsK + (voff[0][0] + kb)), hh = vtr(ldsK + (voff[1][0] + kb));
#pragma unroll
        for (int i = 0; i < 16; ++i) { const int c = i >> 2, ks = i & 3;
            s16x4 nlo = lo, nhh = hh;
            if (i < 15) { const int c2 = (i + 1) >> 2, ks2 = (i + 1) & 3; nlo = vtr(ldsK + (voff[0][c2] + kb) + 4096 * ks2); nhh = vtr(ldsK + (voff[1][c2] + kb) + 4096 * ks2); }
            __builtin_amdgcn_sched_barrier(0x6);
            const bf16x8 vf = (bf16x8){lo[0], lo[1], lo[2], lo[3], hh[0], hh[1], hh[2], hh[3]};
            o[c] = __builtin_amdgcn_mfma_f32_32x32x16_bf16(vf, pf[ks], o[c], 0, 0, 0);
            __builtin_amdgcn_sched_barrier(0x6);
            lo = nlo; hh = nhh;
        }
    }
}

__device__ __forceinline__ void load_kv(const bf16_t* Z, const float* tabg, LAS unsigned char* ldsK, LAS unsigned char* ldsV, LAS float* tab, float M2, int b, int h, int j, int tid) {
    const bf16_t* kbase = Z + (size_t)(b * SEQ + j * 256) * ZP + OFF_D + 512 + h * HD;
#pragma unroll
    for (int i = 0; i < 8; ++i) { const int idx = tid + 512 * i, row = idx >> 4, ch = idx & 15;
        const u32x4 kv = ldg16(kbase + (size_t)row * ZP + 8 * ch), vv = ldg16(kbase + (size_t)row * ZP + 512 + 8 * ch);
        *(LAS u32x4*)(ldsK + off_b(row, ch)) = kv; *(LAS u32x4*)(ldsV + off_b(row, ch)) = vv; }
    for (int i = tid; i < TABP; i += 512) { const int d = TREV - i; tab[i] = tabg[h * TABN + (d < 0 ? 0 : (d > TABN - 1 ? TABN - 1 : d))] - M2; }
}

__global__ void __launch_bounds__(512, 2) fwd(Args args) {
    extern __shared__ __attribute__((aligned(16))) unsigned char lds_raw[];
    LAS unsigned char* lds = (LAS unsigned char*)lds_raw;
    volatile LAS unsigned* MISC = (volatile LAS unsigned*)(lds + MISC_OFF);
    const int G = gridDim.x, bx = blockIdx.x;
    const int vcu = (G % 8 == 0) ? (bx % 8) * (G / 8) + bx / 8 : bx;
    const int ngw = G * 8;
    { const int tid0 = threadIdx.x; for (int u = tid0; u < (LDS_BYTES - MISC_OFF) / 4; u += 512) ((LAS unsigned*)(lds + MISC_OFF))[u] = 0u; }
    __syncthreads();
    XcdBarrier bar = xcd_barrier_post((unsigned*)(args.ws + WS_CTL) + CW_BAR, MISC + 8);
    float* xout = args.out;
#define LANE_VARS const int tid = opaque_tid(); const int lane = tid & 63; const int wave = __builtin_amdgcn_readfirstlane(tid >> 6); const int gw = vcu * 8 + wave; (void)tid; (void)lane; (void)wave; (void)gw;
#define PHASE_VARS \
    const int tid = opaque_tid(); const int lane = tid & 63; const int wave = __builtin_amdgcn_readfirstlane(tid >> 6); const int gw = vcu * 8 + wave; \
    unsigned char* ws = opaque_ptr(args.ws); unsigned* ctl = (unsigned*)(ws + WS_CTL); \
    float* ksum = (float*)(ws + WS_KSUM); float* tabg = (float*)(ws + WS_TAB); bf16_t* Wsb = (bf16_t*)(ws + WS_WSB); \
    unsigned short* lists = (unsigned short*)(ws + WS_LIST); float* lslot = (float*)(ws + WS_LSLOT); \
    bf16_t* Wt_in = (bf16_t*)(ws + WS_W + W_IN_OFF); bf16_t* Wt_out = (bf16_t*)(ws + WS_W + W_OUT_OFF); bf16_t* Wt_o = (bf16_t*)(ws + WS_W + W_O_OFF); \
    bf16_t* Wt_mi = (bf16_t*)(ws + WS_W + W_MI_OFF); bf16_t* Wt_mo = (bf16_t*)(ws + WS_W + W_MO_OFF); \
    unsigned char* h8 = ws + WS_H8; unsigned char* Wg8 = ws + WS_W + W_G8_OFF; bf16_t* xb = (bf16_t*)(ws + WS_XB); float* part = (float*)(ws + WS_PART); (void)h8; (void)Wg8; (void)xb; (void)part; \
    bf16_t* actA = (bf16_t*)(ws + WS_ACTA); bf16_t* U = (bf16_t*)(ws + WS_U); bf16_t* Z = (bf16_t*)(ws + WS_Z); float* oslot = (float*)(ws + WS_OSLOT); \
    (void)tid; (void)lane; (void)wave; (void)gw; (void)ctl; (void)ksum; (void)tabg; (void)Wsb; (void)lists; (void)lslot; (void)Wt_in; (void)Wt_out; (void)Wt_o; (void)Wt_mi; (void)Wt_mo; (void)actA; (void)U; (void)Z; (void)oslot;

    for (int l = 0; l < DEPTH; ++l) {
        if (PH_MASK & (1 << 0)) REP(0) { PHASE_VARS
            LAS float* scr = (LAS float*)(lds + wave * 17408);
            constexpr int I_IN = (DM / 64) * (ZP / 64), I_OUT1 = (512 / 64) * (DM / 64), I_O = (DM / 64) * (DM / 64), I_MI = (DM / 64) * (DFF / 64), I_MO = (DFF / 64) * (DM / 64);
            constexpr int NITEMS = I_IN + 4 * I_OUT1 + I_O + I_MI + I_MO;
            const float* w_in = args.in[3] + (size_t)l * DM * ZP;
            const float* w_oa = args.in[5] + (size_t)l * 512 * DM; const float* w_ob = args.in[10] + (size_t)l * 512 * DM;
            const float* w_oc = args.in[15] + (size_t)l * 512 * DM; const float* w_od = args.in[18] + (size_t)l * 512 * DM;
            const float* gmix = args.in[2] + (size_t)l * DM; const float* gmlp = args.in[20] + (size_t)l * DM;
            const float* w_o = args.in[19] + (size_t)l * DM * DM; const float* w_mi = args.in[21] + (size_t)l * DM * DFF; const float* w_mo = args.in[22] + (size_t)l * DFF * DM;
            for (int it = gw; it < NITEMS; it += ngw) {
                int r = it;
                if (r < I_IN) { if ((r % (ZP / 64)) < OFF_G / 64) transpose_item<false>(w_in, gmix, DM, ZP, Wt_in, 0, scr, r, lane); else transpose_item<true>(w_in, gmix, DM, ZP, Wg8, OFF_G, scr, r, lane); continue; } r -= I_IN;
                if (r < I_OUT1) { transpose_item<false>(w_oa, nullptr, 512, DM, Wt_out, 0, scr, r, lane); continue; } r -= I_OUT1;
                if (r < I_OUT1) { transpose_item<false>(w_ob, nullptr, 512, DM, Wt_out + (size_t)DM * 512, 0, scr, r, lane); continue; } r -= I_OUT1;
                if (r < I_OUT1) { transpose_item<false>(w_oc, nullptr, 512, DM, Wt_out + (size_t)2 * DM * 512, 0, scr, r, lane); continue; } r -= I_OUT1;
                if (r < I_OUT1) { transpose_item<false>(w_od, nullptr, 512, DM, Wt_out + (size_t)3 * DM * 512, 0, scr, r, lane); continue; } r -= I_OUT1;
                if (r < I_O) { transpose_item<false>(w_o, nullptr, DM, DM, Wt_o, 0, scr, r, lane); continue; } r -= I_O;
                if (r < I_MI) { transpose_item<false>(w_mi, gmlp, DM, DFF, Wt_mi, 0, scr, r, lane); continue; } r -= I_MI;
                transpose_item<false>(w_mo, nullptr, DFF, DM, Wt_mo, 0, scr, r, lane);
            }
            const float* wsp = args.in[13] + (size_t)l * 4 * 128 * 128;
            for (int e = bx * 512 + tid; e < 4 * 128 * 128; e += G * 512) { const int t = (e >> 7) & 127, s = e & 127; Wsb[e] = (bf16_t)(pk2(s <= t ? wsp[e] : 0.f, 0.f) & 0xffffu); }
            if (l == 0) for (int e = bx * 512 + tid; e < NH * TABN; e += G * 512) { const int h = e / TABN, d = e % TABN; tabg[e] = args.in[1][rel_bucket(d) * NH + h] * LOG2E; }
            if (l == 0) x_rows_in(args.in[0], xb, h8, part, gw, ngw, lane);
        }
        xcd_barrier(bar);
        if (PH_MASK & (1 << 1)) REP(1) { PHASE_VARS
            { pg8::Gemm g{xb, Wt_in, DM * 2, DM * 2, DM * 2, 0, 0}; pg8::StaticOrder<0> S; S.init(MROWS, OFF_G, G, bx);
              pg8::EpiZ E{Z, part, 0, 0, 1.0f};
              pg8::gemm_phase<pg8::EpiZ, pg8::StaticOrder<0>, false>(lds, g, S, E, tid); }
        }
        xcd_barrier(bar);
        if (PH_MASK & (1 << 2)) { PHASE_VARS
            REP(11) { LANE_VARS
                const float* cw = args.in[4] + (size_t)l * 3 * 512;
                for (int unit = vcu; unit < MROWS / 128; unit += G) {
                    const int c8 = 8 * lane;
                    float w[3][8];
#pragma unroll
                    for (int k = 0; k < 3; ++k) { const f32x4 w0 = *(const GAS f32x4*)(cw + k * 512 + c8), w1 = *(const GAS f32x4*)(cw + k * 512 + c8 + 4);
#pragma unroll
                        for (int e = 0; e < 4; ++e) { w[k][e] = w0[e]; w[k][4 + e] = w1[e]; } }
                    const int t0 = unit * 128 + wave * 16, tseq0 = t0 & (SEQ - 1);
                    float h2[8], h1[8];
                    { const int r2 = tseq0 >= 2 ? t0 - 2 : t0, r1 = tseq0 >= 1 ? t0 - 1 : t0; const float m2 = tseq0 >= 2 ? 1.f : 0.f, m1 = tseq0 >= 1 ? 1.f : 0.f;
                      float a2[8], x2[8], a1[8], x1[8];
                      unpack8(ldg16(Z + (size_t)r2 * ZP + OFF_A + 512 + c8), a2); unpack8(ldg16(Z + (size_t)r2 * ZP + OFF_A + 1024 + c8), x2);
                      unpack8(ldg16(Z + (size_t)r1 * ZP + OFF_A + 512 + c8), a1); unpack8(ldg16(Z + (size_t)r1 * ZP + OFF_A + 1024 + c8), x1);
#pragma unroll
                      for (int e = 0; e < 8; ++e) { h2[e] = a2[e] * x2[e] * m2; h1[e] = a1[e] * x1[e] * m1; } }
#pragma unroll
                    for (int gq = 0; gq < 4; ++gq) {
                        u32x4 rb[4], rc[4], rx[4];
#pragma unroll
                        for (int q = 0; q < 4; ++q) { const bf16_t* zp = Z + (size_t)(t0 + 4 * gq + q) * ZP + OFF_A + c8; rb[q] = ldg16(zp); rc[q] = ldg16(zp + 512); rx[q] = ldg16(zp + 1024); }
#pragma unroll
                        for (int q = 0; q < 4; ++q) {
                            float ab[8], ac[8], ax[8], o[8]; unpack8(rb[q], ab); unpack8(rc[q], ac); unpack8(rx[q], ax);
#pragma unroll
                            for (int e = 0; e < 8; ++e) { const float cx = ac[e] * ax[e]; o[e] = ab[e] * (w[0][e] * h2[e] + w[1][e] * h1[e] + w[2][e] * cx); h2[e] = h1[e]; h1[e] = cx; }
                            stg16(U + (size_t)(t0 + 4 * gq + q) * DM + c8, pack8(o));
                        }
                    }
                }
            }
            REP(12) { LANE_VARS
                const float* gqp = args.in[16] + (size_t)l * HD; const float* gkp = args.in[17] + (size_t)l * HD;
                float gq[8], gk[8];
#pragma unroll
                for (int e = 0; e < 8; ++e) { gq[e] = gqp[(8 * lane + e) & 127] * QSCALE; gk[e] = gkp[(8 * lane + e) & 127]; }
                LAS float* red = (LAS float*)lds;
                for (int unit = vcu; unit < MROWS / 128; unit += G) {
                    float ks[8];
#pragma unroll
                    for (int e = 0; e < 8; ++e) ks[e] = 0.f;
#pragma unroll 1
                    for (int i4 = 0; i4 < 16; i4 += 4) {
                        u32x4 rq4[4], rk4[4];
#pragma unroll
                        for (int q = 0; q < 4; ++q) { const bf16_t* qp = Z + (size_t)(unit * 128 + wave * 16 + i4 + q) * ZP + OFF_D + 8 * lane; rq4[q] = ldg16(qp); rk4[q] = ldg16(qp + 512); }
#pragma unroll
                        for (int q4 = 0; q4 < 4; ++q4) {
                            const int row = unit * 128 + wave * 16 + i4 + q4;
                            bf16_t* qp = Z + (size_t)row * ZP + OFF_D + 8 * lane; bf16_t* kp = qp + 512;
                            float q[8], k[8]; unpack8(rq4[q4], q); unpack8(rk4[q4], k);
                            float sq = 0.f, sk = 0.f;
#pragma unroll
                            for (int e = 0; e < 8; ++e) { sq += q[e] * q[e]; sk += k[e] * k[e]; }
#pragma unroll
                            for (int o = 1; o < 16; o <<= 1) { sq += __shfl_xor(sq, o); sk += __shfl_xor(sk, o); }
                            const float rq = __builtin_amdgcn_rsqf(sq * (1.f / HD) + EPS), rk = __builtin_amdgcn_rsqf(sk * (1.f / HD) + EPS);
#pragma unroll
                            for (int e = 0; e < 8; ++e) { q[e] = q[e] * rq * gq[e]; k[e] = k[e] * rk * gk[e]; ks[e] += k[e]; }
                            if (rep) { bf16_t* dq = U + (size_t)row * DM + 1536 + 8 * lane; stg16(dq, pack8(q)); stg16(dq, pack8(k)); } else { stg16(qp, pack8(q)); stg16(kp, pack8(k)); }
                        }
                    }
#pragma unroll
                    for (int e = 0; e < 8; ++e) red[wave * 512 + 8 * lane + e] = ks[e];
                    __syncthreads();
                    { float s = 0.f;
#pragma unroll
                      for (int w = 0; w < 8; ++w) s += red[w * 512 + tid];
                      (rep ? lslot : ksum)[(size_t)unit * 512 + tid] = s; }
                    __syncthreads();
                }
            }
            REP(13) { LANE_VARS
                const float* cw = args.in[6] + (size_t)l * 31 * 512; const float* cb = args.in[7] + (size_t)l * 512;
                const float* lng = args.in[8] + (size_t)l * 512; const float* lnb = args.in[9] + (size_t)l * 512;
                LAS unsigned char* P = lds;
                for (int unit = vcu; unit < MROWS / 64; unit += G) {
                    const int t0 = unit * 64, tseq0 = t0 & (SEQ - 1);
#pragma unroll 1
                    for (int i0 = 0; i0 < 12; i0 += 4) {
                        u32x4 rba[4], rsg[4];
#pragma unroll
                        for (int q = 0; q < 4; ++q) { const int idx = tid + 512 * (i0 + q), r = idx >> 6, ch = idx & 63; const bool ok = idx < 94 * 64 && (tseq0 - 30 + r >= 0);
                            const size_t grow = ok ? (size_t)(t0 - 30 + r) : (size_t)t0;
                            rba[q] = ldg16(Z + grow * ZP + OFF_B + 8 * ch); rsg[q] = ldg16(Z + grow * ZP + OFF_B + 512 + 8 * ch); }
#pragma unroll
                        for (int q = 0; q < 4; ++q) { const int idx = tid + 512 * (i0 + q), r = idx >> 6, ch = idx & 63; const bool ok = (tseq0 - 30 + r >= 0);
                            float ba[8], sg[8]; unpack8(rba[q], ba); unpack8(rsg[q], sg);
#pragma unroll
                            for (int e = 0; e < 8; ++e) ba[e] = ok ? ba[e] * sg[e] : 0.f;
                            if (idx < 94 * 64) *(LAS u32x4*)(P + r * 1024 + ch * 16) = pack8(ba); }
                    }
                    __syncthreads();
                    {
                        float w[31];
#pragma unroll
                        for (int k = 0; k < 31; ++k) w[k] = cw[k * 512 + tid];
                        const float bias = cb[tid];
                        LAS unsigned short* Pc = (LAS unsigned short*)P + tid;
                        for (int grp = 0; grp < 8; ++grp) {
                            float pv[38];
#pragma unroll
                            for (int i = 0; i < 38; ++i) pv[i] = __uint_as_float((unsigned)Pc[(grp * 8 + i) * 512] << 16);
                            float hb[8];
#pragma unroll
                            for (int o = 0; o < 8; ++o) { float a = bias;
#pragma unroll
                                for (int k = 0; k < 31; ++k) a += w[k] * pv[o + k];
                                hb[o] = a; }
#pragma unroll
                            for (int o = 0; o < 8; o += 2) { const unsigned pkd = pk2(hb[o], hb[o + 1]); Pc[(grp * 8 + o) * 512] = (unsigned short)(pkd & 0xffffu); Pc[(grp * 8 + o + 1) * 512] = (unsigned short)(pkd >> 16); }
                        }
                    }
                    __syncthreads();
                    {
                        float gg[8], bb[8];
#pragma unroll
                        for (int e = 0; e < 8; ++e) { gg[e] = lng[8 * lane + e]; bb[e] = lnb[8 * lane + e]; }
                        for (int i = 0; i < 8; ++i) {
                            const int tt = wave * 8 + i;
                            float x[8]; unpack8(*(const LAS u32x4*)(P + tt * 1024 + lane * 16), x);
                            float s1 = 0.f, s2 = 0.f;
#pragma unroll
                            for (int e = 0; e < 8; ++e) { s1 += x[e]; s2 += x[e] * x[e]; }
                            s1 = wave_sum(s1); s2 = wave_sum(s2);
                            const float mean = s1 * (1.f / 512), var = fmaxf(s2 * (1.f / 512) - mean * mean, 0.f), rstd = __builtin_amdgcn_rsqf(var + EPS);
#pragma unroll
                            for (int e = 0; e < 8; ++e) { const float y = (x[e] - mean) * rstd * gg[e] + bb[e]; x[e] = y * sigmoid_f(y); }
                            stg16(U + (size_t)(t0 + tt) * DM + 512 + 8 * lane, pack8(x));
                        }
                    }
                    __syncthreads();
                }
            }
            REP(14) { LANE_VARS
                const float* lng = args.in[11] + (size_t)l * 512; const float* lnb = args.in[12] + (size_t)l * 512;
                const float* bsp = args.in[14] + (size_t)l * 4 * 128;
                constexpr int VP = 136;
                LAS unsigned short* vvT = (LAS unsigned short*)lds;
                for (int unit = vcu; unit < MROWS / 128; unit += G) {
                    const int row0 = unit * 128;
                    {
                        float gg[8], bb[8];
#pragma unroll
                        for (int e = 0; e < 8; ++e) { gg[e] = lng[8 * lane + e]; bb[e] = lnb[8 * lane + e]; }
#pragma unroll 1
                        for (int i4 = 0; i4 < 16; i4 += 4) {
                            u32x4 rx4[4];
#pragma unroll
                            for (int q = 0; q < 4; ++q) rx4[q] = ldg16(Z + (size_t)(row0 + wave * 16 + i4 + q) * ZP + OFF_C + 512 + 8 * lane);
#pragma unroll
                            for (int q = 0; q < 4; ++q) {
                                const int t = wave * 16 + i4 + q;
                                float x[8]; unpack8(rx4[q], x);
                                float s1 = 0.f, s2 = 0.f;
#pragma unroll
                                for (int e = 0; e < 8; ++e) { s1 += x[e]; s2 += x[e] * x[e]; }
                                s1 = wave_sum(s1); s2 = wave_sum(s2);
                                const float mean = s1 * (1.f / 512), var = fmaxf(s2 * (1.f / 512) - mean * mean, 0.f), rstd = __builtin_amdgcn_rsqf(var + EPS);
#pragma unroll
                                for (int e = 0; e < 8; e += 2) {
                                    const unsigned pkd = pk2((x[e] - mean) * rstd * gg[e] + bb[e], (x[e + 1] - mean) * rstd * gg[e + 1] + bb[e + 1]);
                                    vvT[(8 * lane + e) * VP + t] = (unsigned short)(pkd & 0xffffu); vvT[(8 * lane + e + 1) * VP + t] = (unsigned short)(pkd >> 16);
                                }
                            }
                        }
                    }
                    __syncthreads();
                    {
                        const int grp = wave >> 1, th = wave & 1, l15 = lane & 15, l4 = lane >> 4;
                        bf16x8 bfr[4][4];
#pragma unroll
                        for (int tt = 0; tt < 4; ++tt)
#pragma unroll
                            for (int ks = 0; ks < 4; ++ks) bfr[tt][ks] = __builtin_bit_cast(bf16x8, ldg16(Wsb + (size_t)(grp * 128 + 64 * th + 16 * tt + l15) * 128 + 32 * ks + 8 * l4));
                        float bs4[4]; u32x2 un[4];
#pragma unroll
                        for (int tt = 0; tt < 4; ++tt) { const int t = 64 * th + 16 * tt + l15; bs4[tt] = bsp[grp * 128 + t]; un[tt] = *(const GAS u32x2*)(Z + (size_t)(row0 + t) * ZP + OFF_C + grp * 128 + 4 * l4); }
#pragma unroll
                        for (int ct = 0; ct < 8; ++ct) {
                            f32x4 acc4[4]; u32x2 uc[4];
#pragma unroll
                            for (int tt = 0; tt < 4; ++tt) { acc4[tt] = (f32x4){0.f, 0.f, 0.f, 0.f}; uc[tt] = un[tt]; }
                            if (ct < 7) {
#pragma unroll
                                for (int tt = 0; tt < 4; ++tt) { const int t = 64 * th + 16 * tt + l15; un[tt] = *(const GAS u32x2*)(Z + (size_t)(row0 + t) * ZP + OFF_C + grp * 128 + 16 * (ct + 1) + 4 * l4); } }
#pragma unroll
                            for (int ks = 0; ks < 4; ++ks) {
                                const bf16x8 a = *(const LAS bf16x8*)((const LAS unsigned char*)vvT + ((grp * 128 + 16 * ct + l15) * VP + 32 * ks + 8 * l4) * 2);
#pragma unroll
                                for (int tt = 0; tt < 4; ++tt) acc4[tt] = __builtin_amdgcn_mfma_f32_16x16x32_bf16(a, bfr[tt][ks], acc4[tt], 0, 0, 0);
                            }
                            const int c0 = grp * 128 + 16 * ct + 4 * l4;
#pragma unroll
                            for (int tt = 0; tt < 4; ++tt) {
                                const int t = 64 * th + 16 * tt + l15; const float bs = bs4[tt]; const u32x2 uw = uc[tt];
                                u32x2 ow; ow.x = pk2(bflo(uw.x) * (acc4[tt][0] + bs), bfhi(uw.x) * (acc4[tt][1] + bs)); ow.y = pk2(bflo(uw.y) * (acc4[tt][2] + bs), bfhi(uw.y) * (acc4[tt][3] + bs));
                                *(GAS u32x2*)(U + (size_t)(row0 + t) * DM + 1024 + c0) = ow;
                            }
                        }
                    }
                    __syncthreads();
                }
            }
        }
        xcd_barrier(bar);
        if (PH_MASK & (1 << 3)) REP(3) { PHASE_VARS
            LAS float* km = (LAS float*)lds;
            LAS unsigned* hist = (LAS unsigned*)(lds + 16384);
            unsigned* cntl = ctl + CW_CNT + l * 512 + (rep ? 2048 : 0);
            for (int unit0 = vcu, uk = 0; unit0 < BATCH * NH * 32; unit0 += G, ++uk) {
                const int unit = (uk & 1) ? (unit0 ^ 31) : unit0;
                const int i = unit & 31, h = (unit >> 5) & 3, b = unit >> 7;
                if (i == 0) continue;
                for (int e = tid; e < i * 128; e += 512) { const int j = e >> 7, d = e & 127; km[e] = ksum[(size_t)(b * 64 + 2 * j) * 512 + h * HD + d] + ksum[(size_t)(b * 64 + 2 * j + 1) * 512 + h * HD + d]; }
                if (tid < 96) hist[tid] = 0u;
                __syncthreads();
                const int ql = tid >> 1, half = tid & 1;
                const bf16_t* qp = Z + (size_t)(b * SEQ + i * 256 + ql) * ZP + OFF_D + h * HD + half * 64;
                float qv[64];
#pragma unroll
                for (int s = 0; s < 8; ++s) { float t8[8]; unpack8(ldg16(qp + 8 * s), t8);
#pragma unroll
                    for (int e = 0; e < 8; ++e) qv[8 * s + e] = t8[e]; }
                float v0 = -3.0e38f, v1 = -3.0e38f, v2 = -3.0e38f; int i0 = 0, i1 = 0, i2 = 0;
                for (int j = 0; j < i; ++j) {
                    const LAS f32x4* kp = (const LAS f32x4*)(km + j * 128 + half * 64);
                    float dot = 0.f;
#pragma unroll
                    for (int s = 0; s < 16; ++s) { const f32x4 kk = kp[s]; dot += qv[4 * s] * kk.x + qv[4 * s + 1] * kk.y + qv[4 * s + 2] * kk.z + qv[4 * s + 3] * kk.w; }
                    dot += __shfl_xor(dot, 1);
                    const bool g0 = dot > v0, g1 = dot > v1, g2 = dot > v2;
                    v2 = g1 ? v1 : (g2 ? dot : v2); i2 = g1 ? i1 : (g2 ? j : i2);
                    v1 = g0 ? v0 : (g1 ? dot : v1); i1 = g0 ? i0 : (g1 ? j : i1);
                    v0 = g0 ? dot : v0; i0 = g0 ? j : i0;
                }
                const int nsel = i < 3 ? i : 3;
                if (half == 0) { lds_add(&hist[i0], 1u); if (nsel > 1) lds_add(&hist[i1], 1u); if (nsel > 2) lds_add(&hist[i2], 1u); }
                __syncthreads();
                if (tid < 32) { const unsigned n = hist[tid]; if (n) hist[32 + tid] = __hip_atomic_fetch_add(cntl + (b * NH + h) * 32 + tid, n, __ATOMIC_RELAXED, __HIP_MEMORY_SCOPE_AGENT); }
                __syncthreads();
                if (half == 0) {
                    unsigned short* lb = (rep ? (unsigned short*)oslot : lists) + (size_t)((b * NH + h) * 32) * 8192;
                    const unsigned tq = (unsigned)(i * 256 + ql);
                    { const unsigned pos = hist[32 + i0] + lds_add(&hist[64 + i0], 1u); lb[(size_t)i0 * 8192 + pos] = (unsigned short)(tq); }
                    if (nsel > 1) { const unsigned pos = hist[32 + i1] + lds_add(&hist[64 + i1], 1u); lb[(size_t)i1 * 8192 + pos] = (unsigned short)(tq | (1u << 13)); }
                    if (nsel > 2) { const unsigned pos = hist[32 + i2] + lds_add(&hist[64 + i2], 1u); lb[(size_t)i2 * 8192 + pos] = (unsigned short)(tq | (2u << 13)); }
                }
                __syncthreads();
            }
        }
        xcd_barrier(bar);
        LAS unsigned char* ldsK = lds; LAS unsigned char* ldsV = lds + 65536; LAS float* tab = (LAS float*)(lds + 131072);
        LAS float* M2s = (LAS float*)(lds + 131072 + TABP * 4);
        LAS int* pre = (LAS int*)(lds + 131072 + TABP * 4 + 64);
        { LANE_VARS if (wave == 0) {
            const float* gqp = args.in[16] + (size_t)l * HD; const float* gkp = args.in[17] + (size_t)l * HD;
            const float gqm = wave_max(fmaxf(fabsf(gqp[lane]), fabsf(gqp[64 + lane]))), gkm = wave_max(fmaxf(fabsf(gkp[lane]), fabsf(gkp[64 + lane])));
#pragma unroll
            for (int h = 0; h < NH; ++h) { const float bm = wave_max(lane < 32 ? fabsf(args.in[1][lane * NH + h]) : 0.f); if (lane == 0) M2s[h] = (128.f * gqm * gkm * 0.08838834764831845f + bm) * LOG2E; }
        } }
        __syncthreads();
        if (PH_MASK & (1 << 4)) REP(4) { PHASE_VARS
            const unsigned* cntl = ctl + CW_CNT + l * 512;
            {
                const int c = (int)__hip_atomic_load(cntl + tid, __ATOMIC_RELAXED, __HIP_MEMORY_SCOPE_AGENT);
                const int nch = (c + 255) >> 8;
                int incl = nch;
#pragma unroll
                for (int o = 1; o < 64; o <<= 1) { const int t = __shfl_up(incl, o); if (lane >= o) incl += t; }
                LAS int* wtot = (LAS int*)(lds + 131072 + TABP * 4 + 32);
                if (lane == 63) wtot[wave] = incl;
                __syncthreads();
                int wbase = 0;
#pragma unroll
                for (int w = 0; w < 8; ++w) wbase += (w < wave) ? wtot[w] : 0;
                pre[tid] = wbase + incl - nch;
                if (tid == 511) pre[512] = wbase + incl;
                __syncthreads();
            }
            const int NI = pre[512];
            const int it0 = (int)(((long)vcu * NI) / G), it1 = (int)(((long)(vcu + 1) * NI) / G);
            int cur = -1;
            for (int it = it0; it < it1; ++it) {
                int lo = 0, hi2 = 511;
                while (lo < hi2) { const int mid = (lo + hi2 + 1) >> 1; if (pre[mid] <= it) lo = mid; else hi2 = mid - 1; }
                const int bhj = lo, chunk = it - pre[bhj];
                const int j = bhj & 31, h = (bhj >> 5) & 3, b = bhj >> 7;
                if (bhj != cur) { __syncthreads(); load_kv(Z, tabg, ldsK, ldsV, tab, M2s[h], b, h, j, tid); cur = bhj; __syncthreads(); }
                const int cnt = (int)__hip_atomic_load(cntl + bhj, __ATOMIC_RELAXED, __HIP_MEMORY_SCOPE_AGENT);
                const int e = chunk * 256 + wave * 32 + (lane & 31);
                const bool valid = e < cnt;
                const unsigned ent = lists[(size_t)bhj * 8192 + (valid ? e : chunk * 256)];
                const int tq = ent & 8191, rsel = ent >> 13;
                const size_t row = (size_t)b * SEQ + tq;
                bf16x8 qf[8];
                { const bf16_t* qp = Z + row * ZP + OFF_D + h * HD + 8 * (lane >> 5);
#pragma unroll
                  for (int s = 0; s < 8; ++s) qf[s] = __builtin_bit_cast(bf16x8, ldg16(qp + 16 * s)); }
                f32x16 o[4];
#pragma unroll
                for (int c = 0; c < 4; ++c)
#pragma unroll
                    for (int r = 0; r < 16; ++r) o[c][r] = 0.f;
                float lsum = 0.f;
                attn_core<false>(ldsK, ldsV, tab, qf, tq - j * 256, 4, lane, o, lsum);
                lsum += __shfl_xor(lsum, 32);
                store_o_bf16(valid ? (bf16_t*)oslot + ((size_t)rsel * MROWS + row) * 512 + h * HD : (bf16_t*)oslot + (size_t)3 * MROWS * 512 + (size_t)(tid & 63) * 128, o, 1.0f, lane >> 5);
                if (valid && lane < 32) lslot[((size_t)rsel * MROWS + row) * 4 + h] = lsum;
            }
        }
        xcd_barrier(bar);
        if (PH_MASK & (1 << 5)) REP(5) { PHASE_VARS
            for (int unit = vcu; unit < BATCH * NH * 32; unit += G) {
                const int i = unit & 31, h = (unit >> 5) & 3, b = unit >> 7;
                __syncthreads(); load_kv(Z, tabg, ldsK, ldsV, tab, M2s[h], b, h, i, tid); __syncthreads();
                const int ql = wave * 32 + (lane & 31);
                const size_t row = (size_t)b * SEQ + i * 256 + ql;
                bf16x8 qf[8];
                { const bf16_t* qp = Z + row * ZP + OFF_D + h * HD + 8 * (lane >> 5);
#pragma unroll
                  for (int s = 0; s < 8; ++s) qf[s] = __builtin_bit_cast(bf16x8, ldg16(qp + 16 * s)); }
                f32x16 o[4];
#pragma unroll
                for (int c = 0; c < 4; ++c)
#pragma unroll
                    for (int r = 0; r < 16; ++r) o[c][r] = 0.f;
                float lsum = 0.f;
                attn_core<true>(ldsK, ldsV, tab, qf, ql, (wave >> 1) + 1, lane, o, lsum);
                lsum += __shfl_xor(lsum, 32);
                const int nsel = i < 3 ? i : 3;
                for (int r = 0; r < nsel; ++r) {
                    lsum += lslot[((size_t)r * MROWS + row) * 4 + h];
                    load_add_o_bf16((const bf16_t*)oslot + ((size_t)r * MROWS + row) * 512 + h * HD, o, lane >> 5);
                }
                const float inv = 1.0f / lsum;
                store_o_bf16(U + row * DM + 1536 + h * HD, o, inv, lane >> 5);
            }
            __syncthreads();
        }
        if (PH_MASK & (1 << 1)) REP(1) { PHASE_VARS
            pg8::Gemm g{h8, Wg8, DM, DM, DM, 0, 0}; pg8::StaticOrder<0> S; S.init(MROWS, ZP - OFF_G, G, bx);
            pg8::EpiGate8 E{(unsigned char*)Z + OFF_G * 2, part, 1.0f / 64.0f};
            pg8::gemm_phase<pg8::EpiGate8, pg8::StaticOrder<0>, true>(lds, g, S, E, tid);
        }
        xcd_barrier(bar);
        if (PH_MASK & (1 << 6)) REP(6) { PHASE_VARS
            pg8::Gemm g{U, Wt_out, DM * 2, 512 * 2, 512 * 2, (size_t)512 * 2, (size_t)DM * 512 * 2}; pg8::StaticOrder<2> S; S.init(MROWS, DM, G, bx);
            pg8::EpiMerge E{(const unsigned char*)Z + OFF_G * 2, actA};
            pg8::gemm_phase<pg8::EpiMerge, pg8::StaticOrder<2>>(lds, g, S, E, tid);
        }
        xcd_barrier(bar);
        if (PH_MASK & (1 << 7)) REP(7) { PHASE_VARS const bool dry = ((DUP_MASK >> 7) & 1) && rep == 0;
            pg8::Gemm g{actA, Wt_o, DM * 2, DM * 2, DM * 2, 0, 0}; pg8::StaticOrder<0> S; S.init(MROWS, DM, G, bx);
            pg8::EpiResidB E{xb, dry ? (bf16_t*)oslot : xb, nullptr, dry ? lslot : part, nullptr, (LAS float*)(lds + 131072)};
            pg8::gemm_phase<pg8::EpiResidB, pg8::StaticOrder<0>>(lds, g, S, E, tid);
        }
        xcd_barrier(bar);
        if (PH_MASK & (1 << 9)) REP(9) { PHASE_VARS
            pg8::Gemm g{xb, Wt_mi, DM * 2, DM * 2, DM * 2, 0, 0}; pg8::StaticOrder<0> S; S.init(MROWS, DFF, G, bx);
            pg8::EpiRelu2 E{Z, DFF, part};
            pg8::gemm_phase<pg8::EpiRelu2, pg8::StaticOrder<0>>(lds, g, S, E, tid);
        }
        xcd_barrier(bar);
        if (PH_MASK & (1 << 10)) REP(10) { PHASE_VARS const bool dry = ((DUP_MASK >> 10) & 1) && rep == 0;
            pg8::Gemm g{Z, Wt_mo, DFF * 2, DFF * 2, DFF * 2, 0, 0}; pg8::StaticOrder<0> S; S.init(MROWS, DM, G, bx);
            pg8::EpiResidB E{xb, dry ? (bf16_t*)oslot : xb, dry ? (unsigned char*)oslot + 128 * MiB : h8, dry ? lslot : part, (l == DEPTH - 1 && !dry) ? xout : nullptr, (LAS float*)(lds + 131072)};
            pg8::gemm_phase<pg8::EpiResidB, pg8::StaticOrder<0>>(lds, g, S, E, tid);
        }
        xcd_barrier(bar);
    }
}

extern "C" void kernel_launch(void* const* d_in, const int* in_sizes, int n_in, void* d_out, int out_size, void* d_ws, size_t ws_size, hipStream_t stream) {
    static int grid = 0;
    if (grid == 0) {
        if (n_in != 23 || in_sizes[0] != MROWS * DM || out_size != MROWS * DM || ws_size < WS_END) {
            fprintf(stderr, "kernel_launch: unexpected shapes (n_in %d, in0 %d, out %d, ws %zu < %zu); nothing launched\n", n_in, n_in > 0 ? in_sizes[0] : -1, out_size, ws_size, (size_t)WS_END); grid = -1; return; }
        int dev = 0, cus = 0, per_cu = 0;
        if (hipGetDevice(&dev) != hipSuccess || hipDeviceGetAttribute(&cus, hipDeviceAttributeMultiprocessorCount, dev) != hipSuccess) { grid = -1; return; }
        if (hipFuncSetAttribute((const void*)fwd, hipFuncAttributeMaxDynamicSharedMemorySize, LDS_BYTES) != hipSuccess) { fprintf(stderr, "kernel_launch: hipFuncSetAttribute failed\n"); grid = -1; return; }
        if (hipOccupancyMaxActiveBlocksPerMultiprocessor(&per_cu, (const void*)fwd, 512, LDS_BYTES) != hipSuccess || per_cu < 1)
            fprintf(stderr, "kernel_launch: note: occupancy query reports %d workgroups per CU\n", per_cu);
        (void)hipGetLastError();
        grid = cus;
    }
    if (grid < 0) return;
    if (hipMemsetAsync((char*)d_ws + WS_CTL, 0, CTL_ZERO_BYTES, stream) != hipSuccess) { fprintf(stderr, "kernel_launch: memset failed\n"); return; }
    Args a{};
    for (int i = 0; i < 23; ++i) a.in[i] = (const float*)d_in[i];
    a.out = (float*)d_out; a.ws = (unsigned char*)d_ws;
    hipLaunchKernelGGL(fwd, dim3(grid), dim3(512), LDS_BYTES, stream, a);
}
```

```cpp
#include <hip/hip_runtime.h>
#include <cstdio>
#include <cstdint>

#define LAS __attribute__((address_space(3)))
#define GAS __attribute__((address_space(1)))
typedef unsigned short bf16_t;
typedef short bf16x8 __attribute__((ext_vector_type(8)));
typedef short s16x4 __attribute__((ext_vector_type(4)));
typedef float f32x4 __attribute__((ext_vector_type(4)));
typedef float f32x16 __attribute__((ext_vector_type(16)));
typedef unsigned u32x4 __attribute__((ext_vector_type(4)));
typedef unsigned u32x2 __attribute__((ext_vector_type(2)));

#ifndef PH_MASK
#define PH_MASK 0xFFFF
#endif
#ifndef DUP_MASK
#define DUP_MASK 0
#endif
#define REP(n) for (int rep = 0; rep <= ((DUP_MASK >> (n)) & 1); ++rep)
constexpr int DM = 2048, BATCH = 4, SEQ = 8192, DEPTH = 4, MROWS = BATCH * SEQ;
constexpr int OFF_A = 0, OFF_B = 1536, OFF_C = 2560, OFF_D = 3584, OFF_G = 5120, ZP = 13312;
constexpr int DFF = 8192, NH = 4, HD = 128;
constexpr float EPS = 1e-6f;
constexpr float LOG2E = 1.4426950408889634f;
constexpr float QSCALE = 0.08838834764831845f * 1.4426950408889634f;
constexpr int TABN = 1536;
constexpr int TABP = TABN + 128, TREV = TABN + 58;

__device__ __forceinline__ unsigned pk2(float lo, float hi) {
    typedef float f2_t __attribute__((ext_vector_type(2))); typedef __bf16 b2_t __attribute__((ext_vector_type(2)));
    f2_t v = {lo, hi}; b2_t b = __builtin_convertvector(v, b2_t); return __builtin_bit_cast(unsigned, b);
}
__device__ __forceinline__ float bflo(unsigned w) { return __uint_as_float(w << 16); }
__device__ __forceinline__ float bfhi(unsigned w) { return __uint_as_float(w & 0xffff0000u); }
__device__ __forceinline__ void unpack8(const u32x4 w, float (&f)[8]) {
    f[0] = bflo(w.x); f[1] = bfhi(w.x); f[2] = bflo(w.y); f[3] = bfhi(w.y); f[4] = bflo(w.z); f[5] = bfhi(w.z); f[6] = bflo(w.w); f[7] = bfhi(w.w);
}
__device__ __forceinline__ u32x4 pack8(const float (&f)[8]) { u32x4 w; w.x = pk2(f[0], f[1]); w.y = pk2(f[2], f[3]); w.z = pk2(f[4], f[5]); w.w = pk2(f[6], f[7]); return w; }
__device__ __forceinline__ float sigmoid_f(float x) { return __builtin_amdgcn_rcpf(1.0f + __builtin_amdgcn_exp2f(-x * LOG2E)); }
__device__ __forceinline__ float gelu_tanh_f(float x) {
    const float u2 = 1.5957691216057308f * (x + 0.044715f * x * x * x);
    return x * __builtin_amdgcn_rcpf(1.0f + __builtin_amdgcn_exp2f(-u2 * LOG2E));
}
__device__ __forceinline__ float wave_sum(float v) {
#pragma unroll
    for (int o = 1; o < 64; o <<= 1) v += __shfl_xor(v, o);
    return v;
}
__device__ __forceinline__ float wave_max(float v) {
#pragma unroll
    for (int o = 1; o < 64; o <<= 1) v = fmaxf(v, __shfl_xor(v, o));
    return v;
}
__device__ __forceinline__ unsigned lds_add(LAS unsigned* p, unsigned v) { return __hip_atomic_fetch_add(p, v, __ATOMIC_RELAXED, __HIP_MEMORY_SCOPE_WORKGROUP); }
__device__ __forceinline__ int opaque_tid() { int t = threadIdx.x; asm volatile("" : "+v"(t)); return t; }
__device__ __forceinline__ unsigned char* opaque_ptr(unsigned char* p) { asm volatile("" : "+s"(p)); return p; }
__device__ __forceinline__ u32x4 ldg16(const bf16_t* p) { return *(const GAS u32x4*)p; }
__device__ __forceinline__ void stg16(bf16_t* p, u32x4 v) { *(GAS u32x4*)p = v; }

namespace pg8 {
constexpr int BM = 256, BK = 64, HALF = 128, HTB = HALF * BK * 2, STAGE_BYTES = 8 * HTB, NXCD = 8, WGM = 4;
__host__ __device__ __forceinline__ int lds_byte(int r, int c) { const int st = (r >> 4) * 2 + (c >> 5), rr = r & 15, cc = c & 31, ob = rr * 64 + cc * 2; return st * 1024 + (ob ^ (((ob >> 9) & 1) << 5)); }
__host__ __device__ __forceinline__ void stage_rc(int b, int& R, int& C) { const int st = b / 1024, sb = b % 1024, swz = sb ^ (((sb >> 9) & 1) << 5); R = (st >> 1) * 16 + swz / 64; C = (st & 1) * 32 + (swz % 64) / 2; }
__host__ __device__ __forceinline__ int perm32(int rho) { const int n = rho >> 4, i = rho & 15; return 8 * (i >> 2) + 4 * n + (i & 3); }

typedef int v8i_t __attribute__((ext_vector_type(8)));
typedef v8i_t v8i_a16 __attribute__((aligned(16)));
__device__ __forceinline__ v8i_t cat8(const u32x4 a, const u32x4 b) { return (v8i_t){(int)a.x, (int)a.y, (int)a.z, (int)a.w, (int)b.x, (int)b.y, (int)b.z, (int)b.w}; }
struct Unit { int pm, pn, seg; };
struct Gemm { const void* A; const void* Bt; int lda_b, ldb_b, Kb; size_t a_seg, b_seg; };

template <int NSEG_LOG2> struct StaticOrder {
    int nM, nN, nwg, G, c;
    __device__ void init(int M, int N, int G_, int c_) { nM = M / BM; nN = N / BM; nwg = nM * nN; G = G_; c = c_; }
    __device__ bool next(int i, Unit& u) const {
        const int ti = i >> NSEG_LOG2;
        const long L = (long)ti * G + c; if (L >= nwg) return false;
        int wgid = (int)L; { const int q = nwg / NXCD, r = nwg % NXCD, xcd = wgid % NXCD, off = wgid / NXCD; wgid = (xcd < r ? xcd * (q + 1) : r * (q + 1) + (xcd - r) * q) + off; }
        const int nig = WGM * nN, gid = wgid / nig, fm = gid * WGM, gsz = (nM - fm) < WGM ? (nM - fm) : WGM;
        u.pm = fm + ((wgid % nig) % gsz); u.pn = (wgid % nig) / gsz; u.seg = i & ((1 << NSEG_LOG2) - 1); return true;
    }
};

typedef f32x4 Acc[2][2][4][2];
template <class V, int NDW> __device__ __forceinline__ void store_pair(void* pe, void* po, int odd, V w0, V w1) {
    V A, B;
#pragma unroll
    for (int d = 0; d < NDW; ++d) { const unsigned snd = odd ? w0[d] : w1[d]; const unsigned rcv = (unsigned)__builtin_amdgcn_mov_dpp((int)snd, 0xB1, 0xF, 0xF, true);
        A[d] = odd ? rcv : w0[d]; B[d] = odd ? w1[d] : rcv; }
    *(GAS V*)pe = A; *(GAS V*)po = B;
}
__device__ __forceinline__ void rows_rstd(const float* part, int row0, float scale, float (&rsv)[2][4]) {
    f32x4 pa[2][4], pb[2][4];
#pragma unroll
    for (int ai = 0; ai < 2; ++ai)
#pragma unroll
        for (int m = 0; m < 4; ++m) { const float* p = part + (size_t)(row0 + ai * HALF + m * 16) * 8; pa[ai][m] = *(const GAS f32x4*)p; pb[ai][m] = *(const GAS f32x4*)(p + 4); }
    asm volatile("" ::: "memory");
#pragma unroll
    for (int ai = 0; ai < 2; ++ai)
#pragma unroll
        for (int m = 0; m < 4; ++m) { const f32x4 a = pa[ai][m], b = pb[ai][m];
            rsv[ai][m] = __builtin_amdgcn_rsqf((((a.x + a.y) + (a.z + a.w)) + ((b.x + b.y) + (b.z + b.w))) * (1.0f / DM) + EPS) * scale; }
}

constexpr int RS_OFF0 = 135168, RS_OFF1 = 147456;
__device__ __forceinline__ void rows_rstd_lds(const LAS float* rs, int rl, float scale, float (&rsv)[2][4]) {
#pragma unroll
    for (int ai = 0; ai < 2; ++ai)
#pragma unroll
        for (int m = 0; m < 4; ++m) { const LAS float* p = rs + (rl + ai * HALF + m * 16) * 8; const f32x4 a = *(const LAS f32x4*)p, b = *(const LAS f32x4*)(p + 4);
            rsv[ai][m] = __builtin_amdgcn_rsqf((((a.x + a.y) + (a.z + a.w)) + ((b.x + b.y) + (b.z + b.w))) * (1.0f / DM) + EPS) * scale; }
}
struct EpiZ {
    static constexpr bool PERM = true;
    static constexpr bool NEEDS_RS = true;
    bf16_t* O; const float* part; int col_base; int gates; float pre;
    __device__ __forceinline__ bool keep(const Unit&) const { return false; }
    __device__ __forceinline__ void operator()(Acc& acc, const Unit& u, int wr, int wc, int fr, int fq, const LAS float* rs) const {
        const int row0 = u.pm * BM + wr * 64 + fr, col0 = col_base + u.pn * BM + wc * 64 + 8 * fq;
        const int pn = u.pn;
        const int act = gates ? 1 : ((pn == 8 || pn == 9) ? 1 : ((pn >= 10 && pn < 14) ? 2 : 0));
        float rsv[2][4]; rows_rstd_lds(rs, wr * 64 + fr, pre, rsv);
#pragma unroll
        for (int ai = 0; ai < 2; ++ai)
#pragma unroll
            for (int m = 0; m < 4; ++m) { const int row = row0 + ai * HALF + m * 16; const int odd = fr & 1; bf16_t* rowp = O + (size_t)(row - odd) * ZP + col0 + 32 * odd;
                const float rs = rsv[ai][m]; const float nl2 = -LOG2E * rs; u32x4 wv[2];
#pragma unroll
                for (int bj = 0; bj < 2; ++bj) { f32x4 v0 = acc[ai][bj][m][0], v1 = acc[ai][bj][m][1];
                    if (act == 1) {
#pragma unroll
                        for (int j = 0; j < 4; ++j) { v0[j] = __builtin_amdgcn_rcpf(1.0f + __builtin_amdgcn_exp2f(v0[j] * nl2)); v1[j] = __builtin_amdgcn_rcpf(1.0f + __builtin_amdgcn_exp2f(v1[j] * nl2)); } }
                    else if (act == 2) {
#pragma unroll
                        for (int j = 0; j < 4; ++j) { v0[j] = gelu_tanh_f(v0[j] * rs); v1[j] = gelu_tanh_f(v1[j] * rs); } }
                    else { v0 *= rs; v1 *= rs; }
                    u32x4 w; w.x = pk2(v0[0], v0[1]); w.y = pk2(v0[2], v0[3]); w.z = pk2(v1[0], v1[1]); w.w = pk2(v1[2], v1[3]); wv[bj] = w; }
                store_pair<u32x4, 4>(rowp, rowp + ZP, odd, wv[0], wv[1]); }
    }
};
struct EpiGate8 {
    static constexpr bool PERM = true;
    static constexpr bool NEEDS_RS = true;
    unsigned char* G8; const float* part; float pre;
    __device__ __forceinline__ bool keep(const Unit&) const { return false; }
    __device__ __forceinline__ void operator()(Acc& acc, const Unit& u, int wr, int wc, int fr, int fq, const LAS float* rs) const {
        const int row0 = u.pm * BM + wr * 64 + fr, col0 = u.pn * BM + wc * 64 + 8 * fq;
        float rsv[2][4]; rows_rstd_lds(rs, wr * 64 + fr, pre, rsv);
#pragma unroll
        for (int ai = 0; ai < 2; ++ai)
#pragma unroll
            for (int m = 0; m < 4; ++m) { const int row = row0 + ai * HALF + m * 16; const int odd = fr & 1; unsigned char* rowp = G8 + (size_t)(row - odd) * (ZP * 2) + col0 + 32 * odd;
                const float nl2 = -LOG2E * rsv[ai][m]; u32x2 wv[2]; float cl = -7.98868469f; asm volatile("" : "+v"(cl));
#pragma unroll
                for (int bj = 0; bj < 2; ++bj) { const f32x4 v0 = acc[ai][bj][m][0], v1 = acc[ai][bj][m][1]; u32x2 w = (u32x2){0u, 0u};
                    typedef float f32x2_t __attribute__((ext_vector_type(2))); const f32x2_t nn = {nl2, nl2}, cc = {cl, cl};
                    const f32x2_t ta = __builtin_elementwise_fma((f32x2_t){v0[0], v0[1]}, nn, cc), tb = __builtin_elementwise_fma((f32x2_t){v0[2], v0[3]}, nn, cc), tc = __builtin_elementwise_fma((f32x2_t){v1[0], v1[1]}, nn, cc), td = __builtin_elementwise_fma((f32x2_t){v1[2], v1[3]}, nn, cc);
                    const f32x4 t0 = {ta[0], ta[1], tb[0], tb[1]}, t1 = {tc[0], tc[1], td[0], td[1]}; f32x4 e0, e1;
#pragma unroll
                    for (int j = 0; j < 4; ++j) { e0[j] = __builtin_amdgcn_exp2f(t0[j]); e1[j] = __builtin_amdgcn_exp2f(t1[j]); }
                    e0 += 1.0f / 254.0f; e1 += 1.0f / 254.0f;
#pragma unroll
                    for (int j = 0; j < 4; ++j) {
                        w.x = __builtin_amdgcn_cvt_pk_u8_f32(__builtin_amdgcn_rcpf(e0[j]), j, w.x);
                        w.y = __builtin_amdgcn_cvt_pk_u8_f32(__builtin_amdgcn_rcpf(e1[j]), j, w.y); }
                    w.x += 0x01010101u; w.y += 0x01010101u;
                    wv[bj] = w; }
                store_pair<u32x2, 2>(rowp, rowp + ZP * 2, odd, wv[0], wv[1]); }
    }
};
struct EpiLin {
    static constexpr bool PERM = true;
    static constexpr bool NEEDS_RS = false;
    bf16_t* scratch;
    __device__ __forceinline__ bool keep(const Unit&) const { return false; }
    __device__ __forceinline__ void operator()(Acc& acc, const Unit& u, int wr, int wc, int fr, int fq, const LAS float* rs) const {
        bf16_t* base = scratch + (size_t)((u.pm * 52 + u.pn) & 1023) * 65536 + (size_t)((wr * 4 + wc) * 16) * 512 + (fr + 16 * fq) * 8;
#pragma unroll
        for (int ai = 0; ai < 2; ++ai)
#pragma unroll
            for (int m = 0; m < 4; ++m)
#pragma unroll
                for (int bj = 0; bj < 2; ++bj) { const f32x4 v0 = acc[ai][bj][m][0], v1 = acc[ai][bj][m][1];
                    u32x4 w; w.x = pk2(v0[0], v0[1]); w.y = pk2(v0[2], v0[3]); w.z = pk2(v1[0], v1[1]); w.w = pk2(v1[2], v1[3]);
                    *(GAS u32x4*)(base + ((ai * 4 + m) * 2 + bj) * 512) = w; }
    }
};
struct EpiNull {
    static constexpr bool PERM = true;
    static constexpr bool NEEDS_RS = false;
    __device__ __forceinline__ bool keep(const Unit&) const { return false; }
    __device__ __forceinline__ void operator()(Acc& acc, const Unit& u, int wr, int wc, int fr, int fq, const LAS float* rs) const {
#pragma unroll
        for (int ai = 0; ai < 2; ++ai)
#pragma unroll
            for (int bj = 0; bj < 2; ++bj)
#pragma unroll
                for (int m = 0; m < 4; ++m)
#pragma unroll
                    for (int n = 0; n < 2; ++n) asm volatile("" :: "v"(acc[ai][bj][m][n]));
    }
};
struct EpiRelu2 {
    static constexpr bool PERM = true;
    static constexpr bool NEEDS_RS = true;
    bf16_t* O; int ldc; const float* part;
    __device__ __forceinline__ bool keep(const Unit&) const { return false; }
    __device__ __forceinline__ void operator()(Acc& acc, const Unit& u, int wr, int wc, int fr, int fq, const LAS float* rs) const {
        const int row0 = u.pm * BM + wr * 64 + fr, col0 = u.pn * BM + wc * 64 + 8 * fq;
        float rsv[2][4]; rows_rstd_lds(rs, wr * 64 + fr, 1.0f, rsv);
#pragma unroll
        for (int ai = 0; ai < 2; ++ai)
#pragma unroll
            for (int m = 0; m < 4; ++m) { const int row = row0 + ai * HALF + m * 16; const int odd = fr & 1; bf16_t* rowp = O + (size_t)(row - odd) * ldc + col0 + 32 * odd; const float rs = rsv[ai][m]; u32x4 wv[2];
#pragma unroll
                for (int bj = 0; bj < 2; ++bj) { f32x4 v0 = acc[ai][bj][m][0], v1 = acc[ai][bj][m][1];
#pragma unroll
                    for (int j = 0; j < 4; ++j) { const float a = __builtin_amdgcn_fmed3f(v0[j], 0.f, 3.0e38f) * rs, b = __builtin_amdgcn_fmed3f(v1[j], 0.f, 3.0e38f) * rs; v0[j] = a * a; v1[j] = b * b; }
                    u32x4 w; w.x = pk2(v0[0], v0[1]); w.y = pk2(v0[2], v0[3]); w.z = pk2(v1[0], v1[1]); w.w = pk2(v1[2], v1[3]); wv[bj] = w; }
                store_pair<u32x4, 4>(rowp, rowp + ldc, odd, wv[0], wv[1]); }
    }
};
struct EpiResidB {
    static constexpr bool PERM = true;
    static constexpr bool NEEDS_RS = false;
    const bf16_t* xr; bf16_t* xb; unsigned char* x8; float* part; float* outf; LAS float* red;
    __device__ __forceinline__ bool keep(const Unit&) const { return false; }
    __device__ __forceinline__ void operator()(Acc& acc, const Unit& u, int wr, int wc, int fr, int fq, const LAS float* rs) const {
        const int row0 = u.pm * BM + wr * 64 + fr, col0 = u.pn * BM + wc * 64 + 8 * fq;
#pragma unroll
        for (int ai = 0; ai < 2; ++ai) {
            u32x4 rv[4][2];
#pragma unroll
            for (int m = 0; m < 4; ++m)
#pragma unroll
                for (int bj = 0; bj < 2; ++bj) rv[m][bj] = *(const GAS u32x4*)(xr + (size_t)(row0 + ai * HALF + m * 16) * DM + col0 + bj * 32);
#pragma unroll
            for (int m = 0; m < 4; ++m) { const int row = row0 + ai * HALF + m * 16; const int odd = fr & 1; const size_t off = (size_t)row * DM + col0, offp = (size_t)(row - odd) * DM + col0 + 32 * odd; float ss = 0.f;
                u32x4 wv[2]; u32x2 fv[2];
#pragma unroll
                for (int bj = 0; bj < 2; ++bj) {
                    float v[8]; unpack8(rv[m][bj], v);
#pragma unroll
                    for (int e = 0; e < 8; ++e) { v[e] += acc[ai][bj][m][e >> 2][e & 3]; ss += v[e] * v[e]; }
                    if (outf) { *(GAS f32x4*)(outf + off + bj * 32) = (f32x4){v[0], v[1], v[2], v[3]}; *(GAS f32x4*)(outf + off + bj * 32 + 4) = (f32x4){v[4], v[5], v[6], v[7]}; }
                    else { wv[bj] = pack8(v);
                        if (x8) { int t = __builtin_amdgcn_cvt_pk_fp8_f32(v[0], v[1], 0, false); t = __builtin_amdgcn_cvt_pk_fp8_f32(v[2], v[3], t, true); fv[bj].x = (unsigned)t;
                            t = __builtin_amdgcn_cvt_pk_fp8_f32(v[4], v[5], 0, false); t = __builtin_amdgcn_cvt_pk_fp8_f32(v[6], v[7], t, true); fv[bj].y = (unsigned)t; } }
                }
                if (!outf) { store_pair<u32x4, 4>(xb + offp, xb + offp + DM, odd, wv[0], wv[1]); if (x8) store_pair<u32x2, 2>(x8 + offp, x8 + offp + DM, odd, fv[0], fv[1]); }
                ss += __shfl_xor(ss, 16); ss += __shfl_xor(ss, 32);
                if (fq == 0) red[wc * 256 + ai * HALF + wr * 64 + m * 16 + fr] = ss;
            }
        }
        asm volatile("s_waitcnt lgkmcnt(0)" ::: "memory"); __builtin_amdgcn_s_barrier(); asm volatile("" ::: "memory");
        { const int t = (wr * 4 + wc) * 64 + fr + 16 * fq;
          if (t < 256 && !outf) part[(size_t)(u.pm * BM + t) * 8 + u.pn] = (red[t] + red[256 + t]) + (red[512 + t] + red[768 + t]); }
        asm volatile("s_waitcnt lgkmcnt(0)" ::: "memory"); __builtin_amdgcn_s_barrier(); asm volatile("" ::: "memory");
    }
};
struct EpiMerge {
    static constexpr bool PERM = true;
    static constexpr bool NEEDS_RS = false;
    const unsigned char* G;
    bf16_t* O;
    __device__ __forceinline__ bool keep(const Unit& u) const { return u.seg < 3; }
    __device__ __forceinline__ void operator()(Acc& acc, const Unit& u, int wr, int wc, int fr, int fq, const LAS float* rs) const {
        const int row0 = u.pm * BM + wr * 64 + fr, col0 = u.pn * BM + wc * 64 + 8 * fq;
        const int seg = u.seg;
        const unsigned char* gp0 = G + (size_t)row0 * (ZP * 2) + seg * DM + col0;
        u32x2 ga[4][2][2], gb[4][2][2];
#define MG_LOAD(buf, q, TWO) do { _Pragma("unroll") for (int mm = 0; mm < 2; ++mm) _Pragma("unroll") for (int bj = 0; bj < 2; ++bj) { \
            const unsigned char* p_ = gp0 + (size_t)(((q) >> 1) * HALF + (((q) & 1) * 2 + mm) * 16) * (ZP * 2) + bj * 32; \
            ga[buf][mm][bj] = *(const GAS u32x2*)p_; if (TWO) gb[buf][mm][bj] = *(const GAS u32x2*)(p_ + DM); } } while (0)
#define MG_U8(w, e) ((float)((((e) < 4 ? (w).x : (w).y) >> (8 * ((e) & 3))) & 0xffu))
#define MG_SCALE(buf, q) do { _Pragma("unroll") for (int mm = 0; mm < 2; ++mm) _Pragma("unroll") for (int bj = 0; bj < 2; ++bj) { \
            const int ai_ = (q) >> 1, m_ = ((q) & 1) * 2 + mm; const u32x2 a_ = ga[buf][mm][bj], b_ = gb[buf][mm][bj]; \
            _Pragma("unroll") for (int e = 0; e < 8; ++e) acc[ai_][bj][m_][e >> 2][e & 3] *= MG_U8(a_, e) * __builtin_amdgcn_rcpf(MG_U8(b_, e)); } } while (0)
#define MG_STORE(buf, q) do { _Pragma("unroll") for (int mm = 0; mm < 2; ++mm) _Pragma("unroll") for (int bj = 0; bj < 2; ++bj) { \
            const int ai_ = (q) >> 1, m_ = ((q) & 1) * 2 + mm; const u32x2 a_ = ga[buf][mm][bj]; float v_[8]; \
            _Pragma("unroll") for (int e = 0; e < 8; ++e) v_[e] = acc[ai_][bj][m_][e >> 2][e & 3] * (MG_U8(a_, e) * (1.0f / 255.0f)); \
            *(GAS u32x4*)(O + (size_t)(row0 + ai_ * HALF + m_ * 16) * DM + col0 + bj * 32) = pack8(v_); } } while (0)
        if (seg < 3) {
            MG_LOAD(0, 0, true); MG_LOAD(1, 1, true); MG_LOAD(2, 2, true); MG_LOAD(3, 3, true); asm volatile("" ::: "memory");
            MG_SCALE(0, 0); MG_SCALE(1, 1); MG_SCALE(2, 2); MG_SCALE(3, 3);
        } else {
            MG_LOAD(0, 0, false); MG_LOAD(1, 1, false); MG_LOAD(2, 2, false); MG_LOAD(3, 3, false); asm volatile("" ::: "memory");
            MG_STORE(0, 0); MG_STORE(1, 1); MG_STORE(2, 2); MG_STORE(3, 3);
        }
#undef MG_SCALE
#undef MG_STORE
#undef MG_U8
#undef MG_LOAD
    }
};

template <class Epi, class Sched, bool FP8 = false>
__device__ __forceinline__ void gemm_phase(LAS unsigned char* lds, const Gemm g, const Sched& S, const Epi& E, const int tid) {
    const int wid = __builtin_amdgcn_readfirstlane(tid >> 6), lane = tid & 63, wr = wid >> 2, wc = wid & 3, fr = lane & 15, fq = lane >> 4;
    const int nt = g.Kb / 128;
    unsigned voffA[2], voffB[2];
#pragma unroll
    for (int i = 0; i < 2; ++i) { int R, C; stage_rc(tid * 16 + i * 8192, R, C); const int Rb = 64 * (R >> 5) + perm32(R & 31);
        voffA[i] = (unsigned)(R * g.lda_b + C * 2); voffB[i] = (unsigned)(Rb * g.ldb_b + C * 2); }
    const size_t kstep = (size_t)(BK * 2);
    const size_t hstepA = (size_t)HALF * g.lda_b, hstepB = (size_t)32 * g.ldb_b, tstepB = (size_t)BM * g.ldb_b;
    const unsigned ldsw = (unsigned)wid * 1024u;
    const int aoff = lds_byte(wr * 64 + fr, fq * 8), boff = lds_byte(wc * 32 + fr, fq * 8);
#define PG8_APTR(u) ((const char*)g.A + (size_t)(u).pm * 2 * hstepA + (size_t)(u).seg * g.a_seg)
#define PG8_BPTR(u) ((const char*)g.Bt + (size_t)(u).pn * tstepB + (size_t)(u).seg * g.b_seg)
#define PG8_SA(b, h) (((b) * 2 + (h)) * HTB)
#define PG8_SB(b, h) ((4 + (b) * 2 + (h)) * HTB)
#define PG8_STAGE(bufoff, gbase, voff) do { _Pragma("unroll") for (int _i = 0; _i < 2; ++_i) \
        __builtin_amdgcn_global_load_lds((const unsigned*)((const char*)(gbase) + (voff)[_i]), (LAS unsigned*)(lds + (bufoff) + ldsw + _i * 8192), 16, 0, 0); } while (0)
#define PG8_LDA(dst, b, h) do { _Pragma("unroll") for (int m = 0; m < 4; ++m) { \
        if constexpr (FP8) dst##8[m] = cat8(*(const LAS u32x4*)(lds + PG8_SA(b, h) + aoff + m * 2048), *(const LAS u32x4*)(lds + PG8_SA(b, h) + aoff + m * 2048 + 1024)); \
        else { _Pragma("unroll") for (int k = 0; k < 2; ++k) dst[m][k] = *(const LAS bf16x8*)(lds + PG8_SA(b, h) + aoff + m * 2048 + k * 1024); } } } while (0)
#define PG8_LDB(dst, b, h) do { _Pragma("unroll") for (int n = 0; n < 2; ++n) { \
        if constexpr (FP8) dst##8[n] = cat8(*(const LAS u32x4*)(lds + PG8_SB(b, h) + boff + n * 2048), *(const LAS u32x4*)(lds + PG8_SB(b, h) + boff + n * 2048 + 1024)); \
        else { _Pragma("unroll") for (int k = 0; k < 2; ++k) dst[n][k] = *(const LAS bf16x8*)(lds + PG8_SB(b, h) + boff + n * 2048 + k * 1024); } } } while (0)
#define PG8_MMA(ai, bj, At, Bt) do { __builtin_amdgcn_s_setprio(1); \
        if constexpr (FP8) { _Pragma("unroll") for (int m = 0; m < 4; ++m) _Pragma("unroll") for (int n = 0; n < 2; ++n) \
            asm volatile("v_mfma_f32_16x16x128_f8f6f4 %0, %1, %2, %0" : "+v"(acc[ai][bj][m][n]) : "v"(Bt##8[n]), "v"(At##8[m])); } \
        else { _Pragma("unroll") for (int m = 0; m < 4; ++m) _Pragma("unroll") for (int n = 0; n < 2; ++n) _Pragma("unroll") for (int k = 0; k < 2; ++k) \
            acc[ai][bj][m][n] = __builtin_amdgcn_mfma_f32_16x16x32_bf16(Bt[n][k], At[m][k], acc[ai][bj][m][n], 0, 0, 0); } \
        __builtin_amdgcn_s_setprio(0); } while (0)
#define PG8_WAIT_V(n) asm volatile("s_waitcnt vmcnt(" #n ")" ::: "memory")
#define PG8_WAIT_L(n) asm volatile("s_waitcnt lgkmcnt(" #n ")" ::: "memory")
#define PG8_BAR __builtin_amdgcn_s_barrier()
#define PG8_SCHED __builtin_amdgcn_sched_barrier(0)
    Unit cur, nxt; int ui = 0;
    if (!S.next(0, cur)) return;
    Acc acc;
#pragma unroll
    for (int a = 0; a < 2; ++a)
#pragma unroll
        for (int b = 0; b < 2; ++b)
#pragma unroll
            for (int m = 0; m < 4; ++m)
#pragma unroll
                for (int n = 0; n < 2; ++n) acc[a][b][m][n] = (f32x4){0.f, 0.f, 0.f, 0.f};
    bf16x8 At[4][2], B0[2][2], B1[2][2]; v8i_t At8[4], B08[2], B18[2];
    const char* cA = PG8_APTR(cur); const char* cB = PG8_BPTR(cur);
#define PG8_RS(par, pm_) do { if constexpr (Epi::NEEDS_RS) __builtin_amdgcn_global_load_lds((const unsigned*)(E.part + (size_t)(pm_) * BM * 8 + wid * 256 + lane * 4), \
        (LAS unsigned*)(lds + ((par) ? RS_OFF1 : RS_OFF0) + ldsw), 16, 0, 0); } while (0)
    PG8_RS(0, cur.pm);
    PG8_STAGE(PG8_SB(0, 0), cB, voffB); PG8_STAGE(PG8_SB(0, 1), cB + hstepB, voffB); PG8_STAGE(PG8_SA(0, 0), cA, voffA); PG8_STAGE(PG8_SA(0, 1), cA + hstepA, voffA);
    if (wr == 1) PG8_BAR;
    PG8_WAIT_V(2); PG8_BAR;
    PG8_STAGE(PG8_SB(1, 0), cB + kstep, voffB); PG8_STAGE(PG8_SA(1, 0), cA + kstep, voffA); PG8_STAGE(PG8_SB(1, 1), cB + hstepB + kstep, voffB);
    PG8_WAIT_V(6); PG8_BAR;
    for (;;) {
        const bool has_next = S.next(ui + 1, nxt);
        const char* nA = has_next ? PG8_APTR(nxt) : cA; const char* nB = has_next ? PG8_BPTR(nxt) : cB;
        for (int t = 0; t < nt; t += 2) {
            const bool last = (t == nt - 2);
            const char* a1 = cA + (size_t)(t + 1) * kstep;
            const char* a2 = last ? nA : cA + (size_t)(t + 2) * kstep; const char* b2 = last ? nB : cB + (size_t)(t + 2) * kstep;
            const char* a3 = a2 + kstep; const char* b3 = b2 + kstep;
            PG8_LDB(B0, 0, 0); PG8_LDB(B1, 0, 1); PG8_SCHED; PG8_LDA(At, 0, 0); PG8_STAGE(PG8_SA(1, 1), a1 + hstepA, voffA);
            PG8_WAIT_V(8); PG8_WAIT_L(0); PG8_BAR; PG8_MMA(0, 0, At, B0); PG8_MMA(0, 1, At, B1); PG8_BAR; PG8_SCHED;
            PG8_LDA(At, 0, 1); PG8_STAGE(PG8_SB(0, 0), b2, voffB); PG8_STAGE(PG8_SB(0, 1), b2 + hstepB, voffB); PG8_STAGE(PG8_SA(0, 0), a2, voffA);
            PG8_WAIT_V(8); PG8_WAIT_L(0); PG8_BAR; PG8_MMA(1, 0, At, B0); PG8_MMA(1, 1, At, B1); PG8_BAR; PG8_SCHED;
            PG8_LDB(B0, 1, 0); PG8_LDB(B1, 1, 1); PG8_SCHED; PG8_LDA(At, 1, 0); PG8_STAGE(PG8_SA(0, 1), a2 + hstepA, voffA);
            PG8_WAIT_V(8); PG8_WAIT_L(0); PG8_BAR; PG8_MMA(0, 0, At, B0); PG8_MMA(0, 1, At, B1); PG8_BAR; PG8_SCHED;
            PG8_LDA(At, 1, 1); PG8_STAGE(PG8_SB(1, 0), b3, voffB); PG8_STAGE(PG8_SB(1, 1), b3 + hstepB, voffB); PG8_STAGE(PG8_SA(1, 0), a3, voffA);
            PG8_WAIT_V(8); PG8_WAIT_L(0); PG8_BAR; PG8_MMA(1, 0, At, B0); PG8_MMA(1, 1, At, B1); PG8_BAR; PG8_SCHED;
        }
        if (wr == 0) PG8_BAR;
        if (has_next) PG8_RS((ui + 1) & 1, nxt.pm);
        if constexpr (FP8) { asm volatile("s_nop 15\n\ts_nop 15" ::: "memory"); __builtin_amdgcn_sched_barrier(0); }
        E(acc, cur, wr, wc, fr, fq, (const LAS float*)(lds + ((ui & 1) ? RS_OFF1 : RS_OFF0)));
        if (!has_next) break;
        if (!E.keep(cur)) {
#pragma unroll
            for (int a = 0; a < 2; ++a)
#pragma unroll
                for (int b = 0; b < 2; ++b)
#pragma unroll
                    for (int m = 0; m < 4; ++m)
#pragma unroll
                        for (int n = 0; n < 2; ++n) acc[a][b][m][n] = (f32x4){0.f, 0.f, 0.f, 0.f};
        }
        cur = nxt; cA = nA; cB = nB; ++ui;
        if (wr == 1) PG8_BAR;
    }
    PG8_WAIT_V(0);
    PG8_BAR;
#undef PG8_APTR
#undef PG8_BPTR
#undef PG8_SA
#undef PG8_SB
#undef PG8_STAGE
#undef PG8_RS
#undef PG8_LDA
#undef PG8_LDB
#undef PG8_MMA
#undef PG8_WAIT_V
#undef PG8_WAIT_L
#undef PG8_BAR
#undef PG8_SCHED
}
}

constexpr size_t MiB = 1u << 20;
constexpr size_t WS_CTL = 0, CTL_ZERO_BYTES = 1 * MiB;
constexpr size_t WS_KSUM = 1 * MiB;
constexpr size_t WS_TAB = 1 * MiB + 512 * 1024;
constexpr size_t WS_WSB = 1 * MiB + 768 * 1024;
constexpr size_t WS_LIST = 2 * MiB;
constexpr size_t WS_LSLOT = 10 * MiB;
constexpr size_t WS_W = 16 * MiB;
constexpr size_t W_IN_OFF = 0, W_OUT_OFF = 52 * MiB, W_O_OFF = 60 * MiB, W_MI_OFF = 68 * MiB, W_MO_OFF = 100 * MiB;
constexpr size_t WS_ACTA = 148 * MiB;
constexpr size_t WS_U = 276 * MiB;
constexpr size_t WS_Z = 404 * MiB;
constexpr size_t WS_OSLOT = 1236 * MiB;
constexpr size_t WS_H8 = 1428 * MiB;
constexpr size_t WS_XB = 1492 * MiB;
constexpr size_t WS_END = 1620 * MiB;
constexpr size_t WS_PART = 12 * MiB;
constexpr size_t W_G8_OFF = 20 * MiB;
constexpr int CW_TMO = 0, CW_BAR = 4096, CW_CNT = 16384;

constexpr int MISC_OFF = 143360;
constexpr int LDS_BYTES = 155648;

#define XB_TMO      128
#define XB_XCNT(j)  (256  + 64 * (j))
#define XB_XSUB(j)  (1280 + 64 * (j))
#define XB_XGEN(j)  (2304 + 64 * (j))
#define XB_TOP      3328
#define XB_TOPGEN   3392
#define XCD_BAR_WORDS 3456
#define XB_SPIN_CAP (1u << 18)
__device__ __forceinline__ unsigned xb_ld(unsigned* p)              { return __hip_atomic_load(p, __ATOMIC_RELAXED, __HIP_MEMORY_SCOPE_AGENT); }
__device__ __forceinline__ unsigned xb_add(unsigned* p, unsigned v) { return __hip_atomic_fetch_add(p, v, __ATOMIC_RELAXED, __HIP_MEMORY_SCOPE_AGENT); }
__device__ __forceinline__ unsigned xb_xcc_id() { return (unsigned)__builtin_amdgcn_s_getreg((3 << 11) | 20) & 0xFu; }
#define XB_SPIN(cond, bar) do { unsigned _sp = 0; while (cond) { __builtin_amdgcn_s_sleep(1); \
    if ((++_sp & 255u) == 0u) { if (xb_ld(&(bar)[XB_TMO])) break; if (_sp > XB_SPIN_CAP) { atomicAdd(&(bar)[XB_TMO], 1u); break; } } } } while (0)
struct XcdBarrier { unsigned* bar; unsigned x; volatile LAS unsigned* st; };
__device__ __forceinline__ XcdBarrier xcd_barrier_post(unsigned* bar, volatile LAS unsigned* st) {
    XcdBarrier b; b.bar = bar; b.x = xb_xcc_id(); b.st = st;
    if (threadIdx.x == 0) (void)xb_add(&bar[XB_XCNT(b.x)], 1u);
    return b;
}
__device__ __forceinline__ void xcd_barrier_complete(unsigned* bar, unsigned x, unsigned& nloc, unsigned& nx) {
    const unsigned G = gridDim.x * gridDim.y * gridDim.z;
    unsigned sum, cnt, mine, sp = 0u;
    for (;;) {
        sum = 0u; cnt = 0u; mine = 0u;
#pragma unroll
        for (unsigned j = 0; j < 16; ++j) { const unsigned c = xb_ld(&bar[XB_XCNT(j)]); sum += c; cnt += (c > 0u) ? 1u : 0u; mine = (j == x) ? c : mine; }
        if (sum == G) break;
        __builtin_amdgcn_s_sleep(1);
        if ((++sp & 255u) == 0u) { if (xb_ld(&bar[XB_TMO])) break; if (sp > XB_SPIN_CAP) { atomicAdd(&bar[XB_TMO], 1u); break; } }
    }
    nloc = mine > 0u ? mine : 1u; nx = cnt > 0u ? cnt : 1u;
}
__device__ __forceinline__ void xcd_barrier(const XcdBarrier& b) {
    asm volatile("s_waitcnt vmcnt(0)" ::: "memory");
    __syncthreads();
    if (threadIdx.x == 0) {
        unsigned* bar = b.bar;
        __builtin_amdgcn_s_waitcnt(0);
        unsigned nloc = b.st[0], nx = b.st[1];
        if (nloc == 0u) { xcd_barrier_complete(bar, b.x, nloc, nx); b.st[0] = nloc; b.st[1] = nx; }
        const unsigned old = xb_add(&bar[XB_XSUB(b.x)], 1u);
        const unsigned gen = old / nloc;
        if (old + 1u == (gen + 1u) * nloc) {
            __builtin_amdgcn_fence(__ATOMIC_RELEASE, "agent");
            asm volatile("s_waitcnt vmcnt(0)" ::: "memory");
            const unsigned og = xb_add(&bar[XB_TOP], 1u);
            const unsigned tg = og / nx;
            if (og + 1u == (tg + 1u) * nx) xb_add(&bar[XB_TOPGEN], 1u);
            else XB_SPIN(xb_ld(&bar[XB_TOPGEN]) == tg, bar);
            __builtin_amdgcn_fence(__ATOMIC_ACQUIRE, "agent");
            xb_add(&bar[XB_XGEN(b.x)], 1u);
            asm volatile("s_waitcnt vmcnt(0)" ::: "memory");
        } else {
            XB_SPIN(xb_ld(&bar[XB_XGEN(b.x)]) == gen, bar);
            __builtin_amdgcn_fence(__ATOMIC_ACQUIRE, "agent");
            asm volatile("s_waitcnt vmcnt(0)" ::: "memory");
        }
    }
    __syncthreads();
}

struct Args { const float* in[23]; float* out; unsigned char* ws; };
#define LDS_WAIT() asm volatile("s_waitcnt lgkmcnt(0)" ::: "memory")

template <bool FP8>
__device__ __forceinline__ void transpose_item(const float* W, const float* gk, int K, int N, void* WTv, int n_first, LAS float* scr, int item, int lane) {
    const int nblk = N / 64, kb = item / nblk, nb = item % nblk, k0 = 64 * kb, n0 = 64 * nb;
    const int lr = lane >> 4, lc = lane & 15;
    f32x4 v[16];
#pragma unroll
    for (int i = 0; i < 16; ++i) v[i] = *(const GAS f32x4*)(W + (size_t)(k0 + 4 * i + lr) * N + n0 + 4 * lc);
#pragma unroll
    for (int i = 0; i < 16; ++i) { const int kk = 4 * i + lr; *(LAS f32x4*)(scr + kk * 68 + 4 * (lc ^ ((kk >> 3) & 7))) = v[i]; }
    LDS_WAIT(); asm volatile("" ::: "memory");
    if constexpr (!FP8) {
        bf16_t* WT = (bf16_t*)WTv; const int c = lane & 7;
        float g8[8];
#pragma unroll
        for (int e = 0; e < 8; ++e) g8[e] = gk ? gk[k0 + 8 * c + e] : 1.0f;
#pragma unroll
        for (int j = 0; j < 8; ++j) { const int n = (lane >> 3) + 8 * j; const LAS float* sp = scr + (8 * c) * 68 + 4 * ((n >> 2) ^ c) + (n & 3);
            u32x4 o; o.x = pk2(sp[0 * 68] * g8[0], sp[1 * 68] * g8[1]); o.y = pk2(sp[2 * 68] * g8[2], sp[3 * 68] * g8[3]); o.z = pk2(sp[4 * 68] * g8[4], sp[5 * 68] * g8[5]); o.w = pk2(sp[6 * 68] * g8[6], sp[7 * 68] * g8[7]);
            *(GAS u32x4*)(WT + (size_t)(n0 - n_first + n) * K + k0 + 8 * c) = o; }
    } else {
        unsigned char* W8 = (unsigned char*)WTv; const int c = lane & 3;
        float g16[16];
#pragma unroll
        for (int e = 0; e < 16; ++e) g16[e] = gk[k0 + 16 * c + e] * 64.f;
#pragma unroll
        for (int j = 0; j < 4; ++j) { const int n = (lane >> 2) + 16 * j; float t[16];
#pragma unroll
            for (int e = 0; e < 16; ++e) t[e] = scr[(16 * c + e) * 68 + 4 * ((n >> 2) ^ ((2 * c + (e >> 3)) & 7)) + (n & 3)] * g16[e];
            u32x4 o;
#pragma unroll
            for (int q = 0; q < 4; ++q) { int w = __builtin_amdgcn_cvt_pk_fp8_f32(t[4 * q], t[4 * q + 1], 0, false); w = __builtin_amdgcn_cvt_pk_fp8_f32(t[4 * q + 2], t[4 * q + 3], w, true); o[q] = (unsigned)w; }
            *(GAS u32x4*)(W8 + (size_t)(n0 - n_first + n) * K + k0 + 16 * c) = o; }
    }
    LDS_WAIT(); asm volatile("" ::: "memory");
}

__device__ __forceinline__ int rel_bucket(int n) {
    if (n < 16) return n;
    int b = 16;
    b += (n >= 22); b += (n >= 30); b += (n >= 40); b += (n >= 54); b += (n >= 73); b += (n >= 99); b += (n >= 134); b += (n >= 182);
    b += (n >= 246); b += (n >= 332); b += (n >= 450); b += (n >= 609); b += (n >= 825); b += (n >= 1117); b += (n >= 1513);
    return b;
}

__device__ __forceinline__ void x_rows_in(const float* x, bf16_t* xb, unsigned char* x8, float* part, int gw, int ngw, int lane) {
    for (int m = gw; m < MROWS; m += ngw) {
        const GAS f32x4* xr = (const GAS f32x4*)(x + (size_t)m * DM) + lane;
        f32x4 v[8]; float s = 0.f;
#pragma unroll
        for (int j = 0; j < 8; ++j) { v[j] = xr[64 * j]; s += (v[j].x * v[j].x + v[j].y * v[j].y) + (v[j].z * v[j].z + v[j].w * v[j].w); }
        s = wave_sum(s);
        GAS u32x2* o8 = (GAS u32x2*)(xb + (size_t)m * DM) + lane;
#pragma unroll
        for (int j = 0; j < 8; ++j) { u32x2 w; w.x = pk2(v[j].x, v[j].y); w.y = pk2(v[j].z, v[j].w); o8[64 * j] = w;
            int f = __builtin_amdgcn_cvt_pk_fp8_f32(v[j].x, v[j].y, 0, false); f = __builtin_amdgcn_cvt_pk_fp8_f32(v[j].z, v[j].w, f, true); *((GAS unsigned*)(x8 + (size_t)m * DM) + lane + 64 * j) = (unsigned)f; }
        if (lane < 8) part[(size_t)m * 8 + lane] = lane == 0 ? s : 0.f;
    }
}

__device__ __forceinline__ unsigned off_b(unsigned row, unsigned ch) { return 256u * row + 16u * (ch ^ (((row & 3) << 2) | ((row >> 2) & 3))); }
__device__ __forceinline__ s16x4 vtr(const LAS unsigned char* p) { typedef short v4i16_t __attribute__((ext_vector_type(4))); return __builtin_bit_cast(s16x4, __builtin_amdgcn_ds_read_tr16_b64_v4i16((LAS v4i16_t*)p)); }
__device__ __forceinline__ int crow(int r, int hi) { return (r & 3) + 8 * (r >> 2) + 4 * hi; }

__device__ __forceinline__ void store_o_bf16(bf16_t* p, const f32x16 (&o)[4], float scale, int hi) {
#pragma unroll
    for (int c = 0; c < 4; ++c)
#pragma unroll
        for (int kp = 0; kp < 2; ++kp) {
            unsigned ax = pk2(o[c][8 * kp] * scale, o[c][8 * kp + 1] * scale), ay = pk2(o[c][8 * kp + 2] * scale, o[c][8 * kp + 3] * scale);
            unsigned bx = pk2(o[c][8 * kp + 4] * scale, o[c][8 * kp + 5] * scale), by = pk2(o[c][8 * kp + 6] * scale, o[c][8 * kp + 7] * scale);
            auto r0 = __builtin_amdgcn_permlane32_swap(ax, bx, false, false); auto r1 = __builtin_amdgcn_permlane32_swap(ay, by, false, false);
            *(GAS u32x4*)(p + 32 * c + 16 * kp + 8 * hi) = (u32x4){r0[0], r1[0], r0[1], r1[1]};
        }
}
__device__ __forceinline__ void load_add_o_bf16(const bf16_t* p, f32x16 (&o)[4], int hi) {
    u32x4 L[4][2];
#pragma unroll
    for (int c = 0; c < 4; ++c)
#pragma unroll
        for (int kp = 0; kp < 2; ++kp) L[c][kp] = *(const GAS u32x4*)(p + 32 * c + 16 * kp + 8 * hi);
#pragma unroll
    for (int c = 0; c < 4; ++c)
#pragma unroll
        for (int kp = 0; kp < 2; ++kp) {
            auto r0 = __builtin_amdgcn_permlane32_swap(L[c][kp].x, L[c][kp].z, false, false); auto r1 = __builtin_amdgcn_permlane32_swap(L[c][kp].y, L[c][kp].w, false, false);
            o[c][8 * kp] += bflo(r0[0]); o[c][8 * kp + 1] += bfhi(r0[0]); o[c][8 * kp + 2] += bflo(r1[0]); o[c][8 * kp + 3] += bfhi(r1[0]);
            o[c][8 * kp + 4] += bflo(r0[1]); o[c][8 * kp + 5] += bfhi(r0[1]); o[c][8 * kp + 6] += bflo(r1[1]); o[c][8 * kp + 7] += bfhi(r1[1]);
        }
}

template <bool CAUSAL>
__device__ __forceinline__ void attn_core(const LAS unsigned char* ldsK, const LAS unsigned char* ldsV, const LAS float* tab, const bf16x8 (&qf)[8], int qrel, int ntiles, int lane, f32x16 (&o)[4], float& lsum) {
    const int r32 = lane & 31, hi = lane >> 5, blk16 = (lane >> 4) & 1, q4 = (lane & 15) >> 2, p4 = lane & 3;
    unsigned vlow[2], vc[4];
#pragma unroll
    for (int t = 0; t < 2; ++t) vlow[t] = 256u * (8 * t + 4 * hi + q4) + 16u * ((unsigned)(2 * blk16 + (p4 >> 1)) ^ (unsigned)((2 * t + hi) & 3)) + 8u * (p4 & 1);
#pragma unroll
    for (int c = 0; c < 4; ++c) vc[c] = 64u * (unsigned)(c ^ q4);
    unsigned koff[8], voff[2][4];
    unsigned vrel = (unsigned)(ldsV - ldsK); asm volatile("" : "+v"(vrel));
#pragma unroll
    for (int s = 0; s < 8; ++s) koff[s] = off_b(r32, 2 * s + hi);
#pragma unroll
    for (int t = 0; t < 2; ++t)
#pragma unroll
        for (int c = 0; c < 4; ++c) voff[t][c] = vrel + vlow[t] + vc[c];
    for (int kt = 0; kt < ntiles; ++kt) {
        const int dbase = qrel - 64 * kt - 4 * hi;
        const LAS float* tq = tab + (TREV - (dbase < 0 ? 0 : (dbase > TREV ? TREV : dbase)));
        f32x16 s0, s1;
#pragma unroll
        for (int r = 0; r < 16; ++r) { s0[r] = tq[(r & 3) + 8 * (r >> 2)]; s1[r] = tq[32 + (r & 3) + 8 * (r >> 2)]; }
        const unsigned kb = 16384u * (unsigned)kt;
        bf16x8 a0 = *(const LAS bf16x8*)(ldsK + (koff[0] + kb)), a1 = *(const LAS bf16x8*)(ldsK + (koff[0] + kb) + 8192);
#pragma unroll
        for (int s = 0; s < 8; ++s) {
            bf16x8 n0 = a0, n1 = a1;
            if (s < 7) { const LAS unsigned char* ka = ldsK + (koff[s + 1] + kb); n0 = *(const LAS bf16x8*)ka; n1 = *(const LAS bf16x8*)(ka + 8192); }
            __builtin_amdgcn_sched_barrier(0x6);
            s0 = __builtin_amdgcn_mfma_f32_32x32x16_bf16(a0, qf[s], s0, 0, 0, 0);
            s1 = __builtin_amdgcn_mfma_f32_32x32x16_bf16(a1, qf[s], s1, 0, 0, 0);
            __builtin_amdgcn_sched_barrier(0x6);
            a0 = n0; a1 = n1;
        }
#pragma unroll
        for (int r = 0; r < 16; ++r) {
            float p0 = __builtin_amdgcn_exp2f(s0[r]), p1 = __builtin_amdgcn_exp2f(s1[r]);
            if (CAUSAL) { const int e0 = (r & 3) + 8 * (r >> 2); p0 = dbase < e0 ? 0.f : p0; p1 = dbase < e0 + 32 ? 0.f : p1; }
            s0[r] = p0; s1[r] = p1;
        }
        bf16x8 pf[4];
        typedef __bf16 bf16x2_t __attribute__((ext_vector_type(2)));
        const bf16x2_t ones = __builtin_bit_cast(bf16x2_t, 0x3f803f80u);
#pragma unroll
        for (int s = 0; s < 2; ++s) {
            u32x4 w0, w1;
            w0.x = pk2(s0[8 * s + 0], s0[8 * s + 1]); w0.y = pk2(s0[8 * s + 2], s0[8 * s + 3]); w0.z = pk2(s0[8 * s + 4], s0[8 * s + 5]); w0.w = pk2(s0[8 * s + 6], s0[8 * s + 7]);
            w1.x = pk2(s1[8 * s + 0], s1[8 * s + 1]); w1.y = pk2(s1[8 * s + 2], s1[8 * s + 3]); w1.z = pk2(s1[8 * s + 4], s1[8 * s + 5]); w1.w = pk2(s1[8 * s + 6], s1[8 * s + 7]);
#pragma unroll
            for (int d = 0; d < 4; ++d) { const unsigned u0 = w0[d], u1 = w1[d];
                lsum = __builtin_amdgcn_fdot2_f32_bf16(__builtin_bit_cast(bf16x2_t, u0), ones, lsum, false); lsum = __builtin_amdgcn_fdot2_f32_bf16(__builtin_bit_cast(bf16x2_t, u1), ones, lsum, false); }
            pf[s] = __builtin_bit_cast(bf16x8, w0); pf[2 + s] = __builtin_bit_cast(bf16x8, w1);
        }
        s16x4 lo = vtr(ldsK + (voff[0][0] + kb)), hh = vtr(ldsK + (voff[1][0] + kb));
#pragma unroll
        for (int i = 0; i < 16; ++i) { const int c = i >> 2, ks = i & 3;
            s16x4 nlo = lo, nhh = hh;
            if (i < 15) { const int c2 = (i + 1) >> 2, ks2 = (i + 1) & 3; nlo = vtr(ldsK + (voff[0][c2] + kb) + 4096 * ks2); nhh = vtr(ldsK + (voff[1][c2] + kb) + 4096 * ks2); }
            __builtin_amdgcn_sched_barrier(0x6);
            const bf16x8 vf = (bf16x8){lo[0], lo[1], lo[2], lo[3], hh[0], hh[1], hh[2], hh[3]};
            o[c] = __builtin_amdgcn_mfma_f32_32x32x16_bf16(vf, pf[ks], o[c], 0, 0, 0);
            __builtin_amdgcn_sched_barrier(0x6);
            lo = nlo; hh = nhh;
        }
    }
}

__device__ __forceinline__ void load_kv(const bf16_t* Z, const float* tabg, LAS unsigned char* ldsK, LAS unsigned char* ldsV, LAS float* tab, float M2, int b, int h, int j, int tid) {
    const bf16_t* kbase = Z + (size_t)(b * SEQ + j * 256) * ZP + OFF_D + 512 + h * HD;
#pragma unroll
    for (int i = 0; i < 8; ++i) { const int idx = tid + 512 * i, row = idx >> 4, ch = idx & 15;
        const u32x4 kv = ldg16(kbase + (size_t)row * ZP + 8 * ch), vv = ldg16(kbase + (size_t)row * ZP + 512 + 8 * ch);
        *(LAS u32x4*)(ldsK + off_b(row, ch)) = kv; *(LAS u32x4*)(ldsV + off_b(row, ch)) = vv; }
    for (int i = tid; i < TABP; i += 512) { const int d = TREV - i; tab[i] = tabg[h * TABN + (d < 0 ? 0 : (d > TABN - 1 ? TABN - 1 : d))] - M2; }
}

__global__ void __launch_bounds__(512, 2) fwd(Args args) {
    extern __shared__ __attribute__((aligned(16))) unsigned char lds_raw[];
    LAS unsigned char* lds = (LAS unsigned char*)lds_raw;
    volatile LAS unsigned* MISC = (volatile LAS unsigned*)(lds + MISC_OFF);
    const int G = gridDim.x, bx = blockIdx.x;
    const int vcu = (G % 8 == 0) ? (bx % 8) * (G / 8) + bx / 8 : bx;
    const int ngw = G * 8;
    { const int tid0 = threadIdx.x; for (int u = tid0; u < (LDS_BYTES - MISC_OFF) / 4; u += 512) ((LAS unsigned*)(lds + MISC_OFF))[u] = 0u; }
    __syncthreads();
    XcdBarrier bar = xcd_barrier_post((unsigned*)(args.ws + WS_CTL) + CW_BAR, MISC + 8);
    float* xout = args.out;
#define LANE_VARS const int tid = opaque_tid(); const int lane = tid & 63; const int wave = __builtin_amdgcn_readfirstlane(tid >> 6); const int gw = vcu * 8 + wave; (void)tid; (void)lane; (void)wave; (void)gw;
#define PHASE_VARS \
    const int tid = opaque_tid(); const int lane = tid & 63; const int wave = __builtin_amdgcn_readfirstlane(tid >> 6); const int gw = vcu * 8 + wave; \
    unsigned char* ws = opaque_ptr(args.ws); unsigned* ctl = (unsigned*)(ws + WS_CTL); \
    float* ksum = (float*)(ws + WS_KSUM); float* tabg = (float*)(ws + WS_TAB); bf16_t* Wsb = (bf16_t*)(ws + WS_WSB); \
    unsigned short* lists = (unsigned short*)(ws + WS_LIST); float* lslot = (float*)(ws + WS_LSLOT); \
    bf16_t* Wt_in = (bf16_t*)(ws + WS_W + W_IN_OFF); bf16_t* Wt_out = (bf16_t*)(ws + WS_W + W_OUT_OFF); bf16_t* Wt_o = (bf16_t*)(ws + WS_W + W_O_OFF); \
    bf16_t* Wt_mi = (bf16_t*)(ws + WS_W + W_MI_OFF); bf16_t* Wt_mo = (bf16_t*)(ws + WS_W + W_MO_OFF); \
    unsigned char* h8 = ws + WS_H8; unsigned char* Wg8 = ws + WS_W + W_G8_OFF; bf16_t* xb = (bf16_t*)(ws + WS_XB); float* part = (float*)(ws + WS_PART); (void)h8; (void)Wg8; (void)xb; (void)part; \
    bf16_t* actA = (bf16_t*)(ws + WS_ACTA); bf16_t* U = (bf16_t*)(ws + WS_U); bf16_t* Z = (bf16_t*)(ws + WS_Z); float* oslot = (float*)(ws + WS_OSLOT); \
    (void)tid; (void)lane; (void)wave; (void)gw; (void)ctl; (void)ksum; (void)tabg; (void)Wsb; (void)lists; (void)lslot; (void)Wt_in; (void)Wt_out; (void)Wt_o; (void)Wt_mi; (void)Wt_mo; (void)actA; (void)U; (void)Z; (void)oslot;

    for (int l = 0; l < DEPTH; ++l) {
        if (PH_MASK & (1 << 0)) REP(0) { PHASE_VARS
            LAS float* scr = (LAS float*)(lds + wave * 17408);
            constexpr int I_IN = (DM / 64) * (ZP / 64), I_OUT1 = (512 / 64) * (DM / 64), I_O = (DM / 64) * (DM / 64), I_MI = (DM / 64) * (DFF / 64), I_MO = (DFF / 64) * (DM / 64);
            constexpr int NITEMS = I_IN + 4 * I_OUT1 + I_O + I_MI + I_MO;
            const float* w_in = args.in[3] + (size_t)l * DM * ZP;
            const float* w_oa = args.in[5] + (size_t)l * 512 * DM; const float* w_ob = args.in[10] + (size_t)l * 512 * DM;
            const float* w_oc = args.in[15] + (size_t)l * 512 * DM; const float* w_od = args.in[18] + (size_t)l * 512 * DM;
            const float* gmix = args.in[2] + (size_t)l * DM; const float* gmlp = args.in[20] + (size_t)l * DM;
            const float* w_o = args.in[19] + (size_t)l * DM * DM; const float* w_mi = args.in[21] + (size_t)l * DM * DFF; const float* w_mo = args.in[22] + (size_t)l * DFF * DM;
            for (int it = gw; it < NITEMS; it += ngw) {
                int r = it;
                if (r < I_IN) { if ((r % (ZP / 64)) < OFF_G / 64) transpose_item<false>(w_in, gmix, DM, ZP, Wt_in, 0, scr, r, lane); else transpose_item<true>(w_in, gmix, DM, ZP, Wg8, OFF_G, scr, r, lane); continue; } r -= I_IN;
                if (r < I_OUT1) { transpose_item<false>(w_oa, nullptr, 512, DM, Wt_out, 0, scr, r, lane); continue; } r -= I_OUT1;
                if (r < I_OUT1) { transpose_item<false>(w_ob, nullptr, 512, DM, Wt_out + (size_t)DM * 512, 0, scr, r, lane); continue; } r -= I_OUT1;
                if (r < I_OUT1) { transpose_item<false>(w_oc, nullptr, 512, DM, Wt_out + (size_t)2 * DM * 512, 0, scr, r, lane); continue; } r -= I_OUT1;
                if (r < I_OUT1) { transpose_item<false>(w_od, nullptr, 512, DM, Wt_out + (size_t)3 * DM * 512, 0, scr, r, lane); continue; } r -= I_OUT1;
                if (r < I_O) { transpose_item<false>(w_o, nullptr, DM, DM, Wt_o, 0, scr, r, lane); continue; } r -= I_O;
                if (r < I_MI) { transpose_item<false>(w_mi, gmlp, DM, DFF, Wt_mi, 0, scr, r, lane); continue; } r -= I_MI;
                transpose_item<false>(w_mo, nullptr, DFF, DM, Wt_mo, 0, scr, r, lane);
            }
            const float* wsp = args.in[13] + (size_t)l * 4 * 128 * 128;
            for (int e = bx * 512 + tid; e < 4 * 128 * 128; e += G * 512) { const int t = (e >> 7) & 127, s = e & 127; Wsb[e] = (bf16_t)(pk2(s <= t ? wsp[e] : 0.f, 0.f) & 0xffffu); }
            if (l == 0) for (int e = bx * 512 + tid; e < NH * TABN; e += G * 512) { const int h = e / TABN, d = e % TABN; tabg[e] = args.in[1][rel_bucket(d) * NH + h] * LOG2E; }
            if (l == 0) x_rows_in(args.in[0], xb, h8, part, gw, ngw, lane);
        }
        xcd_barrier(bar);
        if (PH_MASK & (1 << 1)) REP(1) { PHASE_VARS
            { pg8::Gemm g{xb, Wt_in, DM * 2, DM * 2, DM * 2, 0, 0}; pg8::StaticOrder<0> S; S.init(MROWS, OFF_G, G, bx);
              pg8::EpiZ E{Z, part, 0, 0, 1.0f};
              pg8::gemm_phase<pg8::EpiZ, pg8::StaticOrder<0>, false>(lds, g, S, E, tid); }
        }
        xcd_barrier(bar);
        if (PH_MASK & (1 << 2)) { PHASE_VARS
            REP(11) { LANE_VARS
                const float* cw = args.in[4] + (size_t)l * 3 * 512;
                for (int unit = vcu; unit < MROWS / 128; unit += G) {
                    const int c8 = 8 * lane;
                    float w[3][8];
#pragma unroll
                    for (int k = 0; k < 3; ++k) { const f32x4 w0 = *(const GAS f32x4*)(cw + k * 512 + c8), w1 = *(const GAS f32x4*)(cw + k * 512 + c8 + 4);
#pragma unroll
                        for (int e = 0; e < 4; ++e) { w[k][e] = w0[e]; w[k][4 + e] = w1[e]; } }
                    const int t0 = unit * 128 + wave * 16, tseq0 = t0 & (SEQ - 1);
                    float h2[8], h1[8];
                    { const int r2 = tseq0 >= 2 ? t0 - 2 : t0, r1 = tseq0 >= 1 ? t0 - 1 : t0; const float m2 = tseq0 >= 2 ? 1.f : 0.f, m1 = tseq0 >= 1 ? 1.f : 0.f;
                      float a2[8], x2[8], a1[8], x1[8];
                      unpack8(ldg16(Z + (size_t)r2 * ZP + OFF_A + 512 + c8), a2); unpack8(ldg16(Z + (size_t)r2 * ZP + OFF_A + 1024 + c8), x2);
                      unpack8(ldg16(Z + (size_t)r1 * ZP + OFF_A + 512 + c8), a1); unpack8(ldg16(Z + (size_t)r1 * ZP + OFF_A + 1024 + c8), x1);
#pragma unroll
                      for (int e = 0; e < 8; ++e) { h2[e] = a2[e] * x2[e] * m2; h1[e] = a1[e] * x1[e] * m1; } }
#pragma unroll
                    for (int gq = 0; gq < 4; ++gq) {
                        u32x4 rb[4], rc[4], rx[4];
#pragma unroll
                        for (int q = 0; q < 4; ++q) { const bf16_t* zp = Z + (size_t)(t0 + 4 * gq + q) * ZP + OFF_A + c8; rb[q] = ldg16(zp); rc[q] = ldg16(zp + 512); rx[q] = ldg16(zp + 1024); }
#pragma unroll
                        for (int q = 0; q < 4; ++q) {
                            float ab[8], ac[8], ax[8], o[8]; unpack8(rb[q], ab); unpack8(rc[q], ac); unpack8(rx[q], ax);
#pragma unroll
                            for (int e = 0; e < 8; ++e) { const float cx = ac[e] * ax[e]; o[e] = ab[e] * (w[0][e] * h2[e] + w[1][e] * h1[e] + w[2][e] * cx); h2[e] = h1[e]; h1[e] = cx; }
                            stg16(U + (size_t)(t0 + 4 * gq + q) * DM + c8, pack8(o));
                        }
                    }
                }
            }
            REP(12) { LANE_VARS
                const float* gqp = args.in[16] + (size_t)l * HD; const float* gkp = args.in[17] + (size_t)l * HD;
                float gq[8], gk[8];
#pragma unroll
                for (int e = 0; e < 8; ++e) { gq[e] = gqp[(8 * lane + e) & 127] * QSCALE; gk[e] = gkp[(8 * lane + e) & 127]; }
                LAS float* red = (LAS float*)lds;
                for (int unit = vcu; unit < MROWS / 128; unit += G) {
                    float ks[8];
#pragma unroll
                    for (int e = 0; e < 8; ++e) ks[e] = 0.f;
#pragma unroll 1
                    for (int i4 = 0; i4 < 16; i4 += 4) {
                        u32x4 rq4[4], rk4[4];
#pragma unroll
                        for (int q = 0; q < 4; ++q) { const bf16_t* qp = Z + (size_t)(unit * 128 + wave * 16 + i4 + q) * ZP + OFF_D + 8 * lane; rq4[q] = ldg16(qp); rk4[q] = ldg16(qp + 512); }
#pragma unroll
                        for (int q4 = 0; q4 < 4; ++q4) {
                            const int row = unit * 128 + wave * 16 + i4 + q4;
                            bf16_t* qp = Z + (size_t)row * ZP + OFF_D + 8 * lane; bf16_t* kp = qp + 512;
                            float q[8], k[8]; unpack8(rq4[q4], q); unpack8(rk4[q4], k);
                            float sq = 0.f, sk = 0.f;
#pragma unroll
                            for (int e = 0; e < 8; ++e) { sq += q[e] * q[e]; sk += k[e] * k[e]; }
#pragma unroll
                            for (int o = 1; o < 16; o <<= 1) { sq += __shfl_xor(sq, o); sk += __shfl_xor(sk, o); }
                            const float rq = __builtin_amdgcn_rsqf(sq * (1.f / HD) + EPS), rk = __builtin_amdgcn_rsqf(sk * (1.f / HD) + EPS);
#pragma unroll
                            for (int e = 0; e < 8; ++e) { q[e] = q[e] * rq * gq[e]; k[e] = k[e] * rk * gk[e]; ks[e] += k[e]; }
                            if (rep) { bf16_t* dq = U + (size_t)row * DM + 1536 + 8 * lane; stg16(dq, pack8(q)); stg16(dq, pack8(k)); } else { stg16(qp, pack8(q)); stg16(kp, pack8(k)); }
                        }
                    }
#pragma unroll
                    for (int e = 0; e < 8; ++e) red[wave * 512 + 8 * lane + e] = ks[e];
                    __syncthreads();
                    { float s = 0.f;
#pragma unroll
                      for (int w = 0; w < 8; ++w) s += red[w * 512 + tid];
                      (rep ? lslot : ksum)[(size_t)unit * 512 + tid] = s; }
                    __syncthreads();
                }
            }
            REP(13) { LANE_VARS
                const float* cw = args.in[6] + (size_t)l * 31 * 512; const float* cb = args.in[7] + (size_t)l * 512;
                const float* lng = args.in[8] + (size_t)l * 512; const float* lnb = args.in[9] + (size_t)l * 512;
                LAS unsigned char* P = lds;
                for (int unit = vcu; unit < MROWS / 64; unit += G) {
                    const int t0 = unit * 64, tseq0 = t0 & (SEQ - 1);
                    {
                        u32x4 rba[12], rsg[12];
#pragma unroll
                        for (int q = 0; q < 12; ++q) { const int idx = tid + 512 * q, r = idx >> 6, ch = idx & 63; const bool ok = idx < 94 * 64 && (tseq0 - 30 + r >= 0);
                            const size_t grow = ok ? (size_t)(t0 - 30 + r) : (size_t)t0;
                            rba[q] = ldg16(Z + grow * ZP + OFF_B + 8 * ch); rsg[q] = ldg16(Z + grow * ZP + OFF_B + 512 + 8 * ch); }
                        asm volatile("" ::: "memory");
#pragma unroll
                        for (int q = 0; q < 12; ++q) { const int idx = tid + 512 * q, r = idx >> 6, ch = idx & 63; const bool ok = (tseq0 - 30 + r >= 0);
                            float ba[8], sg[8]; unpack8(rba[q], ba); unpack8(rsg[q], sg);
#pragma unroll
                            for (int e = 0; e < 8; ++e) ba[e] = ok ? ba[e] * sg[e] : 0.f;
                            if (idx < 94 * 64) *(LAS u32x4*)(P + r * 1024 + ch * 16) = pack8(ba); }
                    }
                    __syncthreads();
                    {
                        float w[31];
#pragma unroll
                        for (int k = 0; k < 31; ++k) w[k] = cw[k * 512 + tid];
                        const float bias = cb[tid];
                        LAS unsigned short* Pc = (LAS unsigned short*)P + tid;
                        for (int grp = 0; grp < 8; ++grp) {
                            float pv[38];
#pragma unroll
                            for (int i = 0; i < 38; ++i) pv[i] = __uint_as_float((unsigned)Pc[(grp * 8 + i) * 512] << 16);
                            float hb[8];
#pragma unroll
                            for (int o = 0; o < 8; ++o) { float a = bias;
#pragma unroll
                                for (int k = 0; k < 31; ++k) a += w[k] * pv[o + k];
                                hb[o] = a; }
#pragma unroll
                            for (int o = 0; o < 8; o += 2) { const unsigned pkd = pk2(hb[o], hb[o + 1]); Pc[(grp * 8 + o) * 512] = (unsigned short)(pkd & 0xffffu); Pc[(grp * 8 + o + 1) * 512] = (unsigned short)(pkd >> 16); }
                        }
                    }
                    __syncthreads();
                    {
                        float gg[8], bb[8];
#pragma unroll
                        for (int e = 0; e < 8; ++e) { gg[e] = lng[8 * lane + e]; bb[e] = lnb[8 * lane + e]; }
                        for (int i = 0; i < 8; ++i) {
                            const int tt = wave * 8 + i;
                            float x[8]; unpack8(*(const LAS u32x4*)(P + tt * 1024 + lane * 16), x);
                            float s1 = 0.f, s2 = 0.f;
#pragma unroll
                            for (int e = 0; e < 8; ++e) { s1 += x[e]; s2 += x[e] * x[e]; }
                            s1 = wave_sum(s1); s2 = wave_sum(s2);
                            const float mean = s1 * (1.f / 512), var = fmaxf(s2 * (1.f / 512) - mean * mean, 0.f), rstd = __builtin_amdgcn_rsqf(var + EPS);
#pragma unroll
                            for (int e = 0; e < 8; ++e) { const float y = (x[e] - mean) * rstd * gg[e] + bb[e]; x[e] = y * sigmoid_f(y); }
                            stg16(U + (size_t)(t0 + tt) * DM + 512 + 8 * lane, pack8(x));
                        }
                    }
                    __syncthreads();
                }
            }
            REP(14) { LANE_VARS
                const float* lng = args.in[11] + (size_t)l * 512; const float* lnb = args.in[12] + (size_t)l * 512;
                const float* bsp = args.in[14] + (size_t)l * 4 * 128;
                constexpr int VP = 136;
                LAS unsigned short* vvT = (LAS unsigned short*)lds;
                for (int unit = vcu; unit < MROWS / 128; unit += G) {
                    const int row0 = unit * 128;
                    {
                        float gg[8], bb[8];
#pragma unroll
                        for (int e = 0; e < 8; ++e) { gg[e] = lng[8 * lane + e]; bb[e] = lnb[8 * lane + e]; }
#pragma unroll 1
                        for (int i4 = 0; i4 < 16; i4 += 4) {
                            u32x4 rx4[4];
#pragma unroll
                            for (int q = 0; q < 4; ++q) rx4[q] = ldg16(Z + (size_t)(row0 + wave * 16 + i4 + q) * ZP + OFF_C + 512 + 8 * lane);
#pragma unroll
                            for (int q = 0; q < 4; ++q) {
                                const int t = wave * 16 + i4 + q;
                                float x[8]; unpack8(rx4[q], x);
                                float s1 = 0.f, s2 = 0.f;
#pragma unroll
                                for (int e = 0; e < 8; ++e) { s1 += x[e]; s2 += x[e] * x[e]; }
                                s1 = wave_sum(s1); s2 = wave_sum(s2);
                                const float mean = s1 * (1.f / 512), var = fmaxf(s2 * (1.f / 512) - mean * mean, 0.f), rstd = __builtin_amdgcn_rsqf(var + EPS);
#pragma unroll
                                for (int e = 0; e < 8; e += 2) {
                                    const unsigned pkd = pk2((x[e] - mean) * rstd * gg[e] + bb[e], (x[e + 1] - mean) * rstd * gg[e + 1] + bb[e + 1]);
                                    vvT[(8 * lane + e) * VP + t] = (unsigned short)(pkd & 0xffffu); vvT[(8 * lane + e + 1) * VP + t] = (unsigned short)(pkd >> 16);
                                }
                            }
                        }
                    }
                    __syncthreads();
                    {
                        const int grp = wave >> 1, th = wave & 1, l15 = lane & 15, l4 = lane >> 4;
                        bf16x8 bfr[4][4];
#pragma unroll
                        for (int tt = 0; tt < 4; ++tt)
#pragma unroll
                            for (int ks = 0; ks < 4; ++ks) bfr[tt][ks] = __builtin_bit_cast(bf16x8, ldg16(Wsb + (size_t)(grp * 128 + 64 * th + 16 * tt + l15) * 128 + 32 * ks + 8 * l4));
                        float bs4[4]; u32x2 un[4];
#pragma unroll
                        for (int tt = 0; tt < 4; ++tt) { const int t = 64 * th + 16 * tt + l15; bs4[tt] = bsp[grp * 128 + t]; un[tt] = *(const GAS u32x2*)(Z + (size_t)(row0 + t) * ZP + OFF_C + grp * 128 + 4 * l4); }
#pragma unroll
                        for (int ct = 0; ct < 8; ++ct) {
                            f32x4 acc4[4]; u32x2 uc[4];
#pragma unroll
                            for (int tt = 0; tt < 4; ++tt) { acc4[tt] = (f32x4){0.f, 0.f, 0.f, 0.f}; uc[tt] = un[tt]; }
                            if (ct < 7) {
#pragma unroll
                                for (int tt = 0; tt < 4; ++tt) { const int t = 64 * th + 16 * tt + l15; un[tt] = *(const GAS u32x2*)(Z + (size_t)(row0 + t) * ZP + OFF_C + grp * 128 + 16 * (ct + 1) + 4 * l4); } }
#pragma unroll
                            for (int ks = 0; ks < 4; ++ks) {
                                const bf16x8 a = *(const LAS bf16x8*)((const LAS unsigned char*)vvT + ((grp * 128 + 16 * ct + l15) * VP + 32 * ks + 8 * l4) * 2);
#pragma unroll
                                for (int tt = 0; tt < 4; ++tt) acc4[tt] = __builtin_amdgcn_mfma_f32_16x16x32_bf16(a, bfr[tt][ks], acc4[tt], 0, 0, 0);
                            }
                            const int c0 = grp * 128 + 16 * ct + 4 * l4;
#pragma unroll
                            for (int tt = 0; tt < 4; ++tt) {
                                const int t = 64 * th + 16 * tt + l15; const float bs = bs4[tt]; const u32x2 uw = uc[tt];
                                u32x2 ow; ow.x = pk2(bflo(uw.x) * (acc4[tt][0] + bs), bfhi(uw.x) * (acc4[tt][1] + bs)); ow.y = pk2(bflo(uw.y) * (acc4[tt][2] + bs), bfhi(uw.y) * (acc4[tt][3] + bs));
                                *(GAS u32x2*)(U + (size_t)(row0 + t) * DM + 1024 + c0) = ow;
                            }
                        }
                    }
                    __syncthreads();
                }
            }
        }
        xcd_barrier(bar);
        if (PH_MASK & (1 << 3)) REP(3) { PHASE_VARS
            LAS float* km = (LAS float*)lds;
            LAS unsigned* hist = (LAS unsigned*)(lds + 16384);
            unsigned* cntl = ctl + CW_CNT + l * 512 + (rep ? 2048 : 0);
            for (int unit0 = vcu, uk = 0; unit0 < BATCH * NH * 32; unit0 += G, ++uk) {
                const int unit = (uk & 1) ? (unit0 ^ 31) : unit0;
                const int i = unit & 31, h = (unit >> 5) & 3, b = unit >> 7;
                if (i == 0) continue;
                for (int e = tid; e < i * 128; e += 512) { const int j = e >> 7, d = e & 127; km[e] = ksum[(size_t)(b * 64 + 2 * j) * 512 + h * HD + d] + ksum[(size_t)(b * 64 + 2 * j + 1) * 512 + h * HD + d]; }
                if (tid < 96) hist[tid] = 0u;
                __syncthreads();
                const int ql = tid >> 1, half = tid & 1;
                const bf16_t* qp = Z + (size_t)(b * SEQ + i * 256 + ql) * ZP + OFF_D + h * HD + half * 64;
                float qv[64];
#pragma unroll
                for (int s = 0; s < 8; ++s) { float t8[8]; unpack8(ldg16(qp + 8 * s), t8);
#pragma unroll
                    for (int e = 0; e < 8; ++e) qv[8 * s + e] = t8[e]; }
                float v0 = -3.0e38f, v1 = -3.0e38f, v2 = -3.0e38f; int i0 = 0, i1 = 0, i2 = 0;
                for (int j = 0; j < i; ++j) {
                    const LAS f32x4* kp = (const LAS f32x4*)(km + j * 128 + half * 64);
                    float dot = 0.f;
#pragma unroll
                    for (int s = 0; s < 16; ++s) { const f32x4 kk = kp[s]; dot += qv[4 * s] * kk.x + qv[4 * s + 1] * kk.y + qv[4 * s + 2] * kk.z + qv[4 * s + 3] * kk.w; }
                    dot += __shfl_xor(dot, 1);
                    const bool g0 = dot > v0, g1 = dot > v1, g2 = dot > v2;
                    v2 = g1 ? v1 : (g2 ? dot : v2); i2 = g1 ? i1 : (g2 ? j : i2);
                    v1 = g0 ? v0 : (g1 ? dot : v1); i1 = g0 ? i0 : (g1 ? j : i1);
                    v0 = g0 ? dot : v0; i0 = g0 ? j : i0;
                }
                const int nsel = i < 3 ? i : 3;
                if (half == 0) { lds_add(&hist[i0], 1u); if (nsel > 1) lds_add(&hist[i1], 1u); if (nsel > 2) lds_add(&hist[i2], 1u); }
                __syncthreads();
                if (tid < 32) { const unsigned n = hist[tid]; if (n) hist[32 + tid] = __hip_atomic_fetch_add(cntl + (b * NH + h) * 32 + tid, n, __ATOMIC_RELAXED, __HIP_MEMORY_SCOPE_AGENT); }
                __syncthreads();
                if (half == 0) {
                    unsigned short* lb = (rep ? (unsigned short*)oslot : lists) + (size_t)((b * NH + h) * 32) * 8192;
                    const unsigned tq = (unsigned)(i * 256 + ql);
                    { const unsigned pos = hist[32 + i0] + lds_add(&hist[64 + i0], 1u); lb[(size_t)i0 * 8192 + pos] = (unsigned short)(tq); }
                    if (nsel > 1) { const unsigned pos = hist[32 + i1] + lds_add(&hist[64 + i1], 1u); lb[(size_t)i1 * 8192 + pos] = (unsigned short)(tq | (1u << 13)); }
                    if (nsel > 2) { const unsigned pos = hist[32 + i2] + lds_add(&hist[64 + i2], 1u); lb[(size_t)i2 * 8192 + pos] = (unsigned short)(tq | (2u << 13)); }
                }
                __syncthreads();
            }
        }
        xcd_barrier(bar);
        LAS unsigned char* ldsK = lds; LAS unsigned char* ldsV = lds + 65536; LAS float* tab = (LAS float*)(lds + 131072);
        LAS float* M2s = (LAS float*)(lds + 131072 + TABP * 4);
        LAS int* pre = (LAS int*)(lds + 131072 + TABP * 4 + 64);
        { LANE_VARS if (wave == 0) {
            const float* gqp = args.in[16] + (size_t)l * HD; const float* gkp = args.in[17] + (size_t)l * HD;
            const float gqm = wave_max(fmaxf(fabsf(gqp[lane]), fabsf(gqp[64 + lane]))), gkm = wave_max(fmaxf(fabsf(gkp[lane]), fabsf(gkp[64 + lane])));
#pragma unroll
            for (int h = 0; h < NH; ++h) { const float bm = wave_max(lane < 32 ? fabsf(args.in[1][lane * NH + h]) : 0.f); if (lane == 0) M2s[h] = (128.f * gqm * gkm * 0.08838834764831845f + bm) * LOG2E; }
        } }
        __syncthreads();
        if (PH_MASK & (1 << 4)) REP(4) { PHASE_VARS
            const unsigned* cntl = ctl + CW_CNT + l * 512;
            {
                const int c = (int)__hip_atomic_load(cntl + tid, __ATOMIC_RELAXED, __HIP_MEMORY_SCOPE_AGENT);
                const int nch = (c + 255) >> 8;
                int incl = nch;
#pragma unroll
                for (int o = 1; o < 64; o <<= 1) { const int t = __shfl_up(incl, o); if (lane >= o) incl += t; }
                LAS int* wtot = (LAS int*)(lds + 131072 + TABP * 4 + 32);
                if (lane == 63) wtot[wave] = incl;
                __syncthreads();
                int wbase = 0;
#pragma unroll
                for (int w = 0; w < 8; ++w) wbase += (w < wave) ? wtot[w] : 0;
                pre[tid] = wbase + incl - nch;
                if (tid == 511) pre[512] = wbase + incl;
                __syncthreads();
            }
            const int NI = pre[512];
            const int it0 = (int)(((long)vcu * NI) / G), it1 = (int)(((long)(vcu + 1) * NI) / G);
            int cur = -1;
            for (int it = it0; it < it1; ++it) {
                int lo = 0, hi2 = 511;
                while (lo < hi2) { const int mid = (lo + hi2 + 1) >> 1; if (pre[mid] <= it) lo = mid; else hi2 = mid - 1; }
                const int bhj = lo, chunk = it - pre[bhj];
                const int j = bhj & 31, h = (bhj >> 5) & 3, b = bhj >> 7;
                if (bhj != cur) { __syncthreads(); load_kv(Z, tabg, ldsK, ldsV, tab, M2s[h], b, h, j, tid); cur = bhj; __syncthreads(); }
                const int cnt = (int)__hip_atomic_load(cntl + bhj, __ATOMIC_RELAXED, __HIP_MEMORY_SCOPE_AGENT);
                const int e = chunk * 256 + wave * 32 + (lane & 31);
                const bool valid = e < cnt;
                const unsigned ent = lists[(size_t)bhj * 8192 + (valid ? e : chunk * 256)];
                const int tq = ent & 8191, rsel = ent >> 13;
                const size_t row = (size_t)b * SEQ + tq;
                bf16x8 qf[8];
                { const bf16_t* qp = Z + row * ZP + OFF_D + h * HD + 8 * (lane >> 5);
#pragma unroll
                  for (int s = 0; s < 8; ++s) qf[s] = __builtin_bit_cast(bf16x8, ldg16(qp + 16 * s)); }
                f32x16 o[4];
#pragma unroll
                for (int c = 0; c < 4; ++c)
#pragma unroll
                    for (int r = 0; r < 16; ++r) o[c][r] = 0.f;
                float lsum = 0.f;
                attn_core<false>(ldsK, ldsV, tab, qf, tq - j * 256, 4, lane, o, lsum);
                lsum += __shfl_xor(lsum, 32);
                store_o_bf16(valid ? (bf16_t*)oslot + ((size_t)rsel * MROWS + row) * 512 + h * HD : (bf16_t*)oslot + (size_t)3 * MROWS * 512 + (size_t)(tid & 63) * 128, o, 1.0f, lane >> 5);
                if (valid && lane < 32) lslot[((size_t)rsel * MROWS + row) * 4 + h] = lsum;
            }
        }
        xcd_barrier(bar);
        if (PH_MASK & (1 << 5)) REP(5) { PHASE_VARS
            for (int unit = vcu; unit < BATCH * NH * 32; unit += G) {
                const int i = unit & 31, h = (unit >> 5) & 3, b = unit >> 7;
                __syncthreads(); load_kv(Z, tabg, ldsK, ldsV, tab, M2s[h], b, h, i, tid); __syncthreads();
                const int ql = wave * 32 + (lane & 31);
                const size_t row = (size_t)b * SEQ + i * 256 + ql;
                bf16x8 qf[8];
                { const bf16_t* qp = Z + row * ZP + OFF_D + h * HD + 8 * (lane >> 5);
#pragma unroll
                  for (int s = 0; s < 8; ++s) qf[s] = __builtin_bit_cast(bf16x8, ldg16(qp + 16 * s)); }
                f32x16 o[4];
#pragma unroll
                for (int c = 0; c < 4; ++c)
#pragma unroll
                    for (int r = 0; r < 16; ++r) o[c][r] = 0.f;
                float lsum = 0.f;
                attn_core<true>(ldsK, ldsV, tab, qf, ql, (wave >> 1) + 1, lane, o, lsum);
                lsum += __shfl_xor(lsum, 32);
                const int nsel = i < 3 ? i : 3;
                for (int r = 0; r < nsel; ++r) {
                    lsum += lslot[((size_t)r * MROWS + row) * 4 + h];
                    load_add_o_bf16((const bf16_t*)oslot + ((size_t)r * MROWS + row) * 512 + h * HD, o, lane >> 5);
                }
                const float inv = 1.0f / lsum;
                store_o_bf16(U + row * DM + 1536 + h * HD, o, inv, lane >> 5);
            }
            __syncthreads();
        }
        if (PH_MASK & (1 << 1)) REP(1) { PHASE_VARS
            pg8::Gemm g{h8, Wg8, DM, DM, DM, 0, 0}; pg8::StaticOrder<0> S; S.init(MROWS, ZP - OFF_G, G, bx);
            pg8::EpiGate8 E{(unsigned char*)Z + OFF_G * 2, part, 1.0f / 64.0f};
            pg8::gemm_phase<pg8::EpiGate8, pg8::StaticOrder<0>, true>(lds, g, S, E, tid);
        }
        xcd_barrier(bar);
        if (PH_MASK & (1 << 6)) REP(6) { PHASE_VARS
            pg8::Gemm g{U, Wt_out, DM * 2, 512 * 2, 512 * 2, (size_t)512 * 2, (size_t)DM * 512 * 2}; pg8::StaticOrder<2> S; S.init(MROWS, DM, G, bx);
            pg8::EpiMerge E{(const unsigned char*)Z + OFF_G * 2, actA};
            pg8::gemm_phase<pg8::EpiMerge, pg8::StaticOrder<2>>(lds, g, S, E, tid);
        }
        xcd_barrier(bar);
        if (PH_MASK & (1 << 7)) REP(7) { PHASE_VARS const bool dry = ((DUP_MASK >> 7) & 1) && rep == 0;
            pg8::Gemm g{actA, Wt_o, DM * 2, DM * 2, DM * 2, 0, 0}; pg8::StaticOrder<0> S; S.init(MROWS, DM, G, bx);
            pg8::EpiResidB E{xb, dry ? (bf16_t*)oslot : xb, nullptr, dry ? lslot : part, nullptr, (LAS float*)(lds + 131072)};
            pg8::gemm_phase<pg8::EpiResidB, pg8::StaticOrder<0>>(lds, g, S, E, tid);
        }
        xcd_barrier(bar);
        if (PH_MASK & (1 << 9)) REP(9) { PHASE_VARS
            pg8::Gemm g{xb, Wt_mi, DM * 2, DM * 2, DM * 2, 0, 0}; pg8::StaticOrder<0> S; S.init(MROWS, DFF, G, bx);
            pg8::EpiRelu2 E{Z, DFF, part};
            pg8::gemm_phase<pg8::EpiRelu2, pg8::StaticOrder<0>>(lds, g, S, E, tid);
        }
        xcd_barrier(bar);
        if (PH_MASK & (1 << 10)) REP(10) { PHASE_VARS const bool dry = ((DUP_MASK >> 10) & 1) && rep == 0;
            pg8::Gemm g{Z, Wt_mo, DFF * 2, DFF * 2, DFF * 2, 0, 0}; pg8::StaticOrder<0> S; S.init(MROWS, DM, G, bx);
            pg8::EpiResidB E{xb, dry ? (bf16_t*)oslot : xb, dry ? (unsigned char*)oslot + 128 * MiB : h8, dry ? lslot : part, (l == DEPTH - 1 && !dry) ? xout : nullptr, (LAS float*)(lds + 131072)};
            pg8::gemm_phase<pg8::EpiResidB, pg8::StaticOrder<0>>(lds, g, S, E, tid);
        }
        xcd_barrier(bar);
    }
}

extern "C" void kernel_launch(void* const* d_in, const int* in_sizes, int n_in, void* d_out, int out_size, void* d_ws, size_t ws_size, hipStream_t stream) {
    static int grid = 0;
    if (grid == 0) {
        if (n_in != 23 || in_sizes[0] != MROWS * DM || out_size != MROWS * DM || ws_size < WS_END) {
            fprintf(stderr, "kernel_launch: unexpected shapes (n_in %d, in0 %d, out %d, ws %zu < %zu); nothing launched\n", n_in, n_in > 0 ? in_sizes[0] : -1, out_size, ws_size, (size_t)WS_END); grid = -1; return; }
        int dev = 0, cus = 0, per_cu = 0;
        if (hipGetDevice(&dev) != hipSuccess || hipDeviceGetAttribute(&cus, hipDeviceAttributeMultiprocessorCount, dev) != hipSuccess) { grid = -1; return; }
        if (hipFuncSetAttribute((const void*)fwd, hipFuncAttributeMaxDynamicSharedMemorySize, LDS_BYTES) != hipSuccess) { fprintf(stderr, "kernel_launch: hipFuncSetAttribute failed\n"); grid = -1; return; }
        if (hipOccupancyMaxActiveBlocksPerMultiprocessor(&per_cu, (const void*)fwd, 512, LDS_BYTES) != hipSuccess || per_cu < 1)
            fprintf(stderr, "kernel_launch: note: occupancy query reports %d workgroups per CU\n", per_cu);
        (void)hipGetLastError();
        grid = cus;
    }
    if (grid < 0) return;
    if (hipMemsetAsync((char*)d_ws + WS_CTL, 0, CTL_ZERO_BYTES, stream) != hipSuccess) { fprintf(stderr, "kernel_launch: memset failed\n"); return; }
    Args a{};
    for (int i = 0; i < 23; ++i) a.in[i] = (const float*)d_in[i];
    a.out = (float*)d_out; a.ws = (unsigned char*)d_ws;
    hipLaunchKernelGGL(fwd, dim3(grid), dim3(512), LDS_BYTES, stream, a);
}
```

```cpp
#include <hip/hip_runtime.h>
#include <cstdio>
#include <cstdint>

#define LAS __attribute__((address_space(3)))
#define GAS __attribute__((address_space(1)))
typedef unsigned short bf16_t;
typedef short bf16x8 __attribute__((ext_vector_type(8)));
typedef short s16x4 __attribute__((ext_vector_type(4)));
typedef float f32x4 __attribute__((ext_vector_type(4)));
typedef float f32x16 __attribute__((ext_vector_type(16)));
typedef unsigned u32x4 __attribute__((ext_vector_type(4)));
typedef unsigned u32x2 __attribute__((ext_vector_type(2)));

#ifndef PH_MASK
#define PH_MASK 0xFFFF
#endif
#ifndef DUP_MASK
#define DUP_MASK 0
#endif
#define REP(n) for (int rep = 0; rep <= ((DUP_MASK >> (n)) & 1); ++rep)
constexpr int DM = 2048, BATCH = 4, SEQ = 8192, DEPTH = 4, MROWS = BATCH * SEQ;
constexpr int OFF_A = 0, OFF_B = 1536, OFF_C = 2560, OFF_D = 3584, OFF_G = 5120, ZP = 13312;
constexpr int DFF = 8192, NH = 4, HD = 128;
constexpr float EPS = 1e-6f;
constexpr float LOG2E = 1.4426950408889634f;
constexpr float QSCALE = 0.08838834764831845f * 1.4426950408889634f;
constexpr int TABN = 1536;
constexpr int TABP = TABN + 128, TREV = TABN + 58;

__device__ __forceinline__ unsigned pk2(float lo, float hi) {
    typedef float f2_t __attribute__((ext_vector_type(2))); typedef __bf16 b2_t __attribute__((ext_vector_type(2)));
    f2_t v = {lo, hi}; b2_t b = __builtin_convertvector(v, b2_t); return __builtin_bit_cast(unsigned, b);
}
__device__ __forceinline__ float bflo(unsigned w) { return __uint_as_float(w << 16); }
__device__ __forceinline__ float bfhi(unsigned w) { return __uint_as_float(w & 0xffff0000u); }
__device__ __forceinline__ void unpack8(const u32x4 w, float (&f)[8]) {
    f[0] = bflo(w.x); f[1] = bfhi(w.x); f[2] = bflo(w.y); f[3] = bfhi(w.y); f[4] = bflo(w.z); f[5] = bfhi(w.z); f[6] = bflo(w.w); f[7] = bfhi(w.w);
}
__device__ __forceinline__ u32x4 pack8(const float (&f)[8]) { u32x4 w; w.x = pk2(f[0], f[1]); w.y = pk2(f[2], f[3]); w.z = pk2(f[4], f[5]); w.w = pk2(f[6], f[7]); return w; }
__device__ __forceinline__ float sigmoid_f(float x) { return __builtin_amdgcn_rcpf(1.0f + __builtin_amdgcn_exp2f(-x * LOG2E)); }
__device__ __forceinline__ float gelu_tanh_f(float x) {
    const float u2 = 1.5957691216057308f * (x + 0.044715f * x * x * x);
    return x * __builtin_amdgcn_rcpf(1.0f + __builtin_amdgcn_exp2f(-u2 * LOG2E));
}
__device__ __forceinline__ float wave_sum(float v) {
#pragma unroll
    for (int o = 1; o < 64; o <<= 1) v += __shfl_xor(v, o);
    return v;
}
__device__ __forceinline__ float wave_max(float v) {
#pragma unroll
    for (int o = 1; o < 64; o <<= 1) v = fmaxf(v, __shfl_xor(v, o));
    return v;
}
__device__ __forceinline__ unsigned lds_add(LAS unsigned* p, unsigned v) { return __hip_atomic_fetch_add(p, v, __ATOMIC_RELAXED, __HIP_MEMORY_SCOPE_WORKGROUP); }
__device__ __forceinline__ int opaque_tid() { int t = threadIdx.x; asm volatile("" : "+v"(t)); return t; }
__device__ __forceinline__ unsigned char* opaque_ptr(unsigned char* p) { asm volatile("" : "+s"(p)); return p; }
__device__ __forceinline__ u32x4 ldg16(const bf16_t* p) { return *(const GAS u32x4*)p; }
__device__ __forceinline__ void stg16(bf16_t* p, u32x4 v) { *(GAS u32x4*)p = v; }

namespace pg8 {
constexpr int BM = 256, BK = 64, HALF = 128, HTB = HALF * BK * 2, STAGE_BYTES = 8 * HTB, NXCD = 8, WGM = 4;
__host__ __device__ __forceinline__ int lds_byte(int r, int c) { const int st = (r >> 4) * 2 + (c >> 5), rr = r & 15, cc = c & 31, ob = rr * 64 + cc * 2; return st * 1024 + (ob ^ (((ob >> 9) & 1) << 5)); }
__host__ __device__ __forceinline__ void stage_rc(int b, int& R, int& C) { const int st = b / 1024, sb = b % 1024, swz = sb ^ (((sb >> 9) & 1) << 5); R = (st >> 1) * 16 + swz / 64; C = (st & 1) * 32 + (swz % 64) / 2; }
__host__ __device__ __forceinline__ int perm32(int rho) { const int n = rho >> 4, i = rho & 15; return 8 * (i >> 2) + 4 * n + (i & 3); }

typedef int v8i_t __attribute__((ext_vector_type(8)));
typedef v8i_t v8i_a16 __attribute__((aligned(16)));
__device__ __forceinline__ v8i_t cat8(const u32x4 a, const u32x4 b) { return (v8i_t){(int)a.x, (int)a.y, (int)a.z, (int)a.w, (int)b.x, (int)b.y, (int)b.z, (int)b.w}; }
struct Unit { int pm, pn, seg; };
struct Gemm { const void* A; const void* Bt; int lda_b, ldb_b, Kb; size_t a_seg, b_seg; };

template <int NSEG_LOG2> struct StaticOrder {
    int nM, nN, nwg, G, c;
    __device__ void init(int M, int N, int G_, int c_) { nM = M / BM; nN = N / BM; nwg = nM * nN; G = G_; c = c_; }
    __device__ bool next(int i, Unit& u) const {
        const int ti = i >> NSEG_LOG2;
        const long L = (long)ti * G + c; if (L >= nwg) return false;
        int wgid = (int)L; { const int q = nwg / NXCD, r = nwg % NXCD, xcd = wgid % NXCD, off = wgid / NXCD; wgid = (xcd < r ? xcd * (q + 1) : r * (q + 1) + (xcd - r) * q) + off; }
        const int nig = WGM * nN, gid = wgid / nig, fm = gid * WGM, gsz = (nM - fm) < WGM ? (nM - fm) : WGM;
        u.pm = fm + ((wgid % nig) % gsz); u.pn = (wgid % nig) / gsz; u.seg = i & ((1 << NSEG_LOG2) - 1); return true;
    }
};

typedef f32x4 Acc[2][2][4][2];
template <class V, int NDW> __device__ __forceinline__ void store_pair(void* pe, void* po, int odd, V w0, V w1) {
    V A, B;
#pragma unroll
    for (int d = 0; d < NDW; ++d) { const unsigned snd = odd ? w0[d] : w1[d]; const unsigned rcv = (unsigned)__builtin_amdgcn_mov_dpp((int)snd, 0xB1, 0xF, 0xF, true);
        A[d] = odd ? rcv : w0[d]; B[d] = odd ? w1[d] : rcv; }
    *(GAS V*)pe = A; *(GAS V*)po = B;
}
__device__ __forceinline__ void rows_rstd(const float* part, int row0, float scale, float (&rsv)[2][4]) {
    f32x4 pa[2][4], pb[2][4];
#pragma unroll
    for (int ai = 0; ai < 2; ++ai)
#pragma unroll
        for (int m = 0; m < 4; ++m) { const float* p = part + (size_t)(row0 + ai * HALF + m * 16) * 8; pa[ai][m] = *(const GAS f32x4*)p; pb[ai][m] = *(const GAS f32x4*)(p + 4); }
    asm volatile("" ::: "memory");
#pragma unroll
    for (int ai = 0; ai < 2; ++ai)
#pragma unroll
        for (int m = 0; m < 4; ++m) { const f32x4 a = pa[ai][m], b = pb[ai][m];
            rsv[ai][m] = __builtin_amdgcn_rsqf((((a.x + a.y) + (a.z + a.w)) + ((b.x + b.y) + (b.z + b.w))) * (1.0f / DM) + EPS) * scale; }
}

constexpr int RS_OFF0 = 135168, RS_OFF1 = 147456;
__device__ __forceinline__ void rows_rstd_lds(const LAS float* rs, int rl, float scale, float (&rsv)[2][4]) {
    f32x4 pa[2][4], pb[2][4];
#pragma unroll
    for (int ai = 0; ai < 2; ++ai)
#pragma unroll
        for (int m = 0; m < 4; ++m) { const LAS float* p = rs + (rl + ai * HALF + m * 16) * 8; pa[ai][m] = *(const LAS f32x4*)p; pb[ai][m] = *(const LAS f32x4*)(p + 4); }
    asm volatile("s_waitcnt lgkmcnt(0)" ::: "memory");
#pragma unroll
    for (int ai = 0; ai < 2; ++ai)
#pragma unroll
        for (int m = 0; m < 4; ++m) { const f32x4 a = pa[ai][m], b = pb[ai][m];
            rsv[ai][m] = __builtin_amdgcn_rsqf((((a.x + a.y) + (a.z + a.w)) + ((b.x + b.y) + (b.z + b.w))) * (1.0f / DM) + EPS) * scale; }
}
struct EpiZ {
    static constexpr bool PERM = true;
    static constexpr bool NEEDS_RS = true;
    bf16_t* O; const float* part; int col_base; int gates; float pre;
    __device__ __forceinline__ bool keep(const Unit&) const { return false; }
    __device__ __forceinline__ void operator()(Acc& acc, const Unit& u, int wr, int wc, int fr, int fq, const LAS float* rs) const {
        const int row0 = u.pm * BM + wr * 64 + fr, col0 = col_base + u.pn * BM + wc * 64 + 8 * fq;
        const int pn = u.pn;
        const int act = gates ? 1 : ((pn == 8 || pn == 9) ? 1 : ((pn >= 10 && pn < 14) ? 2 : 0));
        float rsv[2][4]; rows_rstd_lds(rs, wr * 64 + fr, pre, rsv);
#pragma unroll
        for (int ai = 0; ai < 2; ++ai)
#pragma unroll
            for (int m = 0; m < 4; ++m) { const int row = row0 + ai * HALF + m * 16; const int odd = fr & 1; bf16_t* rowp = O + (size_t)(row - odd) * ZP + col0 + 32 * odd;
                const float rs = rsv[ai][m]; const float nl2 = -LOG2E * rs; u32x4 wv[2];
#pragma unroll
                for (int bj = 0; bj < 2; ++bj) { f32x4 v0 = acc[ai][bj][m][0], v1 = acc[ai][bj][m][1];
                    if (act == 1) {
#pragma unroll
                        for (int j = 0; j < 4; ++j) { v0[j] = __builtin_amdgcn_rcpf(1.0f + __builtin_amdgcn_exp2f(v0[j] * nl2)); v1[j] = __builtin_amdgcn_rcpf(1.0f + __builtin_amdgcn_exp2f(v1[j] * nl2)); } }
                    else if (act == 2) {
#pragma unroll
                        for (int j = 0; j < 4; ++j) { v0[j] = gelu_tanh_f(v0[j] * rs); v1[j] = gelu_tanh_f(v1[j] * rs); } }
                    else { v0 *= rs; v1 *= rs; }
                    u32x4 w; w.x = pk2(v0[0], v0[1]); w.y = pk2(v0[2], v0[3]); w.z = pk2(v1[0], v1[1]); w.w = pk2(v1[2], v1[3]); wv[bj] = w; }
                store_pair<u32x4, 4>(rowp, rowp + ZP, odd, wv[0], wv[1]); }
    }
};
struct EpiGate8 {
    static constexpr bool PERM = true;
    static constexpr bool NEEDS_RS = true;
    unsigned char* G8; const float* part; float pre;
    __device__ __forceinline__ bool keep(const Unit&) const { return false; }
    __device__ __forceinline__ void operator()(Acc& acc, const Unit& u, int wr, int wc, int fr, int fq, const LAS float* rs) const {
        const int row0 = u.pm * BM + wr * 64 + fr, col0 = u.pn * BM + wc * 64 + 8 * fq;
        float rsv[2][4]; rows_rstd_lds(rs, wr * 64 + fr, pre, rsv);
#pragma unroll
        for (int ai = 0; ai < 2; ++ai)
#pragma unroll
            for (int m = 0; m < 4; ++m) { const int row = row0 + ai * HALF + m * 16; const int odd = fr & 1; unsigned char* rowp = G8 + (size_t)(row - odd) * (ZP * 2) + col0 + 32 * odd;
                const float nl2 = -LOG2E * rsv[ai][m]; u32x2 wv[2]; float cl = -7.98868469f; asm volatile("" : "+v"(cl));
#pragma unroll
                for (int bj = 0; bj < 2; ++bj) { const f32x4 v0 = acc[ai][bj][m][0], v1 = acc[ai][bj][m][1]; u32x2 w = (u32x2){0u, 0u};
                    typedef float f32x2_t __attribute__((ext_vector_type(2))); const f32x2_t nn = {nl2, nl2}, cc = {cl, cl};
                    const f32x2_t ta = __builtin_elementwise_fma((f32x2_t){v0[0], v0[1]}, nn, cc), tb = __builtin_elementwise_fma((f32x2_t){v0[2], v0[3]}, nn, cc), tc = __builtin_elementwise_fma((f32x2_t){v1[0], v1[1]}, nn, cc), td = __builtin_elementwise_fma((f32x2_t){v1[2], v1[3]}, nn, cc);
                    const f32x4 t0 = {ta[0], ta[1], tb[0], tb[1]}, t1 = {tc[0], tc[1], td[0], td[1]}; f32x4 e0, e1;
#pragma unroll
                    for (int j = 0; j < 4; ++j) { e0[j] = __builtin_amdgcn_exp2f(t0[j]); e1[j] = __builtin_amdgcn_exp2f(t1[j]); }
                    e0 += 1.0f / 254.0f; e1 += 1.0f / 254.0f;
#pragma unroll
                    for (int j = 0; j < 4; ++j) {
                        w.x = __builtin_amdgcn_cvt_pk_u8_f32(__builtin_amdgcn_rcpf(e0[j]), j, w.x);
                        w.y = __builtin_amdgcn_cvt_pk_u8_f32(__builtin_amdgcn_rcpf(e1[j]), j, w.y); }
                    w.x += 0x01010101u; w.y += 0x01010101u;
                    wv[bj] = w; }
                store_pair<u32x2, 2>(rowp, rowp + ZP * 2, odd, wv[0], wv[1]); }
    }
};
struct EpiLin {
    static constexpr bool PERM = true;
    static constexpr bool NEEDS_RS = false;
    bf16_t* scratch;
    __device__ __forceinline__ bool keep(const Unit&) const { return false; }
    __device__ __forceinline__ void operator()(Acc& acc, const Unit& u, int wr, int wc, int fr, int fq, const LAS float* rs) const {
        bf16_t* base = scratch + (size_t)((u.pm * 52 + u.pn) & 1023) * 65536 + (size_t)((wr * 4 + wc) * 16) * 512 + (fr + 16 * fq) * 8;
#pragma unroll
        for (int ai = 0; ai < 2; ++ai)
#pragma unroll
            for (int m = 0; m < 4; ++m)
#pragma unroll
                for (int bj = 0; bj < 2; ++bj) { const f32x4 v0 = acc[ai][bj][m][0], v1 = acc[ai][bj][m][1];
                    u32x4 w; w.x = pk2(v0[0], v0[1]); w.y = pk2(v0[2], v0[3]); w.z = pk2(v1[0], v1[1]); w.w = pk2(v1[2], v1[3]);
                    *(GAS u32x4*)(base + ((ai * 4 + m) * 2 + bj) * 512) = w; }
    }
};
struct EpiNull {
    static constexpr bool PERM = true;
    static constexpr bool NEEDS_RS = false;
    __device__ __forceinline__ bool keep(const Unit&) const { return false; }
    __device__ __forceinline__ void operator()(Acc& acc, const Unit& u, int wr, int wc, int fr, int fq, const LAS float* rs) const {
#pragma unroll
        for (int ai = 0; ai < 2; ++ai)
#pragma unroll
            for (int bj = 0; bj < 2; ++bj)
#pragma unroll
                for (int m = 0; m < 4; ++m)
#pragma unroll
                    for (int n = 0; n < 2; ++n) asm volatile("" :: "v"(acc[ai][bj][m][n]));
    }
};
struct EpiRelu2 {
    static constexpr bool PERM = true;
    static constexpr bool NEEDS_RS = true;
    bf16_t* O; int ldc; const float* part;
    __device__ __forceinline__ bool keep(const Unit&) const { return false; }
    __device__ __forceinline__ void operator()(Acc& acc, const Unit& u, int wr, int wc, int fr, int fq, const LAS float* rs) const {
        const int row0 = u.pm * BM + wr * 64 + fr, col0 = u.pn * BM + wc * 64 + 8 * fq;
        float rsv[2][4]; rows_rstd_lds(rs, wr * 64 + fr, 1.0f, rsv);
#pragma unroll
        for (int ai = 0; ai < 2; ++ai)
#pragma unroll
            for (int m = 0; m < 4; ++m) { const int row = row0 + ai * HALF + m * 16; const int odd = fr & 1; bf16_t* rowp = O + (size_t)(row - odd) * ldc + col0 + 32 * odd; const float rs = rsv[ai][m]; u32x4 wv[2];
#pragma unroll
                for (int bj = 0; bj < 2; ++bj) { f32x4 v0 = acc[ai][bj][m][0], v1 = acc[ai][bj][m][1];
#pragma unroll
                    for (int j = 0; j < 4; ++j) { const float a = __builtin_amdgcn_fmed3f(v0[j], 0.f, 3.0e38f) * rs, b = __builtin_amdgcn_fmed3f(v1[j], 0.f, 3.0e38f) * rs; v0[j] = a * a; v1[j] = b * b; }
                    u32x4 w; w.x = pk2(v0[0], v0[1]); w.y = pk2(v0[2], v0[3]); w.z = pk2(v1[0], v1[1]); w.w = pk2(v1[2], v1[3]); wv[bj] = w; }
                store_pair<u32x4, 4>(rowp, rowp + ldc, odd, wv[0], wv[1]); }
    }
};
struct EpiResidB {
    static constexpr bool PERM = true;
    static constexpr bool NEEDS_RS = false;
    const bf16_t* xr; bf16_t* xb; unsigned char* x8; float* part; float* outf; LAS float* red;
    __device__ __forceinline__ bool keep(const Unit&) const { return false; }
    __device__ __forceinline__ void operator()(Acc& acc, const Unit& u, int wr, int wc, int fr, int fq, const LAS float* rs) const {
        const int row0 = u.pm * BM + wr * 64 + fr, col0 = u.pn * BM + wc * 64 + 8 * fq;
#pragma unroll
        for (int ai = 0; ai < 2; ++ai) {
            u32x4 rv[4][2];
#pragma unroll
            for (int m = 0; m < 4; ++m)
#pragma unroll
                for (int bj = 0; bj < 2; ++bj) rv[m][bj] = *(const GAS u32x4*)(xr + (size_t)(row0 + ai * HALF + m * 16) * DM + col0 + bj * 32);
#pragma unroll
            for (int m = 0; m < 4; ++m) { const int row = row0 + ai * HALF + m * 16; const int odd = fr & 1; const size_t off = (size_t)row * DM + col0, offp = (size_t)(row - odd) * DM + col0 + 32 * odd; float ss = 0.f;
                u32x4 wv[2]; u32x2 fv[2];
#pragma unroll
                for (int bj = 0; bj < 2; ++bj) {
                    float v[8]; unpack8(rv[m][bj], v);
#pragma unroll
                    for (int e = 0; e < 8; ++e) { v[e] += acc[ai][bj][m][e >> 2][e & 3]; ss += v[e] * v[e]; }
                    if (outf) { *(GAS f32x4*)(outf + off + bj * 32) = (f32x4){v[0], v[1], v[2], v[3]}; *(GAS f32x4*)(outf + off + bj * 32 + 4) = (f32x4){v[4], v[5], v[6], v[7]}; }
                    else { wv[bj] = pack8(v);
                        if (x8) { int t = __builtin_amdgcn_cvt_pk_fp8_f32(v[0], v[1], 0, false); t = __builtin_amdgcn_cvt_pk_fp8_f32(v[2], v[3], t, true); fv[bj].x = (unsigned)t;
                            t = __builtin_amdgcn_cvt_pk_fp8_f32(v[4], v[5], 0, false); t = __builtin_amdgcn_cvt_pk_fp8_f32(v[6], v[7], t, true); fv[bj].y = (unsigned)t; } }
                }
                if (!outf) { store_pair<u32x4, 4>(xb + offp, xb + offp + DM, odd, wv[0], wv[1]); if (x8) store_pair<u32x2, 2>(x8 + offp, x8 + offp + DM, odd, fv[0], fv[1]); }
                ss += __shfl_xor(ss, 16); ss += __shfl_xor(ss, 32);
                if (fq == 0) red[wc * 256 + ai * HALF + wr * 64 + m * 16 + fr] = ss;
            }
        }
        asm volatile("s_waitcnt lgkmcnt(0)" ::: "memory"); __builtin_amdgcn_s_barrier(); asm volatile("" ::: "memory");
        { const int t = (wr * 4 + wc) * 64 + fr + 16 * fq;
          if (t < 256 && !outf) part[(size_t)(u.pm * BM + t) * 8 + u.pn] = (red[t] + red[256 + t]) + (red[512 + t] + red[768 + t]); }
        asm volatile("s_waitcnt lgkmcnt(0)" ::: "memory"); __builtin_amdgcn_s_barrier(); asm volatile("" ::: "memory");
    }
};
struct EpiMerge {
    static constexpr bool PERM = true;
    static constexpr bool NEEDS_RS = false;
    const unsigned char* G;
    bf16_t* O;
    __device__ __forceinline__ bool keep(const Unit& u) const { return u.seg < 3; }
    __device__ __forceinline__ void operator()(Acc& acc, const Unit& u, int wr, int wc, int fr, int fq, const LAS float* rs) const {
        const int row0 = u.pm * BM + wr * 64 + fr, col0 = u.pn * BM + wc * 64 + 8 * fq;
        const int seg = u.seg;
        const unsigned char* gp0 = G + (size_t)row0 * (ZP * 2) + seg * DM + col0;
        u32x2 ga[4][2][2], gb[4][2][2];
#define MG_LOAD(buf, q, TWO) do { _Pragma("unroll") for (int mm = 0; mm < 2; ++mm) _Pragma("unroll") for (int bj = 0; bj < 2; ++bj) { \
            const unsigned char* p_ = gp0 + (size_t)(((q) >> 1) * HALF + (((q) & 1) * 2 + mm) * 16) * (ZP * 2) + bj * 32; \
            ga[buf][mm][bj] = *(const GAS u32x2*)p_; if (TWO) gb[buf][mm][bj] = *(const GAS u32x2*)(p_ + DM); } } while (0)
#define MG_U8(w, e) ((float)((((e) < 4 ? (w).x : (w).y) >> (8 * ((e) & 3))) & 0xffu))
#define MG_SCALE(buf, q) do { _Pragma("unroll") for (int mm = 0; mm < 2; ++mm) _Pragma("unroll") for (int bj = 0; bj < 2; ++bj) { \
            const int ai_ = (q) >> 1, m_ = ((q) & 1) * 2 + mm; const u32x2 a_ = ga[buf][mm][bj], b_ = gb[buf][mm][bj]; \
            _Pragma("unroll") for (int e = 0; e < 8; ++e) acc[ai_][bj][m_][e >> 2][e & 3] *= MG_U8(a_, e) * __builtin_amdgcn_rcpf(MG_U8(b_, e)); } } while (0)
#define MG_STORE(buf, q) do { _Pragma("unroll") for (int mm = 0; mm < 2; ++mm) _Pragma("unroll") for (int bj = 0; bj < 2; ++bj) { \
            const int ai_ = (q) >> 1, m_ = ((q) & 1) * 2 + mm; const u32x2 a_ = ga[buf][mm][bj]; float v_[8]; \
            _Pragma("unroll") for (int e = 0; e < 8; ++e) v_[e] = acc[ai_][bj][m_][e >> 2][e & 3] * (MG_U8(a_, e) * (1.0f / 255.0f)); \
            *(GAS u32x4*)(O + (size_t)(row0 + ai_ * HALF + m_ * 16) * DM + col0 + bj * 32) = pack8(v_); } } while (0)
        if (seg < 3) {
            MG_LOAD(0, 0, true); MG_LOAD(1, 1, true); MG_LOAD(2, 2, true); MG_LOAD(3, 3, true); asm volatile("" ::: "memory");
            MG_SCALE(0, 0); MG_SCALE(1, 1); MG_SCALE(2, 2); MG_SCALE(3, 3);
        } else {
            MG_LOAD(0, 0, false); MG_LOAD(1, 1, false); MG_LOAD(2, 2, false); MG_LOAD(3, 3, false); asm volatile("" ::: "memory");
            MG_STORE(0, 0); MG_STORE(1, 1); MG_STORE(2, 2); MG_STORE(3, 3);
        }
#undef MG_SCALE
#undef MG_STORE
#undef MG_U8
#undef MG_LOAD
    }
};

template <class Epi, class Sched, bool FP8 = false>
__device__ __forceinline__ void gemm_phase(LAS unsigned char* lds, const Gemm g, const Sched& S, const Epi& E, const int tid) {
    const int wid = __builtin_amdgcn_readfirstlane(tid >> 6), lane = tid & 63, wr = wid >> 2, wc = wid & 3, fr = lane & 15, fq = lane >> 4;
    const int nt = g.Kb / 128;
    unsigned voffA[2], voffB[2];
#pragma unroll
    for (int i = 0; i < 2; ++i) { int R, C; stage_rc(tid * 16 + i * 8192, R, C); const int Rb = 64 * (R >> 5) + perm32(R & 31);
        voffA[i] = (unsigned)(R * g.lda_b + C * 2); voffB[i] = (unsigned)(Rb * g.ldb_b + C * 2); }
    const size_t kstep = (size_t)(BK * 2);
    const size_t hstepA = (size_t)HALF * g.lda_b, hstepB = (size_t)32 * g.ldb_b, tstepB = (size_t)BM * g.ldb_b;
    const unsigned ldsw = (unsigned)wid * 1024u;
    const int aoff = lds_byte(wr * 64 + fr, fq * 8), boff = lds_byte(wc * 32 + fr, fq * 8);
#define PG8_APTR(u) ((const char*)g.A + (size_t)(u).pm * 2 * hstepA + (size_t)(u).seg * g.a_seg)
#define PG8_BPTR(u) ((const char*)g.Bt + (size_t)(u).pn * tstepB + (size_t)(u).seg * g.b_seg)
#define PG8_SA(b, h) (((b) * 2 + (h)) * HTB)
#define PG8_SB(b, h) ((4 + (b) * 2 + (h)) * HTB)
#define PG8_STAGE(bufoff, gbase, voff) do { _Pragma("unroll") for (int _i = 0; _i < 2; ++_i) \
        __builtin_amdgcn_global_load_lds((const unsigned*)((const char*)(gbase) + (voff)[_i]), (LAS unsigned*)(lds + (bufoff) + ldsw + _i * 8192), 16, 0, 0); } while (0)
#define PG8_LDA(dst, b, h) do { _Pragma("unroll") for (int m = 0; m < 4; ++m) { \
        if constexpr (FP8) dst##8[m] = cat8(*(const LAS u32x4*)(lds + PG8_SA(b, h) + aoff + m * 2048), *(const LAS u32x4*)(lds + PG8_SA(b, h) + aoff + m * 2048 + 1024)); \
        else { _Pragma("unroll") for (int k = 0; k < 2; ++k) dst[m][k] = *(const LAS bf16x8*)(lds + PG8_SA(b, h) + aoff + m * 2048 + k * 1024); } } } while (0)
#define PG8_LDB(dst, b, h) do { _Pragma("unroll") for (int n = 0; n < 2; ++n) { \
        if constexpr (FP8) dst##8[n] = cat8(*(const LAS u32x4*)(lds + PG8_SB(b, h) + boff + n * 2048), *(const LAS u32x4*)(lds + PG8_SB(b, h) + boff + n * 2048 + 1024)); \
        else { _Pragma("unroll") for (int k = 0; k < 2; ++k) dst[n][k] = *(const LAS bf16x8*)(lds + PG8_SB(b, h) + boff + n * 2048 + k * 1024); } } } while (0)
#define PG8_MMA(ai, bj, At, Bt) do { __builtin_amdgcn_s_setprio(1); \
        if constexpr (FP8) { _Pragma("unroll") for (int m = 0; m < 4; ++m) _Pragma("unroll") for (int n = 0; n < 2; ++n) \
            asm volatile("v_mfma_f32_16x16x128_f8f6f4 %0, %1, %2, %0" : "+v"(acc[ai][bj][m][n]) : "v"(Bt##8[n]), "v"(At##8[m])); } \
        else { _Pragma("unroll") for (int m = 0; m < 4; ++m) _Pragma("unroll") for (int n = 0; n < 2; ++n) _Pragma("unroll") for (int k = 0; k < 2; ++k) \
            acc[ai][bj][m][n] = __builtin_amdgcn_mfma_f32_16x16x32_bf16(Bt[n][k], At[m][k], acc[ai][bj][m][n], 0, 0, 0); } \
        __builtin_amdgcn_s_setprio(0); } while (0)
#define PG8_WAIT_V(n) asm volatile("s_waitcnt vmcnt(" #n ")" ::: "memory")
#define PG8_WAIT_L(n) asm volatile("s_waitcnt lgkmcnt(" #n ")" ::: "memory")
#define PG8_BAR __builtin_amdgcn_s_barrier()
#define PG8_SCHED __builtin_amdgcn_sched_barrier(0)
    Unit cur, nxt; int ui = 0;
    if (!S.next(0, cur)) return;
    Acc acc;
#pragma unroll
    for (int a = 0; a < 2; ++a)
#pragma unroll
        for (int b = 0; b < 2; ++b)
#pragma unroll
            for (int m = 0; m < 4; ++m)
#pragma unroll
                for (int n = 0; n < 2; ++n) acc[a][b][m][n] = (f32x4){0.f, 0.f, 0.f, 0.f};
    bf16x8 At[4][2], B0[2][2], B1[2][2]; v8i_t At8[4], B08[2], B18[2];
    const char* cA = PG8_APTR(cur); const char* cB = PG8_BPTR(cur);
#define PG8_RS(par, pm_) do { if constexpr (Epi::NEEDS_RS) __builtin_amdgcn_global_load_lds((const unsigned*)(E.part + (size_t)(pm_) * BM * 8 + wid * 256 + lane * 4), \
        (LAS unsigned*)(lds + ((par) ? RS_OFF1 : RS_OFF0) + ldsw), 16, 0, 0); } while (0)
    PG8_RS(0, cur.pm);
    PG8_STAGE(PG8_SB(0, 0), cB, voffB); PG8_STAGE(PG8_SB(0, 1), cB + hstepB, voffB); PG8_STAGE(PG8_SA(0, 0), cA, voffA); PG8_STAGE(PG8_SA(0, 1), cA + hstepA, voffA);
    if (wr == 1) PG8_BAR;
    PG8_WAIT_V(2); PG8_BAR;
    PG8_STAGE(PG8_SB(1, 0), cB + kstep, voffB); PG8_STAGE(PG8_SA(1, 0), cA + kstep, voffA); PG8_STAGE(PG8_SB(1, 1), cB + hstepB + kstep, voffB);
    PG8_WAIT_V(6); PG8_BAR;
    for (;;) {
        const bool has_next = S.next(ui + 1, nxt);
        const char* nA = has_next ? PG8_APTR(nxt) : cA; const char* nB = has_next ? PG8_BPTR(nxt) : cB;
        for (int t = 0; t < nt; t += 2) {
            const bool last = (t == nt - 2);
            const char* a1 = cA + (size_t)(t + 1) * kstep;
            const char* a2 = last ? nA : cA + (size_t)(t + 2) * kstep; const char* b2 = last ? nB : cB + (size_t)(t + 2) * kstep;
            const char* a3 = a2 + kstep; const char* b3 = b2 + kstep;
            PG8_LDB(B0, 0, 0); PG8_LDB(B1, 0, 1); PG8_SCHED; PG8_LDA(At, 0, 0); PG8_STAGE(PG8_SA(1, 1), a1 + hstepA, voffA);
            PG8_WAIT_V(8); PG8_WAIT_L(0); PG8_BAR; PG8_MMA(0, 0, At, B0); PG8_MMA(0, 1, At, B1); PG8_BAR; PG8_SCHED;
            PG8_LDA(At, 0, 1); PG8_STAGE(PG8_SB(0, 0), b2, voffB); PG8_STAGE(PG8_SB(0, 1), b2 + hstepB, voffB); PG8_STAGE(PG8_SA(0, 0), a2, voffA);
            PG8_WAIT_V(8); PG8_WAIT_L(0); PG8_BAR; PG8_MMA(1, 0, At, B0); PG8_MMA(1, 1, At, B1); PG8_BAR; PG8_SCHED;
            PG8_LDB(B0, 1, 0); PG8_LDB(B1, 1, 1); PG8_SCHED; PG8_LDA(At, 1, 0); PG8_STAGE(PG8_SA(0, 1), a2 + hstepA, voffA);
            PG8_WAIT_V(8); PG8_WAIT_L(0); PG8_BAR; PG8_MMA(0, 0, At, B0); PG8_MMA(0, 1, At, B1); PG8_BAR; PG8_SCHED;
            PG8_LDA(At, 1, 1); PG8_STAGE(PG8_SB(1, 0), b3, voffB); PG8_STAGE(PG8_SB(1, 1), b3 + hstepB, voffB); PG8_STAGE(PG8_SA(1, 0), a3, voffA);
            PG8_WAIT_V(8); PG8_WAIT_L(0); PG8_BAR; PG8_MMA(1, 0, At, B0); PG8_MMA(1, 1, At, B1); PG8_BAR; PG8_SCHED;
        }
        if (wr == 0) PG8_BAR;
        if (has_next) PG8_RS((ui + 1) & 1, nxt.pm);
        if constexpr (FP8) { asm volatile("s_nop 15\n\ts_nop 15" ::: "memory"); __builtin_amdgcn_sched_barrier(0); }
        E(acc, cur, wr, wc, fr, fq, (const LAS float*)(lds + ((ui & 1) ? RS_OFF1 : RS_OFF0)));
        if (!has_next) break;
        if (!E.keep(cur)) {
#pragma unroll
            for (int a = 0; a < 2; ++a)
#pragma unroll
                for (int b = 0; b < 2; ++b)
#pragma unroll
                    for (int m = 0; m < 4; ++m)
#pragma unroll
                        for (int n = 0; n < 2; ++n) acc[a][b][m][n] = (f32x4){0.f, 0.f, 0.f, 0.f};
        }
        cur = nxt; cA = nA; cB = nB; ++ui;
        if (wr == 1) PG8_BAR;
    }
    PG8_WAIT_V(0);
    PG8_BAR;
#undef PG8_APTR
#undef PG8_BPTR
#undef PG8_SA
#undef PG8_SB
#undef PG8_STAGE
#undef PG8_RS
#undef PG8_LDA
#undef PG8_LDB
#undef PG8_MMA
#undef PG8_WAIT_V
#undef PG8_WAIT_L
#undef PG8_BAR
#undef PG8_SCHED
}
}

constexpr size_t MiB = 1u << 20;
constexpr size_t WS_CTL = 0, CTL_ZERO_BYTES = 1 * MiB;
constexpr size_t WS_KSUM = 1 * MiB;
constexpr size_t WS_TAB = 1 * MiB + 512 * 1024;
constexpr size_t WS_WSB = 1 * MiB + 768 * 1024;
constexpr size_t WS_LIST = 2 * MiB;
constexpr size_t WS_LSLOT = 10 * MiB;
constexpr size_t WS_W = 16 * MiB;
constexpr size_t W_IN_OFF = 0, W_OUT_OFF = 52 * MiB, W_O_OFF = 60 * MiB, W_MI_OFF = 68 * MiB, W_MO_OFF = 100 * MiB;
constexpr size_t WS_ACTA = 148 * MiB;
constexpr size_t WS_U = 276 * MiB;
constexpr size_t WS_Z = 404 * MiB;
constexpr size_t WS_OSLOT = 1236 * MiB;
constexpr size_t WS_H8 = 1428 * MiB;
constexpr size_t WS_XB = 1492 * MiB;
constexpr size_t WS_END = 1620 * MiB;
constexpr size_t WS_PART = 12 * MiB;
constexpr size_t W_G8_OFF = 20 * MiB;
constexpr int CW_TMO = 0, CW_BAR = 4096, CW_CNT = 16384;

constexpr int MISC_OFF = 143360;
constexpr int LDS_BYTES = 155648;

#define XB_TMO      128
#define XB_XCNT(j)  (256  + 64 * (j))
#define XB_XSUB(j)  (1280 + 64 * (j))
#define XB_XGEN(j)  (2304 + 64 * (j))
#define XB_TOP      3328
#define XB_TOPGEN   3392
#define XCD_BAR_WORDS 3456
#define XB_SPIN_CAP (1u << 18)
__device__ __forceinline__ unsigned xb_ld(unsigned* p)              { return __hip_atomic_load(p, __ATOMIC_RELAXED, __HIP_MEMORY_SCOPE_AGENT); }
__device__ __forceinline__ unsigned xb_add(unsigned* p, unsigned v) { return __hip_atomic_fetch_add(p, v, __ATOMIC_RELAXED, __HIP_MEMORY_SCOPE_AGENT); }
__device__ __forceinline__ unsigned xb_xcc_id() { return (unsigned)__builtin_amdgcn_s_getreg((3 << 11) | 20) & 0xFu; }
#define XB_SPIN(cond, bar) do { unsigned _sp = 0; while (cond) { __builtin_amdgcn_s_sleep(1); \
    if ((++_sp & 255u) == 0u) { if (xb_ld(&(bar)[XB_TMO])) break; if (_sp > XB_SPIN_CAP) { atomicAdd(&(bar)[XB_TMO], 1u); break; } } } } while (0)
struct XcdBarrier { unsigned* bar; unsigned x; volatile LAS unsigned* st; };
__device__ __forceinline__ XcdBarrier xcd_barrier_post(unsigned* bar, volatile LAS unsigned* st) {
    XcdBarrier b; b.bar = bar; b.x = xb_xcc_id(); b.st = st;
    if (threadIdx.x == 0) (void)xb_add(&bar[XB_XCNT(b.x)], 1u);
    return b;
}
__device__ __forceinline__ void xcd_barrier_complete(unsigned* bar, unsigned x, unsigned& nloc, unsigned& nx) {
    const unsigned G = gridDim.x * gridDim.y * gridDim.z;
    unsigned sum, cnt, mine, sp = 0u;
    for (;;) {
        sum = 0u; cnt = 0u; mine = 0u;
#pragma unroll
        for (unsigned j = 0; j < 16; ++j) { const unsigned c = xb_ld(&bar[XB_XCNT(j)]); sum += c; cnt += (c > 0u) ? 1u : 0u; mine = (j == x) ? c : mine; }
        if (sum == G) break;
        __builtin_amdgcn_s_sleep(1);
        if ((++sp & 255u) == 0u) { if (xb_ld(&bar[XB_TMO])) break; if (sp > XB_SPIN_CAP) { atomicAdd(&bar[XB_TMO], 1u); break; } }
    }
    nloc = mine > 0u ? mine : 1u; nx = cnt > 0u ? cnt : 1u;
}
__device__ __forceinline__ void xcd_barrier(const XcdBarrier& b) {
    asm volatile("s_waitcnt vmcnt(0)" ::: "memory");
    __syncthreads();
    if (threadIdx.x == 0) {
        unsigned* bar = b.bar;
        __builtin_amdgcn_s_waitcnt(0);
        unsigned nloc = b.st[0], nx = b.st[1];
        if (nloc == 0u) { xcd_barrier_complete(bar, b.x, nloc, nx); b.st[0] = nloc; b.st[1] = nx; }
        const unsigned old = xb_add(&bar[XB_XSUB(b.x)], 1u);
        const unsigned gen = old / nloc;
        if (old + 1u == (gen + 1u) * nloc) {
            __builtin_amdgcn_fence(__ATOMIC_RELEASE, "agent");
            asm volatile("s_waitcnt vmcnt(0)" ::: "memory");
            const unsigned og = xb_add(&bar[XB_TOP], 1u);
            const unsigned tg = og / nx;
            if (og + 1u == (tg + 1u) * nx) xb_add(&bar[XB_TOPGEN], 1u);
            else XB_SPIN(xb_ld(&bar[XB_TOPGEN]) == tg, bar);
            __builtin_amdgcn_fence(__ATOMIC_ACQUIRE, "agent");
            xb_add(&bar[XB_XGEN(b.x)], 1u);
            asm volatile("s_waitcnt vmcnt(0)" ::: "memory");
        } else {
            XB_SPIN(xb_ld(&bar[XB_XGEN(b.x)]) == gen, bar);
            __builtin_amdgcn_fence(__ATOMIC_ACQUIRE, "agent");
            asm volatile("s_waitcnt vmcnt(0)" ::: "memory");
        }
    }
    __syncthreads();
}

struct Args { const float* in[23]; float* out; unsigned char* ws; };
#define LDS_WAIT() asm volatile("s_waitcnt lgkmcnt(0)" ::: "memory")

template <bool FP8>
__device__ __forceinline__ void transpose_item(const float* W, const float* gk, int K, int N, void* WTv, int n_first, LAS float* scr, int item, int lane) {
    const int nblk = N / 64, kb = item / nblk, nb = item % nblk, k0 = 64 * kb, n0 = 64 * nb;
    const int lr = lane >> 4, lc = lane & 15;
    f32x4 v[16];
#pragma unroll
    for (int i = 0; i < 16; ++i) v[i] = *(const GAS f32x4*)(W + (size_t)(k0 + 4 * i + lr) * N + n0 + 4 * lc);
#pragma unroll
    for (int i = 0; i < 16; ++i) { const int kk = 4 * i + lr; *(LAS f32x4*)(scr + kk * 68 + 4 * (lc ^ ((kk >> 3) & 7))) = v[i]; }
    LDS_WAIT(); asm volatile("" ::: "memory");
    if constexpr (!FP8) {
        bf16_t* WT = (bf16_t*)WTv; const int c = lane & 7;
        float g8[8];
#pragma unroll
        for (int e = 0; e < 8; ++e) g8[e] = gk ? gk[k0 + 8 * c + e] : 1.0f;
#pragma unroll
        for (int j = 0; j < 8; ++j) { const int n = (lane >> 3) + 8 * j; const LAS float* sp = scr + (8 * c) * 68 + 4 * ((n >> 2) ^ c) + (n & 3);
            u32x4 o; o.x = pk2(sp[0 * 68] * g8[0], sp[1 * 68] * g8[1]); o.y = pk2(sp[2 * 68] * g8[2], sp[3 * 68] * g8[3]); o.z = pk2(sp[4 * 68] * g8[4], sp[5 * 68] * g8[5]); o.w = pk2(sp[6 * 68] * g8[6], sp[7 * 68] * g8[7]);
            *(GAS u32x4*)(WT + (size_t)(n0 - n_first + n) * K + k0 + 8 * c) = o; }
    } else {
        unsigned char* W8 = (unsigned char*)WTv; const int c = lane & 3;
        float g16[16];
#pragma unroll
        for (int e = 0; e < 16; ++e) g16[e] = gk[k0 + 16 * c + e] * 64.f;
#pragma unroll
        for (int j = 0; j < 4; ++j) { const int n = (lane >> 2) + 16 * j; float t[16];
#pragma unroll
            for (int e = 0; e < 16; ++e) t[e] = scr[(16 * c + e) * 68 + 4 * ((n >> 2) ^ ((2 * c + (e >> 3)) & 7)) + (n & 3)] * g16[e];
            u32x4 o;
#pragma unroll
            for (int q = 0; q < 4; ++q) { int w = __builtin_amdgcn_cvt_pk_fp8_f32(t[4 * q], t[4 * q + 1], 0, false); w = __builtin_amdgcn_cvt_pk_fp8_f32(t[4 * q + 2], t[4 * q + 3], w, true); o[q] = (unsigned)w; }
            *(GAS u32x4*)(W8 + (size_t)(n0 - n_first + n) * K + k0 + 16 * c) = o; }
    }
    LDS_WAIT(); asm volatile("" ::: "memory");
}

__device__ __forceinline__ int rel_bucket(int n) {
    if (n < 16) return n;
    int b = 16;
    b += (n >= 22); b += (n >= 30); b += (n >= 40); b += (n >= 54); b += (n >= 73); b += (n >= 99); b += (n >= 134); b += (n >= 182);
    b += (n >= 246); b += (n >= 332); b += (n >= 450); b += (n >= 609); b += (n >= 825); b += (n >= 1117); b += (n >= 1513);
    return b;
}

__device__ __forceinline__ void x_rows_in(const float* x, bf16_t* xb, unsigned char* x8, float* part, int gw, int ngw, int lane) {
    for (int m = gw; m < MROWS; m += ngw) {
        const GAS f32x4* xr = (const GAS f32x4*)(x + (size_t)m * DM) + lane;
        f32x4 v[8]; float s = 0.f;
#pragma unroll
        for (int j = 0; j < 8; ++j) { v[j] = xr[64 * j]; s += (v[j].x * v[j].x + v[j].y * v[j].y) + (v[j].z * v[j].z + v[j].w * v[j].w); }
        s = wave_sum(s);
        GAS u32x2* o8 = (GAS u32x2*)(xb + (size_t)m * DM) + lane;
#pragma unroll
        for (int j = 0; j < 8; ++j) { u32x2 w; w.x = pk2(v[j].x, v[j].y); w.y = pk2(v[j].z, v[j].w); o8[64 * j] = w;
            int f = __builtin_amdgcn_cvt_pk_fp8_f32(v[j].x, v[j].y, 0, false); f = __builtin_amdgcn_cvt_pk_fp8_f32(v[j].z, v[j].w, f, true); *((GAS unsigned*)(x8 + (size_t)m * DM) + lane + 64 * j) = (unsigned)f; }
        if (lane < 8) part[(size_t)m * 8 + lane] = lane == 0 ? s : 0.f;
    }
}

__device__ __forceinline__ unsigned off_b(unsigned row, unsigned ch) { return 256u * row + 16u * (ch ^ (((row & 3) << 2) | ((row >> 2) & 3))); }
__device__ __forceinline__ s16x4 vtr(const LAS unsigned char* p) { typedef short v4i16_t __attribute__((ext_vector_type(4))); return __builtin_bit_cast(s16x4, __builtin_amdgcn_ds_read_tr16_b64_v4i16((LAS v4i16_t*)p)); }
__device__ __forceinline__ int crow(int r, int hi) { return (r & 3) + 8 * (r >> 2) + 4 * hi; }

__device__ __forceinline__ void store_o_bf16(bf16_t* p, const f32x16 (&o)[4], float scale, int hi) {
#pragma unroll
    for (int c = 0; c < 4; ++c)
#pragma unroll
        for (int kp = 0; kp < 2; ++kp) {
            unsigned ax = pk2(o[c][8 * kp] * scale, o[c][8 * kp + 1] * scale), ay = pk2(o[c][8 * kp + 2] * scale, o[c][8 * kp + 3] * scale);
            unsigned bx = pk2(o[c][8 * kp + 4] * scale, o[c][8 * kp + 5] * scale), by = pk2(o[c][8 * kp + 6] * scale, o[c][8 * kp + 7] * scale);
            auto r0 = __builtin_amdgcn_permlane32_swap(ax, bx, false, false); auto r1 = __builtin_amdgcn_permlane32_swap(ay, by, false, false);
            *(GAS u32x4*)(p + 32 * c + 16 * kp + 8 * hi) = (u32x4){r0[0], r1[0], r0[1], r1[1]};
        }
}
__device__ __forceinline__ void load_add_o_bf16(const bf16_t* p, f32x16 (&o)[4], int hi) {
    u32x4 L[4][2];
#pragma unroll
    for (int c = 0; c < 4; ++c)
#pragma unroll
        for (int kp = 0; kp < 2; ++kp) L[c][kp] = *(const GAS u32x4*)(p + 32 * c + 16 * kp + 8 * hi);
#pragma unroll
    for (int c = 0; c < 4; ++c)
#pragma unroll
        for (int kp = 0; kp < 2; ++kp) {
            auto r0 = __builtin_amdgcn_permlane32_swap(L[c][kp].x, L[c][kp].z, false, false); auto r1 = __builtin_amdgcn_permlane32_swap(L[c][kp].y, L[c][kp].w, false, false);
            o[c][8 * kp] += bflo(r0[0]); o[c][8 * kp + 1] += bfhi(r0[0]); o[c][8 * kp + 2] += bflo(r1[0]); o[c][8 * kp + 3] += bfhi(r1[0]);
            o[c][8 * kp + 4] += bflo(r0[1]); o[c][8 * kp + 5] += bfhi(r0[1]); o[c][8 * kp + 6] += bflo(r1[1]); o[c][8 * kp + 7] += bfhi(r1[1]);
        }
}

template <bool CAUSAL>
__device__ __forceinline__ void attn_core(const LAS unsigned char* ldsK, const LAS unsigned char* ldsV, const LAS float* tab, const bf16x8 (&qf)[8], int qrel, int ntiles, int lane, f32x16 (&o)[4], float& lsum) {
    const int r32 = lane & 31, hi = lane >> 5, blk16 = (lane >> 4) & 1, q4 = (lane & 15) >> 2, p4 = lane & 3;
    unsigned vlow[2], vc[4];
#pragma unroll
    for (int t = 0; t < 2; ++t) vlow[t] = 256u * (8 * t + 4 * hi + q4) + 16u * ((unsigned)(2 * blk16 + (p4 >> 1)) ^ (unsigned)((2 * t + hi) & 3)) + 8u * (p4 & 1);
#pragma unroll
    for (int c = 0; c < 4; ++c) vc[c] = 64u * (unsigned)(c ^ q4);
    unsigned koff[8], voff[2][4];
    unsigned vrel = (unsigned)(ldsV - ldsK); asm volatile("" : "+v"(vrel));
#pragma unroll
    for (int s = 0; s < 8; ++s) koff[s] = off_b(r32, 2 * s + hi);
#pragma unroll
    for (int t = 0; t < 2; ++t)
#pragma unroll
        for (int c = 0; c < 4; ++c) voff[t][c] = vrel + vlow[t] + vc[c];
    for (int kt = 0; kt < ntiles; ++kt) {
        const int dbase = qrel - 64 * kt - 4 * hi;
        const LAS float* tq = tab + (TREV - (dbase < 0 ? 0 : (dbase > TREV ? TREV : dbase)));
        f32x16 s0, s1;
#pragma unroll
        for (int r = 0; r < 16; ++r) { s0[r] = tq[(r & 3) + 8 * (r >> 2)]; s1[r] = tq[32 + (r & 3) + 8 * (r >> 2)]; }
        const unsigned kb = 16384u * (unsigned)kt;
        bf16x8 a0 = *(const LAS bf16x8*)(ldsK + (koff[0] + kb)), a1 = *(const LAS bf16x8*)(ldsK + (koff[0] + kb) + 8192);
#pragma unroll
        for (int s = 0; s < 8; ++s) {
            bf16x8 n0 = a0, n1 = a1;
            if (s < 7) { const LAS unsigned char* ka = ldsK + (koff[s + 1] + kb); n0 = *(const LAS bf16x8*)ka; n1 = *(const LAS bf16x8*)(ka + 8192); }
            __builtin_amdgcn_sched_barrier(0x6);
            s0 = __builtin_amdgcn_mfma_f32_32x32x16_bf16(a0, qf[s], s0, 0, 0, 0);
            s1 = __builtin_amdgcn_mfma_f32_32x32x16_bf16(a1, qf[s], s1, 0, 0, 0);
            __builtin_amdgcn_sched_barrier(0x6);
            a0 = n0; a1 = n1;
        }
#pragma unroll
        for (int r = 0; r < 16; ++r) {
            float p0 = __builtin_amdgcn_exp2f(s0[r]), p1 = __builtin_amdgcn_exp2f(s1[r]);
            if (CAUSAL) { const int e0 = (r & 3) + 8 * (r >> 2); p0 = dbase < e0 ? 0.f : p0; p1 = dbase < e0 + 32 ? 0.f : p1; }
            s0[r] = p0; s1[r] = p1;
        }
        bf16x8 pf[4];
        typedef __bf16 bf16x2_t __attribute__((ext_vector_type(2)));
        const bf16x2_t ones = __builtin_bit_cast(bf16x2_t, 0x3f803f80u);
#pragma unroll
        for (int s = 0; s < 2; ++s) {
            u32x4 w0, w1;
            w0.x = pk2(s0[8 * s + 0], s0[8 * s + 1]); w0.y = pk2(s0[8 * s + 2], s0[8 * s + 3]); w0.z = pk2(s0[8 * s + 4], s0[8 * s + 5]); w0.w = pk2(s0[8 * s + 6], s0[8 * s + 7]);
            w1.x = pk2(s1[8 * s + 0], s1[8 * s + 1]); w1.y = pk2(s1[8 * s + 2], s1[8 * s + 3]); w1.z = pk2(s1[8 * s + 4], s1[8 * s + 5]); w1.w = pk2(s1[8 * s + 6], s1[8 * s + 7]);
#pragma unroll
            for (int d = 0; d < 4; ++d) { const unsigned u0 = w0[d], u1 = w1[d];
                lsum = __builtin_amdgcn_fdot2_f32_bf16(__builtin_bit_cast(bf16x2_t, u0), ones, lsum, false); lsum = __builtin_amdgcn_fdot2_f32_bf16(__builtin_bit_cast(bf16x2_t, u1), ones, lsum, false); }
            pf[s] = __builtin_bit_cast(bf16x8, w0); pf[2 + s] = __builtin_bit_cast(bf16x8, w1);
        }
        s16x4 lo = vtr(ldsK + (voff[0][0] + kb)), hh = vtr(ldsK + (voff[1][0] + kb));
#pragma unroll
        for (int i = 0; i < 16; ++i) { const int c = i >> 2, ks = i & 3;
            s16x4 nlo = lo, nhh = hh;
            if (i < 15) { const int c2 = (i + 1) >> 2, ks2 = (i + 1) & 3; nlo = vtr(ldsK + (voff[0][c2] + kb) + 4096 * ks2); nhh = vtr(ldsK + (voff[1][c2] + kb) + 4096 * ks2); }
            __builtin_amdgcn_sched_barrier(0x6);
            const bf16x8 vf = (bf16x8){lo[0], lo[1], lo[2], lo[3], hh[0], hh[1], hh[2], hh[3]};
            o[c] = __builtin_amdgcn_mfma_f32_32x32x16_bf16(vf, pf[ks], o[c], 0, 0, 0);
            __builtin_amdgcn_sched_barrier(0x6);
            lo = nlo; hh = nhh;
        }
    }
}

__device__ __forceinline__ void load_kv(const bf16_t* Z, const float* tabg, LAS unsigned char* ldsK, LAS unsigned char* ldsV, LAS float* tab, float M2, int b, int h, int j, int tid) {
    const bf16_t* kbase = Z + (size_t)(b * SEQ + j * 256) * ZP + OFF_D + 512 + h * HD;
#pragma unroll
    for (int i = 0; i < 8; ++i) { const int idx = tid + 512 * i, row = idx >> 4, ch = idx & 15;
        const u32x4 kv = ldg16(kbase + (size_t)row * ZP + 8 * ch), vv = ldg16(kbase + (size_t)row * ZP + 512 + 8 * ch);
        *(LAS u32x4*)(ldsK + off_b(row, ch)) = kv; *(LAS u32x4*)(ldsV + off_b(row, ch)) = vv; }
    for (int i = tid; i < TABP; i += 512) { const int d = TREV - i; tab[i] = tabg[h * TABN + (d < 0 ? 0 : (d > TABN - 1 ? TABN - 1 : d))] - M2; }
}

__global__ void __launch_bounds__(512, 2) fwd(Args args) {
    extern __shared__ __attribute__((aligned(16))) unsigned char lds_raw[];
    LAS unsigned char* lds = (LAS unsigned char*)lds_raw;
    volatile LAS unsigned* MISC = (volatile LAS unsigned*)(lds + MISC_OFF);
    const int G = gridDim.x, bx = blockIdx.x;
    const int vcu = (G % 8 == 0) ? (bx % 8) * (G / 8) + bx / 8 : bx;
    const int ngw = G * 8;
    { const int tid0 = threadIdx.x; for (int u = tid0; u < (LDS_BYTES - MISC_OFF) / 4; u += 512) ((LAS unsigned*)(lds + MISC_OFF))[u] = 0u; }
    __syncthreads();
    XcdBarrier bar = xcd_barrier_post((unsigned*)(args.ws + WS_CTL) + CW_BAR, MISC + 8);
    float* xout = args.out;
#define LANE_VARS const int tid = opaque_tid(); const int lane = tid & 63; const int wave = __builtin_amdgcn_readfirstlane(tid >> 6); const int gw = vcu * 8 + wave; (void)tid; (void)lane; (void)wave; (void)gw;
#define PHASE_VARS \
    const int tid = opaque_tid(); const int lane = tid & 63; const int wave = __builtin_amdgcn_readfirstlane(tid >> 6); const int gw = vcu * 8 + wave; \
    unsigned char* ws = opaque_ptr(args.ws); unsigned* ctl = (unsigned*)(ws + WS_CTL); \
    float* ksum = (float*)(ws + WS_KSUM); float* tabg = (float*)(ws + WS_TAB); bf16_t* Wsb = (bf16_t*)(ws + WS_WSB); \
    unsigned short* lists = (unsigned short*)(ws + WS_LIST); float* lslot = (float*)(ws + WS_LSLOT); \
    bf16_t* Wt_in = (bf16_t*)(ws + WS_W + W_IN_OFF); bf16_t* Wt_out = (bf16_t*)(ws + WS_W + W_OUT_OFF); bf16_t* Wt_o = (bf16_t*)(ws + WS_W + W_O_OFF); \
    bf16_t* Wt_mi = (bf16_t*)(ws + WS_W + W_MI_OFF); bf16_t* Wt_mo = (bf16_t*)(ws + WS_W + W_MO_OFF); \
    unsigned char* h8 = ws + WS_H8; unsigned char* Wg8 = ws + WS_W + W_G8_OFF; bf16_t* xb = (bf16_t*)(ws + WS_XB); float* part = (float*)(ws + WS_PART); (void)h8; (void)Wg8; (void)xb; (void)part; \
    bf16_t* actA = (bf16_t*)(ws + WS_ACTA); bf16_t* U = (bf16_t*)(ws + WS_U); bf16_t* Z = (bf16_t*)(ws + WS_Z); float* oslot = (float*)(ws + WS_OSLOT); \
    (void)tid; (void)lane; (void)wave; (void)gw; (void)ctl; (void)ksum; (void)tabg; (void)Wsb; (void)lists; (void)lslot; (void)Wt_in; (void)Wt_out; (void)Wt_o; (void)Wt_mi; (void)Wt_mo; (void)actA; (void)U; (void)Z; (void)oslot;

    for (int l = 0; l < DEPTH; ++l) {
        if (PH_MASK & (1 << 0)) REP(0) { PHASE_VARS
            LAS float* scr = (LAS float*)(lds + wave * 17408);
            constexpr int I_IN = (DM / 64) * (ZP / 64), I_OUT1 = (512 / 64) * (DM / 64), I_O = (DM / 64) * (DM / 64), I_MI = (DM / 64) * (DFF / 64), I_MO = (DFF / 64) * (DM / 64);
            constexpr int NITEMS = I_IN + 4 * I_OUT1 + I_O + I_MI + I_MO;
            const float* w_in = args.in[3] + (size_t)l * DM * ZP;
            const float* w_oa = args.in[5] + (size_t)l * 512 * DM; const float* w_ob = args.in[10] + (size_t)l * 512 * DM;
            const float* w_oc = args.in[15] + (size_t)l * 512 * DM; const float* w_od = args.in[18] + (size_t)l * 512 * DM;
            const float* gmix = args.in[2] + (size_t)l * DM; const float* gmlp = args.in[20] + (size_t)l * DM;
            const float* w_o = args.in[19] + (size_t)l * DM * DM; const float* w_mi = args.in[21] + (size_t)l * DM * DFF; const float* w_mo = args.in[22] + (size_t)l * DFF * DM;
            for (int it = gw; it < NITEMS; it += ngw) {
                int r = it;
                if (r < I_IN) { if ((r % (ZP / 64)) < OFF_G / 64) transpose_item<false>(w_in, gmix, DM, ZP, Wt_in, 0, scr, r, lane); else transpose_item<true>(w_in, gmix, DM, ZP, Wg8, OFF_G, scr, r, lane); continue; } r -= I_IN;
                if (r < I_OUT1) { transpose_item<false>(w_oa, nullptr, 512, DM, Wt_out, 0, scr, r, lane); continue; } r -= I_OUT1;
                if (r < I_OUT1) { transpose_item<false>(w_ob, nullptr, 512, DM, Wt_out + (size_t)DM * 512, 0, scr, r, lane); continue; } r -= I_OUT1;
                if (r < I_OUT1) { transpose_item<false>(w_oc, nullptr, 512, DM, Wt_out + (size_t)2 * DM * 512, 0, scr, r, lane); continue; } r -= I_OUT1;
                if (r < I_OUT1) { transpose_item<false>(w_od, nullptr, 512, DM, Wt_out + (size_t)3 * DM * 512, 0, scr, r, lane); continue; } r -= I_OUT1;
                if (r < I_O) { transpose_item<false>(w_o, nullptr, DM, DM, Wt_o, 0, scr, r, lane); continue; } r -= I_O;
                if (r < I_MI) { transpose_item<false>(w_mi, gmlp, DM, DFF, Wt_mi, 0, scr, r, lane); continue; } r -= I_MI;
                transpose_item<false>(w_mo, nullptr, DFF, DM, Wt_mo, 0, scr, r, lane);
            }
            const float* wsp = args.in[13] + (size_t)l * 4 * 128 * 128;
            for (int e = bx * 512 + tid; e < 4 * 128 * 128; e += G * 512) { const int t = (e >> 7) & 127, s = e & 127; Wsb[e] = (bf16_t)(pk2(s <= t ? wsp[e] : 0.f, 0.f) & 0xffffu); }
            if (l == 0) for (int e = bx * 512 + tid; e < NH * TABN; e += G * 512) { const int h = e / TABN, d = e % TABN; tabg[e] = args.in[1][rel_bucket(d) * NH + h] * LOG2E; }
            if (l == 0) x_rows_in(args.in[0], xb, h8, part, gw, ngw, lane);
        }
        xcd_barrier(bar);
        if (PH_MASK & (1 << 1)) REP(1) { PHASE_VARS
            { pg8::Gemm g{xb, Wt_in, DM * 2, DM * 2, DM * 2, 0, 0}; pg8::StaticOrder<0> S; S.init(MROWS, OFF_G, G, bx);
              pg8::EpiZ E{Z, part, 0, 0, 1.0f};
              pg8::gemm_phase<pg8::EpiZ, pg8::StaticOrder<0>, false>(lds, g, S, E, tid); }
        }
        xcd_barrier(bar);
        if (PH_MASK & (1 << 2)) { PHASE_VARS
            REP(11) { LANE_VARS
                const float* cw = args.in[4] + (size_t)l * 3 * 512;
                for (int unit = vcu; unit < MROWS / 128; unit += G) {
                    const int c8 = 8 * lane;
                    float w[3][8];
#pragma unroll
                    for (int k = 0; k < 3; ++k) { const f32x4 w0 = *(const GAS f32x4*)(cw + k * 512 + c8), w1 = *(const GAS f32x4*)(cw + k * 512 + c8 + 4);
#pragma unroll
                        for (int e = 0; e < 4; ++e) { w[k][e] = w0[e]; w[k][4 + e] = w1[e]; } }
                    const int t0 = unit * 128 + wave * 16, tseq0 = t0 & (SEQ - 1);
                    float h2[8], h1[8];
                    { const int r2 = tseq0 >= 2 ? t0 - 2 : t0, r1 = tseq0 >= 1 ? t0 - 1 : t0; const float m2 = tseq0 >= 2 ? 1.f : 0.f, m1 = tseq0 >= 1 ? 1.f : 0.f;
                      float a2[8], x2[8], a1[8], x1[8];
                      unpack8(ldg16(Z + (size_t)r2 * ZP + OFF_A + 512 + c8), a2); unpack8(ldg16(Z + (size_t)r2 * ZP + OFF_A + 1024 + c8), x2);
                      unpack8(ldg16(Z + (size_t)r1 * ZP + OFF_A + 512 + c8), a1); unpack8(ldg16(Z + (size_t)r1 * ZP + OFF_A + 1024 + c8), x1);
#pragma unroll
                      for (int e = 0; e < 8; ++e) { h2[e] = a2[e] * x2[e] * m2; h1[e] = a1[e] * x1[e] * m1; } }
#pragma unroll
                    for (int gq = 0; gq < 4; ++gq) {
                        u32x4 rb[4], rc[4], rx[4];
#pragma unroll
                        for (int q = 0; q < 4; ++q) { const bf16_t* zp = Z + (size_t)(t0 + 4 * gq + q) * ZP + OFF_A + c8; rb[q] = ldg16(zp); rc[q] = ldg16(zp + 512); rx[q] = ldg16(zp + 1024); }
#pragma unroll
                        for (int q = 0; q < 4; ++q) {
                            float ab[8], ac[8], ax[8], o[8]; unpack8(rb[q], ab); unpack8(rc[q], ac); unpack8(rx[q], ax);
#pragma unroll
                            for (int e = 0; e < 8; ++e) { const float cx = ac[e] * ax[e]; o[e] = ab[e] * (w[0][e] * h2[e] + w[1][e] * h1[e] + w[2][e] * cx); h2[e] = h1[e]; h1[e] = cx; }
                            stg16(U + (size_t)(t0 + 4 * gq + q) * DM + c8, pack8(o));
                        }
                    }
                }
            }
            REP(12) { LANE_VARS
                const float* gqp = args.in[16] + (size_t)l * HD; const float* gkp = args.in[17] + (size_t)l * HD;
                float gq[8], gk[8];
#pragma unroll
                for (int e = 0; e < 8; ++e) { gq[e] = gqp[(8 * lane + e) & 127] * QSCALE; gk[e] = gkp[(8 * lane + e) & 127]; }
                LAS float* red = (LAS float*)lds;
                for (int unit = vcu; unit < MROWS / 128; unit += G) {
                    float ks[8];
#pragma unroll
                    for (int e = 0; e < 8; ++e) ks[e] = 0.f;
#pragma unroll 1
                    for (int i4 = 0; i4 < 16; i4 += 4) {
                        u32x4 rq4[4], rk4[4];
#pragma unroll
                        for (int q = 0; q < 4; ++q) { const bf16_t* qp = Z + (size_t)(unit * 128 + wave * 16 + i4 + q) * ZP + OFF_D + 8 * lane; rq4[q] = ldg16(qp); rk4[q] = ldg16(qp + 512); }
#pragma unroll
                        for (int q4 = 0; q4 < 4; ++q4) {
                            const int row = unit * 128 + wave * 16 + i4 + q4;
                            bf16_t* qp = Z + (size_t)row * ZP + OFF_D + 8 * lane; bf16_t* kp = qp + 512;
                            float q[8], k[8]; unpack8(rq4[q4], q); unpack8(rk4[q4], k);
                            float sq = 0.f, sk = 0.f;
#pragma unroll
                            for (int e = 0; e < 8; ++e) { sq += q[e] * q[e]; sk += k[e] * k[e]; }
#pragma unroll
                            for (int o = 1; o < 16; o <<= 1) { sq += __shfl_xor(sq, o); sk += __shfl_xor(sk, o); }
                            const float rq = __builtin_amdgcn_rsqf(sq * (1.f / HD) + EPS), rk = __builtin_amdgcn_rsqf(sk * (1.f / HD) + EPS);
#pragma unroll
                            for (int e = 0; e < 8; ++e) { q[e] = q[e] * rq * gq[e]; k[e] = k[e] * rk * gk[e]; ks[e] += k[e]; }
                            if (rep) { bf16_t* dq = U + (size_t)row * DM + 1536 + 8 * lane; stg16(dq, pack8(q)); stg16(dq, pack8(k)); } else { stg16(qp, pack8(q)); stg16(kp, pack8(k)); }
                        }
                    }
#pragma unroll
                    for (int e = 0; e < 8; ++e) red[wave * 512 + 8 * lane + e] = ks[e];
                    __syncthreads();
                    { float s = 0.f;
#pragma unroll
                      for (int w = 0; w < 8; ++w) s += red[w * 512 + tid];
                      (rep ? lslot : ksum)[(size_t)unit * 512 + tid] = s; }
                    __syncthreads();
                }
            }
            REP(13) { LANE_VARS
                const float* cw = args.in[6] + (size_t)l * 31 * 512; const float* cb = args.in[7] + (size_t)l * 512;
                const float* lng = args.in[8] + (size_t)l * 512; const float* lnb = args.in[9] + (size_t)l * 512;
                LAS unsigned char* P = lds;
                for (int unit = vcu; unit < MROWS / 64; unit += G) {
                    const int t0 = unit * 64, tseq0 = t0 & (SEQ - 1);
                    {
                        u32x4 rba[12], rsg[12];
#pragma unroll
                        for (int q = 0; q < 12; ++q) { const int idx = tid + 512 * q, r = idx >> 6, ch = idx & 63; const bool ok = idx < 94 * 64 && (tseq0 - 30 + r >= 0);
                            const size_t grow = ok ? (size_t)(t0 - 30 + r) : (size_t)t0;
                            rba[q] = ldg16(Z + grow * ZP + OFF_B + 8 * ch); rsg[q] = ldg16(Z + grow * ZP + OFF_B + 512 + 8 * ch); }
                        asm volatile("" ::: "memory");
#pragma unroll
                        for (int q = 0; q < 12; ++q) { const int idx = tid + 512 * q, r = idx >> 6, ch = idx & 63; const bool ok = (tseq0 - 30 + r >= 0);
                            float ba[8], sg[8]; unpack8(rba[q], ba); unpack8(rsg[q], sg);
#pragma unroll
                            for (int e = 0; e < 8; ++e) ba[e] = ok ? ba[e] * sg[e] : 0.f;
                            if (idx < 94 * 64) *(LAS u32x4*)(P + r * 1024 + ch * 16) = pack8(ba); }
                    }
                    __syncthreads();
                    {
                        float w[31];
#pragma unroll
                        for (int k = 0; k < 31; ++k) w[k] = cw[k * 512 + tid];
                        const float bias = cb[tid];
                        LAS unsigned short* Pc = (LAS unsigned short*)P + tid;
                        for (int grp = 0; grp < 8; ++grp) {
                            float pv[38];
#pragma unroll
                            for (int i = 0; i < 38; ++i) pv[i] = __uint_as_float((unsigned)Pc[(grp * 8 + i) * 512] << 16);
                            float hb[8];
#pragma unroll
                            for (int o = 0; o < 8; ++o) { float a = bias;
#pragma unroll
                                for (int k = 0; k < 31; ++k) a += w[k] * pv[o + k];
                                hb[o] = a; }
#pragma unroll
                            for (int o = 0; o < 8; o += 2) { const unsigned pkd = pk2(hb[o], hb[o + 1]); Pc[(grp * 8 + o) * 512] = (unsigned short)(pkd & 0xffffu); Pc[(grp * 8 + o + 1) * 512] = (unsigned short)(pkd >> 16); }
                        }
                    }
                    __syncthreads();
                    {
                        float gg[8], bb[8];
#pragma unroll
                        for (int e = 0; e < 8; ++e) { gg[e] = lng[8 * lane + e]; bb[e] = lnb[8 * lane + e]; }
                        for (int i = 0; i < 8; ++i) {
                            const int tt = wave * 8 + i;
                            float x[8]; unpack8(*(const LAS u32x4*)(P + tt * 1024 + lane * 16), x);
                            float s1 = 0.f, s2 = 0.f;
#pragma unroll
                            for (int e = 0; e < 8; ++e) { s1 += x[e]; s2 += x[e] * x[e]; }
                            s1 = wave_sum(s1); s2 = wave_sum(s2);
                            const float mean = s1 * (1.f / 512), var = fmaxf(s2 * (1.f / 512) - mean * mean, 0.f), rstd = __builtin_amdgcn_rsqf(var + EPS);
#pragma unroll
                            for (int e = 0; e < 8; ++e) { const float y = (x[e] - mean) * rstd * gg[e] + bb[e]; x[e] = y * sigmoid_f(y); }
                            stg16(U + (size_t)(t0 + tt) * DM + 512 + 8 * lane, pack8(x));
                        }
                    }
                    __syncthreads();
                }
            }
            REP(14) { LANE_VARS
                const float* lng = args.in[11] + (size_t)l * 512; const float* lnb = args.in[12] + (size_t)l * 512;
                const float* bsp = args.in[14] + (size_t)l * 4 * 128;
                constexpr int VP = 136;
                LAS unsigned short* vvT = (LAS unsigned short*)lds;
                for (int unit = vcu; unit < MROWS / 128; unit += G) {
                    const int row0 = unit * 128;
                    {
                        float gg[8], bb[8];
#pragma unroll
                        for (int e = 0; e < 8; ++e) { gg[e] = lng[8 * lane + e]; bb[e] = lnb[8 * lane + e]; }
#pragma unroll 1
                        for (int i4 = 0; i4 < 16; i4 += 4) {
                            u32x4 rx4[4];
#pragma unroll
                            for (int q = 0; q < 4; ++q) rx4[q] = ldg16(Z + (size_t)(row0 + wave * 16 + i4 + q) * ZP + OFF_C + 512 + 8 * lane);
#pragma unroll
                            for (int q = 0; q < 4; ++q) {
                                const int t = wave * 16 + i4 + q;
                                float x[8]; unpack8(rx4[q], x);
                                float s1 = 0.f, s2 = 0.f;
#pragma unroll
                                for (int e = 0; e < 8; ++e) { s1 += x[e]; s2 += x[e] * x[e]; }
                                s1 = wave_sum(s1); s2 = wave_sum(s2);
                                const float mean = s1 * (1.f / 512), var = fmaxf(s2 * (1.f / 512) - mean * mean, 0.f), rstd = __builtin_amdgcn_rsqf(var + EPS);
#pragma unroll
                                for (int e = 0; e < 8; e += 2) {
                                    const unsigned pkd = pk2((x[e] - mean) * rstd * gg[e] + bb[e], (x[e + 1] - mean) * rstd * gg[e + 1] + bb[e + 1]);
                                    vvT[(8 * lane + e) * VP + t] = (unsigned short)(pkd & 0xffffu); vvT[(8 * lane + e + 1) * VP + t] = (unsigned short)(pkd >> 16);
                                }
                            }
                        }
                    }
                    __syncthreads();
                    {
                        const int grp = wave >> 1, th = wave & 1, l15 = lane & 15, l4 = lane >> 4;
                        bf16x8 bfr[4][4];
#pragma unroll
                        for (int tt = 0; tt < 4; ++tt)
#pragma unroll
                            for (int ks = 0; ks < 4; ++ks) bfr[tt][ks] = __builtin_bit_cast(bf16x8, ldg16(Wsb + (size_t)(grp * 128 + 64 * th + 16 * tt + l15) * 128 + 32 * ks + 8 * l4));
                        float bs4[4]; u32x2 un[4];
#pragma unroll
                        for (int tt = 0; tt < 4; ++tt) { const int t = 64 * th + 16 * tt + l15; bs4[tt] = bsp[grp * 128 + t]; un[tt] = *(const GAS u32x2*)(Z + (size_t)(row0 + t) * ZP + OFF_C + grp * 128 + 4 * l4); }
#pragma unroll
                        for (int ct = 0; ct < 8; ++ct) {
                            f32x4 acc4[4]; u32x2 uc[4];
#pragma unroll
                            for (int tt = 0; tt < 4; ++tt) { acc4[tt] = (f32x4){0.f, 0.f, 0.f, 0.f}; uc[tt] = un[tt]; }
                            if (ct < 7) {
#pragma unroll
                                for (int tt = 0; tt < 4; ++tt) { const int t = 64 * th + 16 * tt + l15; un[tt] = *(const GAS u32x2*)(Z + (size_t)(row0 + t) * ZP + OFF_C + grp * 128 + 16 * (ct + 1) + 4 * l4); } }
#pragma unroll
                            for (int ks = 0; ks < 4; ++ks) {
                                const bf16x8 a = *(const LAS bf16x8*)((const LAS unsigned char*)vvT + ((grp * 128 + 16 * ct + l15) * VP + 32 * ks + 8 * l4) * 2);
#pragma unroll
                                for (int tt = 0; tt < 4; ++tt) acc4[tt] = __builtin_amdgcn_mfma_f32_16x16x32_bf16(a, bfr[tt][ks], acc4[tt], 0, 0, 0);
                            }
                            const int c0 = grp * 128 + 16 * ct + 4 * l4;
#pragma unroll
                            for (int tt = 0; tt < 4; ++tt) {
                                const int t = 64 * th + 16 * tt + l15; const float bs = bs4[tt]; const u32x2 uw = uc[tt];
                                u32x2 ow; ow.x = pk2(bflo(uw.x) * (acc4[tt][0] + bs), bfhi(uw.x) * (acc4[tt][1] + bs)); ow.y = pk2(bflo(uw.y) * (acc4[tt][2] + bs), bfhi(uw.y) * (acc4[tt][3] + bs));
                                *(GAS u32x2*)(U + (size_t)(row0 + t) * DM + 1024 + c0) = ow;
                            }
                        }
                    }
                    __syncthreads();
                }
            }
        }
        xcd_barrier(bar);
        if (PH_MASK & (1 << 3)) REP(3) { PHASE_VARS
            LAS float* km = (LAS float*)lds;
            LAS unsigned* hist = (LAS unsigned*)(lds + 16384);
            unsigned* cntl = ctl + CW_CNT + l * 512 + (rep ? 2048 : 0);
            for (int unit0 = vcu, uk = 0; unit0 < BATCH * NH * 32; unit0 += G, ++uk) {
                const int unit = (uk & 1) ? (unit0 ^ 31) : unit0;
                const int i = unit & 31, h = (unit >> 5) & 3, b = unit >> 7;
                if (i == 0) continue;
                for (int e = tid; e < i * 128; e += 512) { const int j = e >> 7, d = e & 127; km[e] = ksum[(size_t)(b * 64 + 2 * j) * 512 + h * HD + d] + ksum[(size_t)(b * 64 + 2 * j + 1) * 512 + h * HD + d]; }
                if (tid < 96) hist[tid] = 0u;
                __syncthreads();
                const int ql = tid >> 1, half = tid & 1;
                const bf16_t* qp = Z + (size_t)(b * SEQ + i * 256 + ql) * ZP + OFF_D + h * HD + half * 64;
                float qv[64];
#pragma unroll
                for (int s = 0; s < 8; ++s) { float t8[8]; unpack8(ldg16(qp + 8 * s), t8);
#pragma unroll
                    for (int e = 0; e < 8; ++e) qv[8 * s + e] = t8[e]; }
                float v0 = -3.0e38f, v1 = -3.0e38f, v2 = -3.0e38f; int i0 = 0, i1 = 0, i2 = 0;
                for (int j = 0; j < i; ++j) {
                    const LAS f32x4* kp = (const LAS f32x4*)(km + j * 128 + half * 64);
                    float dot = 0.f;
#pragma unroll
                    for (int s = 0; s < 16; ++s) { const f32x4 kk = kp[s]; dot += qv[4 * s] * kk.x + qv[4 * s + 1] * kk.y + qv[4 * s + 2] * kk.z + qv[4 * s + 3] * kk.w; }
                    dot += __shfl_xor(dot, 1);
                    const bool g0 = dot > v0, g1 = dot > v1, g2 = dot > v2;
                    v2 = g1 ? v1 : (g2 ? dot : v2); i2 = g1 ? i1 : (g2 ? j : i2);
                    v1 = g0 ? v0 : (g1 ? dot : v1); i1 = g0 ? i0 : (g1 ? j : i1);
                    v0 = g0 ? dot : v0; i0 = g0 ? j : i0;
                }
                const int nsel = i < 3 ? i : 3;
                if (half == 0) { lds_add(&hist[i0], 1u); if (nsel > 1) lds_add(&hist[i1], 1u); if (nsel > 2) lds_add(&hist[i2], 1u); }
                __syncthreads();
                if (tid < 32) { const unsigned n = hist[tid]; if (n) hist[32 + tid] = __hip_atomic_fetch_add(cntl + (b * NH + h) * 32 + tid, n, __ATOMIC_RELAXED, __HIP_MEMORY_SCOPE_AGENT); }
                __syncthreads();
                if (half == 0) {
                    unsigned short* lb = (rep ? (unsigned short*)oslot : lists) + (size_t)((b * NH + h) * 32) * 8192;
                    const unsigned tq = (unsigned)(i * 256 + ql);
                    { const unsigned pos = hist[32 + i0] + lds_add(&hist[64 + i0], 1u); lb[(size_t)i0 * 8192 + pos] = (unsigned short)(tq); }
                    if (nsel > 1) { const unsigned pos = hist[32 + i1] + lds_add(&hist[64 + i1], 1u); lb[(size_t)i1 * 8192 + pos] = (unsigned short)(tq | (1u << 13)); }
                    if (nsel > 2) { const unsigned pos = hist[32 + i2] + lds_add(&hist[64 + i2], 1u); lb[(size_t)i2 * 8192 + pos] = (unsigned short)(tq | (2u << 13)); }
                }
                __syncthreads();
            }
        }
        xcd_barrier(bar);
        LAS unsigned char* ldsK = lds; LAS unsigned char* ldsV = lds + 65536; LAS float* tab = (LAS float*)(lds + 131072);
        LAS float* M2s = (LAS float*)(lds + 131072 + TABP * 4);
        LAS int* pre = (LAS int*)(lds + 131072 + TABP * 4 + 64);
        { LANE_VARS if (wave == 0) {
            const float* gqp = args.in[16] + (size_t)l * HD; const float* gkp = args.in[17] + (size_t)l * HD;
            const float gqm = wave_max(fmaxf(fabsf(gqp[lane]), fabsf(gqp[64 + lane]))), gkm = wave_max(fmaxf(fabsf(gkp[lane]), fabsf(gkp[64 + lane])));
#pragma unroll
            for (int h = 0; h < NH; ++h) { const float bm = wave_max(lane < 32 ? fabsf(args.in[1][lane * NH + h]) : 0.f); if (lane == 0) M2s[h] = (128.f * gqm * gkm * 0.08838834764831845f + bm) * LOG2E; }
        } }
        __syncthreads();
        if (PH_MASK & (1 << 4)) REP(4) { PHASE_VARS
            const unsigned* cntl = ctl + CW_CNT + l * 512;
            {
                const int c = (int)__hip_atomic_load(cntl + tid, __ATOMIC_RELAXED, __HIP_MEMORY_SCOPE_AGENT);
                const int nch = (c + 255) >> 8;
                int incl = nch;
#pragma unroll
                for (int o = 1; o < 64; o <<= 1) { const int t = __shfl_up(incl, o); if (lane >= o) incl += t; }
                LAS int* wtot = (LAS int*)(lds + 131072 + TABP * 4 + 32);
                if (lane == 63) wtot[wave] = incl;
                __syncthreads();
                int wbase = 0;
#pragma unroll
                for (int w = 0; w < 8; ++w) wbase += (w < wave) ? wtot[w] : 0;
                pre[tid] = wbase + incl - nch;
                if (tid == 511) pre[512] = wbase + incl;
                __syncthreads();
            }
            const int NI = pre[512];
            const int it0 = (int)(((long)vcu * NI) / G), it1 = (int)(((long)(vcu + 1) * NI) / G);
            int cur = -1;
            for (int it = it0; it < it1; ++it) {
                int lo = 0, hi2 = 511;
                while (lo < hi2) { const int mid = (lo + hi2 + 1) >> 1; if (pre[mid] <= it) lo = mid; else hi2 = mid - 1; }
                const int bhj = lo, chunk = it - pre[bhj];
                const int j = bhj & 31, h = (bhj >> 5) & 3, b = bhj >> 7;
                if (bhj != cur) { __syncthreads(); load_kv(Z, tabg, ldsK, ldsV, tab, M2s[h], b, h, j, tid); cur = bhj; __syncthreads(); }
                const int cnt = (int)__hip_atomic_load(cntl + bhj, __ATOMIC_RELAXED, __HIP_MEMORY_SCOPE_AGENT);
                const int e = chunk * 256 + wave * 32 + (lane & 31);
                const bool valid = e < cnt;
                const unsigned ent = lists[(size_t)bhj * 8192 + (valid ? e : chunk * 256)];
                const int tq = ent & 8191, rsel = ent >> 13;
                const size_t row = (size_t)b * SEQ + tq;
                bf16x8 qf[8];
                { const bf16_t* qp = Z + row * ZP + OFF_D + h * HD + 8 * (lane >> 5);
#pragma unroll
                  for (int s = 0; s < 8; ++s) qf[s] = __builtin_bit_cast(bf16x8, ldg16(qp + 16 * s)); }
                f32x16 o[4];
#pragma unroll
                for (int c = 0; c < 4; ++c)
#pragma unroll
                    for (int r = 0; r < 16; ++r) o[c][r] = 0.f;
                float lsum = 0.f;
                attn_core<false>(ldsK, ldsV, tab, qf, tq - j * 256, 4, lane, o, lsum);
                lsum += __shfl_xor(lsum, 32);
                store_o_bf16(valid ? (bf16_t*)oslot + ((size_t)rsel * MROWS + row) * 512 + h * HD : (bf16_t*)oslot + (size_t)3 * MROWS * 512 + (size_t)(tid & 63) * 128, o, 1.0f, lane >> 5);
                if (valid && lane < 32) lslot[((size_t)rsel * MROWS + row) * 4 + h] = lsum;
            }
        }
        xcd_barrier(bar);
        if (PH_MASK & (1 << 5)) REP(5) { PHASE_VARS
            for (int unit = vcu; unit < BATCH * NH * 32; unit += G) {
                const int i = unit & 31, h = (unit >> 5) & 3, b = unit >> 7;
                __syncthreads(); load_kv(Z, tabg, ldsK, ldsV, tab, M2s[h], b, h, i, tid); __syncthreads();
                const int ql = wave * 32 + (lane & 31);
                const size_t row = (size_t)b * SEQ + i * 256 + ql;
                bf16x8 qf[8];
                { const bf16_t* qp = Z + row * ZP + OFF_D + h * HD + 8 * (lane >> 5);
#pragma unroll
                  for (int s = 0; s < 8; ++s) qf[s] = __builtin_bit_cast(bf16x8, ldg16(qp + 16 * s)); }
                f32x16 o[4];
#pragma unroll
                for (int c = 0; c < 4; ++c)
#pragma unroll
                    for (int r = 0; r < 16; ++r) o[c][r] = 0.f;
                float lsum = 0.f;
                attn_core<true>(ldsK, ldsV, tab, qf, ql, (wave >> 1) + 1, lane, o, lsum);
                lsum += __shfl_xor(lsum, 32);
                const int nsel = i < 3 ? i : 3;
                for (int r = 0; r < nsel; ++r) {
                    lsum += lslot[((size_t)r * MROWS + row) * 4 + h];
                    load_add_o_bf16((const bf16_t*)oslot + ((size_t)r * MROWS + row) * 512 + h * HD, o, lane >> 5);
                }
                const float inv = 1.0f / lsum;
                store_o_bf16(U + row * DM + 1536 + h * HD, o, inv, lane >> 5);
            }
            __syncthreads();
        }
        if (PH_MASK & (1 << 1)) REP(1) { PHASE_VARS
            pg8::Gemm g{h8, Wg8, DM, DM, DM, 0, 0}; pg8::StaticOrder<0> S; S.init(MROWS, ZP - OFF_G, G, bx);
            pg8::EpiGate8 E{(unsigned char*)Z + OFF_G * 2, part, 1.0f / 64.0f};
            pg8::gemm_phase<pg8::EpiGate8, pg8::StaticOrder<0>, true>(lds, g, S, E, tid);
        }
        xcd_barrier(bar);
        if (PH_MASK & (1 << 6)) REP(6) { PHASE_VARS
            pg8::Gemm g{U, Wt_out, DM * 2, 512 * 2, 512 * 2, (size_t)512 * 2, (size_t)DM * 512 * 2}; pg8::StaticOrder<2> S; S.init(MROWS, DM, G, bx);
            pg8::EpiMerge E{(const unsigned char*)Z + OFF_G * 2, actA};
            pg8::gemm_phase<pg8::EpiMerge, pg8::StaticOrder<2>>(lds, g, S, E, tid);
        }
        xcd_barrier(bar);
        if (PH_MASK & (1 << 7)) REP(7) { PHASE_VARS const bool dry = ((DUP_MASK >> 7) & 1) && rep == 0;
            pg8::Gemm g{actA, Wt_o, DM * 2, DM * 2, DM * 2, 0, 0}; pg8::StaticOrder<0> S; S.init(MROWS, DM, G, bx);
            pg8::EpiResidB E{xb, dry ? (bf16_t*)oslot : xb, nullptr, dry ? lslot : part, nullptr, (LAS float*)(lds + 131072)};
            pg8::gemm_phase<pg8::EpiResidB, pg8::StaticOrder<0>>(lds, g, S, E, tid);
        }
        xcd_barrier(bar);
        if (PH_MASK & (1 << 9)) REP(9) { PHASE_VARS
            pg8::Gemm g{xb, Wt_mi, DM * 2, DM * 2, DM * 2, 0, 0}; pg8::StaticOrder<0> S; S.init(MROWS, DFF, G, bx);
            pg8::EpiRelu2 E{Z, DFF, part};
            pg8::gemm_phase<pg8::EpiRelu2, pg8::StaticOrder<0>>(lds, g, S, E, tid);
        }
        xcd_barrier(bar);
        if (PH_MASK & (1 << 10)) REP(10) { PHASE_VARS const bool dry = ((DUP_MASK >> 10) & 1) && rep == 0;
            pg8::Gemm g{Z, Wt_mo, DFF * 2, DFF * 2, DFF * 2, 0, 0}; pg8::StaticOrder<0> S; S.init(MROWS, DM, G, bx);
            pg8::EpiResidB E{xb, dry ? (bf16_t*)oslot : xb, dry ? (unsigned char*)oslot + 128 * MiB : h8, dry ? lslot : part, (l == DEPTH - 1 && !dry) ? xout : nullptr, (LAS float*)(lds + 131072)};
            pg8::gemm_phase<pg8::EpiResidB, pg8::StaticOrder<0>>(lds, g, S, E, tid);
        }
        xcd_barrier(bar);
    }
}

extern "C" void kernel_launch(void* const* d_in, const int* in_sizes, int n_in, void* d_out, int out_size, void* d_ws, size_t ws_size, hipStream_t stream) {
    static int grid = 0;
    if (grid == 0) {
        if (n_in != 23 || in_sizes[0] != MROWS * DM || out_size != MROWS * DM || ws_size < WS_END) {
            fprintf(stderr, "kernel_launch: unexpected shapes (n_in %d, in0 %d, out %d, ws %zu < %zu); nothing launched\n", n_in, n_in > 0 ? in_sizes[0] : -1, out_size, ws_size, (size_t)WS_END); grid = -1; return; }
        int dev = 0, cus = 0, per_cu = 0;
        if (hipGetDevice(&dev) != hipSuccess || hipDeviceGetAttribute(&cus, hipDeviceAttributeMultiprocessorCount, dev) != hipSuccess) { grid = -1; return; }
        if (hipFuncSetAttribute((const void*)fwd, hipFuncAttributeMaxDynamicSharedMemorySize, LDS_BYTES) != hipSuccess) { fprintf(stderr, "kernel_launch: hipFuncSetAttribute failed\n"); grid = -1; return; }
        if (hipOccupancyMaxActiveBlocksPerMultiprocessor(&per_cu, (const void*)fwd, 512, LDS_BYTES) != hipSuccess || per_cu < 1)
            fprintf(stderr, "kernel_launch: note: occupancy query reports %d workgroups per CU\n", per_cu);
        (void)hipGetLastError();
        grid = cus;
    }
    if (grid < 0) return;
    if (hipMemsetAsync((char*)d_ws + WS_CTL, 0, CTL_ZERO_BYTES, stream) != hipSuccess) { fprintf(stderr, "kernel_launch: memset failed\n"); return; }
    Args a{};
    for (int i = 0; i < 23; ++i) a.in[i] = (const float*)d_in[i];
    a.out = (float*)d_out; a.ws = (unsigned char*)d_ws;
    hipLaunchKernelGGL(fwd, dim3(grid), dim3(512), LDS_BYTES, stream, a);
}
```
